# Optimizing an MI355X kernel written in HIP

```python
import jax, jax.numpy as jnp
from jax import lax
import numpy as np

D_MODEL = 2048
BATCH = 4
SEQ = 2048
DEPTH = 4

GRID_W = 64
CTX_LEN = 256
N_MIXERS = 3
EPS = 1e-6
NEG_INF = -1e30

D_FF = ((8 * D_MODEL // 3 + 255) // 256) * 256

GLA_HEADS = 4
GLA_DK = D_MODEL // 2
GLA_DV = D_MODEL
GLA_DK_HEAD = GLA_DK // GLA_HEADS
GLA_DV_HEAD = GLA_DV // GLA_HEADS
GLA_RANK = 16
GLA_TAU = 16.0
GLA_CHUNK = 64
GLA_IN = 2 * GLA_DK + 2 * GLA_DV + 2 * GLA_RANK

SWA_HEAD_DIM = 64
SWA_HEADS = D_MODEL // SWA_HEAD_DIM
SWA_KV_HEADS = 4
SWA_GROUP = SWA_HEADS // SWA_KV_HEADS
SWA_WINDOW = 128
SWA_BLOCK = 128
SWA_IN = (SWA_HEADS + 2 * SWA_KV_HEADS) * SWA_HEAD_DIM
ROPE_BASE = 10000.0

GMLP_WIDTH = D_MODEL
GMLP_CHUNK = 128
GMLP_GROUPS = 16
GMLP_GROUP_DIM = GMLP_WIDTH // GMLP_GROUPS

N_A = (DEPTH + 2) // 3
N_B = (DEPTH + 1) // 3
N_C = DEPTH // 3

kernel_name = "hybrid_gla_swa_gmlp_diffusion_trunk"

F32 = jnp.float32


def rmsnorm(x, g):
    xf = x.astype(F32)
    y = xf * lax.rsqrt(jnp.mean(xf * xf, axis=-1, keepdims=True) + EPS)
    return (y * g.astype(F32)).astype(x.dtype)


def layernorm(x, g, b):
    xf = x.astype(F32)
    mu = jnp.mean(xf, axis=-1, keepdims=True)
    var = jnp.mean(jnp.square(xf - mu), axis=-1, keepdims=True)
    return ((xf - mu) * lax.rsqrt(var + EPS) * g.astype(F32) + b.astype(F32)).astype(x.dtype)


def swiglu(h, w1, w3, w2):
    return (jax.nn.silu(h @ w1) * (h @ w3)) @ w2


def axial_rope_tables(n_tokens):
    rows = n_tokens // GRID_W
    quarter = SWA_HEAD_DIM // 4
    inv_freq = ROPE_BASE ** (-jnp.arange(quarter, dtype=F32) / quarter)
    row = jnp.repeat(jnp.arange(rows), GRID_W).astype(F32)
    col = jnp.tile(jnp.arange(GRID_W), rows).astype(F32)
    ang_r = row[:, None] * inv_freq
    ang_c = col[:, None] * inv_freq
    ang = jnp.concatenate([ang_r, ang_r, ang_c, ang_c], axis=-1)
    return jnp.cos(ang), jnp.sin(ang)


def apply_axial_rope(x, cos, sin):
    half, quarter = SWA_HEAD_DIM // 2, SWA_HEAD_DIM // 4

    def rot_half(a):
        return jnp.concatenate([-a[..., quarter:], a[..., :quarter]], axis=-1)

    rot = jnp.concatenate([rot_half(x[..., :half]), rot_half(x[..., half:])], axis=-1)
    return (x * cos + rot * sin).astype(x.dtype)


def gla_chunk_scan(q, k, v, g, s0):
    B, H, T, DK = q.shape
    n = T // GLA_CHUNK

    def split(a):
        return a.reshape(B, H, n, GLA_CHUNK, a.shape[-1]).transpose(2, 0, 1, 3, 4)

    mask = jnp.tril(jnp.ones((GLA_CHUNK, GLA_CHUNK), bool))[:, :, None]

    def step(s, inp):
        qc, kc, vc, gc = inp
        b = jnp.cumsum(gc.astype(F32), axis=2)
        o_inter = jnp.einsum('bhik,bhkv->bhiv', qc * jnp.exp(b), s)
        diff = b[:, :, :, None, :] - b[:, :, None, :, :]
        decay = jnp.where(mask, jnp.exp(jnp.where(mask, diff, 0.0)), 0.0)
        att = jnp.einsum('bhik,bhjk,bhijk->bhij', qc, kc, decay)
        o_intra = jnp.einsum('bhij,bhjv->bhiv', att, vc)
        b_last = b[:, :, -1:, :]
        s_new = (jnp.exp(b_last[:, :, 0, :])[..., None] * s
                 + jnp.einsum('bhjk,bhjv->bhkv', kc * jnp.exp(b_last - b), vc))
        return s_new, o_inter + o_intra

    s_fin, o = lax.scan(step, s0, (split(q), split(k), split(v), split(g)))
    return o.transpose(1, 2, 0, 3, 4).reshape(B, H, T, v.shape[-1]), s_fin


def gla_mixer(hx, hc, w_in, wa2, ba, onorm_g, wo, need_ctx):
    B, L, _ = hx.shape
    Lc = hc.shape[1]
    h = jnp.concatenate([hc, hx], axis=1)
    T = Lc + L
    p = h @ w_in
    q, k, v, og, a_f, a_b = jnp.split(
        p, [GLA_DK, 2 * GLA_DK, 2 * GLA_DK + GLA_DV, 2 * GLA_DK + 2 * GLA_DV,
            2 * GLA_DK + 2 * GLA_DV + GLA_RANK], axis=-1)

    def heads(a):
        return a.reshape(B, T, GLA_HEADS, -1).transpose(0, 2, 1, 3)

    q = heads(q) * (GLA_DK_HEAD ** -0.5)
    k, v = heads(k), heads(v)

    def log_decay(a, d):
        return heads(jax.nn.log_sigmoid((a @ wa2[d] + ba[d]).astype(F32)) / GLA_TAU)

    g_f, g_b = log_decay(a_f, 0), log_decay(a_b, 1)
    s0 = jnp.zeros((B, GLA_HEADS, GLA_DK_HEAD, GLA_DV_HEAD), F32)
    o_f, _ = gla_chunk_scan(q, k, v, g_f, s0)

    def rev(a):
        return jnp.concatenate([jnp.flip(a[:, :, :Lc], 2), jnp.flip(a[:, :, Lc:], 2)], axis=2)

    o_b, _ = gla_chunk_scan(rev(q), rev(k), rev(v), rev(g_b), s0)
    o = o_f + rev(o_b)
    o = rmsnorm(o, onorm_g.reshape(GLA_HEADS, 1, GLA_DV_HEAD))
    o = o.transpose(0, 2, 1, 3).reshape(B, T, GLA_DV).astype(hx.dtype) * jax.nn.silu(og)
    yx = o[:, Lc:] @ wo
    yc = (o[:, :Lc] @ wo) if need_ctx else None
    return yx, yc


def sink_softmax(logits, sink):
    s = jnp.broadcast_to(sink.astype(F32).reshape(SWA_KV_HEADS, SWA_GROUP, 1, 1),
                         logits.shape[:-1] + (1,))
    return jax.nn.softmax(jnp.concatenate([s, logits], axis=-1), axis=-1)[..., 1:]


def swa_mixer(hx, hc, w_in, sink, wo, cos, sin, need_ctx):
    B, L, _ = hx.shape
    Lc = hc.shape[1]
    scale = SWA_HEAD_DIM ** -0.5
    nq, nk = SWA_HEADS * SWA_HEAD_DIM, SWA_KV_HEADS * SWA_HEAD_DIM

    def proj(h):
        p = h @ w_in
        n = h.shape[1]
        q = p[..., :nq].reshape(B, n, SWA_KV_HEADS, SWA_GROUP, SWA_HEAD_DIM)
        k = p[..., nq:nq + nk].reshape(B, n, SWA_KV_HEADS, SWA_HEAD_DIM)
        v = p[..., nq + nk:].reshape(B, n, SWA_KV_HEADS, SWA_HEAD_DIM)
        return q, k, v

    qc, kc, vc = proj(hc)
    qx, kx, vx = proj(hx)
    qx = apply_axial_rope(qx, cos[:, None, None, :], sin[:, None, None, :]) * scale
    kx = apply_axial_rope(kx, cos[:, None, :], sin[:, None, :])
    qc = qc * scale

    pad = ((0, 0), (SWA_WINDOW, SWA_WINDOW), (0, 0), (0, 0))
    kx_p, vx_p = jnp.pad(kx, pad), jnp.pad(vx, pad)
    span = SWA_BLOCK + 2 * SWA_WINDOW

    def block(j):
        start = j * SWA_BLOCK
        qb = lax.dynamic_slice_in_dim(qx, start, SWA_BLOCK, axis=1)
        kb = lax.dynamic_slice_in_dim(kx_p, start, span, axis=1)
        vb = lax.dynamic_slice_in_dim(vx_p, start, span, axis=1)
        qpos = start + jnp.arange(SWA_BLOCK)
        kpos = start - SWA_WINDOW + jnp.arange(span)
        valid = ((jnp.abs(qpos[:, None] - kpos[None, :]) <= SWA_WINDOW)
                 & (kpos[None, :] >= 0) & (kpos[None, :] < L))
        lw = jnp.where(valid, jnp.einsum('bqkgd,bskd->bkgqs', qb, kb).astype(F32), NEG_INF)
        lc = jnp.einsum('bqkgd,bskd->bkgqs', qb, kc).astype(F32)
        p = sink_softmax(jnp.concatenate([lc, lw], axis=-1), sink).astype(vb.dtype)
        return (jnp.einsum('bkgqs,bskd->bqkgd', p[..., :Lc], vc)
                + jnp.einsum('bkgqs,bskd->bqkgd', p[..., Lc:], vb))

    o = lax.map(block, jnp.arange(L // SWA_BLOCK))
    o = jnp.moveaxis(o, 0, 1).reshape(B, L, nq)
    yx = o @ wo
    yc = None
    if need_ctx:
        pc = sink_softmax(jnp.einsum('bqkgd,bskd->bkgqs', qc, kc).astype(F32), sink).astype(vc.dtype)
        oc = jnp.einsum('bkgqs,bskd->bqkgd', pc, vc).reshape(B, Lc, nq)
        yc = oc @ wo
    return yx, yc


def gmlp_mixer(h, w_in, ln_g, ln_b, ws, bs, wo):
    B, T, _ = h.shape
    p = jax.nn.gelu(h @ w_in)
    u, v = p[..., :GMLP_WIDTH], p[..., GMLP_WIDTH:]
    v = layernorm(v, ln_g, ln_b)
    vg = v.reshape(B, T // GMLP_CHUNK, GMLP_CHUNK, GMLP_GROUPS, GMLP_GROUP_DIM)
    mixed = jnp.einsum('gij,bnjgc->bnigc', ws, vg) + bs.T[None, None, :, :, None]
    return (u * mixed.reshape(B, T, GMLP_WIDTH)) @ wo


def setup_inputs(seed: int = 0) -> dict:
    key = jax.random.key(seed)
    ks = jax.random.split(key, 26)
    D, F = D_MODEL, D_FF
    nrm = jax.random.normal
    return {
        "x": nrm(ks[0], (BATCH, SEQ, D), F32),
        "c": nrm(ks[1], (BATCH, D), F32),
        "ctx": nrm(ks[2], (BATCH, CTX_LEN, D), F32),
        "c_ctx": nrm(ks[3], (D,), F32),
        "ada_w": nrm(ks[4], (DEPTH, D, 6 * D), F32) * (0.5 * D ** -0.5),
        "ada_b": nrm(ks[5], (DEPTH, 6 * D), F32) * 0.02,
        "norm_g": 1.0 + 0.05 * nrm(ks[6], (DEPTH, 4, D), F32),
        "ffn_w1": nrm(ks[7], (DEPTH, D, F), F32) * D ** -0.5,
        "ffn_w3": nrm(ks[8], (DEPTH, D, F), F32) * D ** -0.5,
        "ffn_w2": nrm(ks[9], (DEPTH, F, D), F32) * F ** -0.5,
        "gla_w_in": nrm(ks[10], (N_A, D, GLA_IN), F32) * D ** -0.5,
        "gla_wa2": nrm(ks[11], (N_A, 2, GLA_RANK, GLA_DK), F32) * GLA_RANK ** -0.5,
        "gla_ba": nrm(ks[12], (N_A, 2, GLA_DK), F32) * 0.1,
        "gla_onorm_g": 1.0 + 0.05 * nrm(ks[13], (N_A, GLA_DV), F32),
        "gla_wo": nrm(ks[14], (N_A, GLA_DV, D), F32) * GLA_DV ** -0.5,
        "attn_w_in": nrm(ks[15], (N_B, D, SWA_IN), F32) * D ** -0.5,
        "attn_sink": nrm(ks[16], (N_B, SWA_HEADS), F32) * 0.5,
        "attn_wo": nrm(ks[17], (N_B, SWA_HEADS * SWA_HEAD_DIM, D), F32) * (SWA_HEADS * SWA_HEAD_DIM) ** -0.5,
        "gmlp_w_in": nrm(ks[18], (N_C, D, 2 * GMLP_WIDTH), F32) * D ** -0.5,
        "gmlp_ln_g": 1.0 + 0.05 * nrm(ks[19], (N_C, GMLP_WIDTH), F32),
        "gmlp_ln_b": 0.02 * nrm(ks[20], (N_C, GMLP_WIDTH), F32),
        "gmlp_ws": nrm(ks[21], (N_C, GMLP_GROUPS, GMLP_CHUNK, GMLP_CHUNK), F32) * GMLP_CHUNK ** -0.5,
        "gmlp_bs": 1.0 + 0.1 * nrm(ks[22], (N_C, GMLP_GROUPS, GMLP_CHUNK), F32),
        "gmlp_wo": nrm(ks[23], (N_C, GMLP_WIDTH, D), F32) * GMLP_WIDTH ** -0.5,
    }


def reference(x, c, ctx, c_ctx, ada_w, ada_b, norm_g, ffn_w1, ffn_w3, ffn_w2,
              gla_w_in, gla_wa2, gla_ba, gla_onorm_g, gla_wo,
              attn_w_in, attn_sink, attn_wo,
              gmlp_w_in, gmlp_ln_g, gmlp_ln_b, gmlp_ws, gmlp_bs, gmlp_wo):
    L = x.shape[1]
    cos, sin = axial_rope_tables(L)
    cx = ctx
    for i in range(DEPTH):
        last = i == DEPTH - 1
        kind, slot = i % N_MIXERS, i // N_MIXERS
        mod_x = (jax.nn.silu(c) @ ada_w[i] + ada_b[i])[:, None, :]
        mod_c = (jax.nn.silu(c_ctx) @ ada_w[i] + ada_b[i])[None, None, :]
        shm, scm, gm, shf, scf, gf = jnp.split(mod_x, 6, axis=-1)
        shm_c, scm_c, gm_c, shf_c, scf_c, gf_c = jnp.split(mod_c, 6, axis=-1)

        hx = rmsnorm(x, norm_g[i, 0]) * (1.0 + scm) + shm
        hc = rmsnorm(cx, norm_g[i, 0]) * (1.0 + scm_c) + shm_c
        if kind == 0:
            yx, yc = gla_mixer(hx, hc, gla_w_in[slot], gla_wa2[slot], gla_ba[slot],
                               gla_onorm_g[slot], gla_wo[slot], not last)
        elif kind == 1:
            yx, yc = swa_mixer(hx, hc, attn_w_in[slot], attn_sink[slot], attn_wo[slot],
                               cos, sin, not last)
        else:
            gp = (gmlp_w_in[slot], gmlp_ln_g[slot], gmlp_ln_b[slot], gmlp_ws[slot],
                  gmlp_bs[slot], gmlp_wo[slot])
            yx = gmlp_mixer(hx, *gp)
            yc = None if last else gmlp_mixer(hc, *gp)
        x = x + gm * rmsnorm(yx, norm_g[i, 1])
        if not last:
            cx = cx + gm_c * rmsnorm(yc, norm_g[i, 1])

        hx = rmsnorm(x, norm_g[i, 2]) * (1.0 + scf) + shf
        x = x + gf * rmsnorm(swiglu(hx, ffn_w1[i], ffn_w3[i], ffn_w2[i]), norm_g[i, 3])
        if not last:
            hc = rmsnorm(cx, norm_g[i, 2]) * (1.0 + scf_c) + shf_c
            cx = cx + gf_c * rmsnorm(swiglu(hc, ffn_w1[i], ffn_w3[i], ffn_w2[i]), norm_g[i, 3])
    return x
```

```cpp
#define MK_ONE_LAUNCH 1
#include <hip/hip_runtime.h>
#include <cstdio>
#include <cstdint>

#define LAS __attribute__((address_space(3)))
#define GAS __attribute__((address_space(1)))

namespace pg8 {
#define PG8_LAS __attribute__((address_space(3)))
typedef unsigned short bf16_t;
typedef short bf16x8 __attribute__((ext_vector_type(8)));
typedef float f32x4 __attribute__((ext_vector_type(4)));
typedef float f32x2 __attribute__((ext_vector_type(2)));
typedef unsigned u32x4 __attribute__((ext_vector_type(4)));
typedef unsigned u32x2 __attribute__((ext_vector_type(2)));
constexpr int BM = 256, BK = 64, HALF = 128, HTB = HALF * BK * 2  , STAGE_BYTES = 8 * HTB, NXCD = 8, WGM = 4;

__host__ __device__ __forceinline__ int lds_byte(int r, int c) { const int st = (r >> 4) * 2 + (c >> 5), rr = r & 15, cc = c & 31, ob = rr * 64 + cc * 2; return st * 1024 + (ob ^ (((ob >> 9) & 1) << 5)); }
__host__ __device__ __forceinline__ void stage_rc(int b, int& R, int& C) { const int st = b / 1024, sb = b % 1024, swz = sb ^ (((sb >> 9) & 1) << 5); R = (st >> 1) * 16 + swz / 64; C = (st & 1) * 32 + (swz % 64) / 2; }
__host__ __device__ __forceinline__ int perm32(int rho) { const int n = rho >> 4, i = rho & 15; return 8 * (i >> 2) + 4 * n + (i & 3); }

struct Unit { int pm, pn, k0, nt, part; };
struct Gemm { const bf16_t* A; const bf16_t* Bt; int M, N, K, ldk; };

struct Sched {
    int nM, nN, nwg, G, c, skip;
    __device__ __forceinline__ void init(int nM_, int nN_, int G_, int c_, int skip_) { nM = nM_; nN = nN_; nwg = nM * nN; G = G_; c = c_; skip = skip_; one = 0; opm = 0; opn = 0; dual = 0; se = 0; so = 0; }
    int one, opm, opn;
    int dual, se, so;
    __device__ __forceinline__ void init_one(bool valid, int pm_, int pn_) { nM = nN = nwg = G = c = skip = 0; dual = 0; se = 0; so = 0; one = valid ? 1 : -1; opm = pm_; opn = pn_; }
    __device__ __forceinline__ bool next(int i, Unit& u) const {
        u.k0 = 0; u.nt = 0; u.part = -1;
        if (one) { if (one < 0 || i > 0) return false; u.pm = opm; u.pn = opn; return true; }
        if (dual && i >= 1) { if (i > 1) return false; const int sl = c & 7; u.pm = 9 * (c >> 6); u.pn = (c >> 3) & 7; u.part = sl; u.nt = (sl & 1) ? so : se; u.k0 = 64 * ((sl >> 1) * (se + so) + (sl & 1) * se); return true; }
        const long L = (long)i * G + c; if (L >= nwg) return false;
        int wgid = (int)L; { const int q = nwg / NXCD, r = nwg % NXCD, xcd = wgid % NXCD, off = wgid / NXCD; wgid = (xcd < r ? xcd * (q + 1) : r * (q + 1) + (xcd - r) * q) + off; }
        const int nig = WGM * nN, gid = wgid / nig, fm = gid * WGM, gsz = (nM - fm) < WGM ? (nM - fm) : WGM;
        int pm = fm + ((wgid % nig) % gsz); u.pn = (wgid % nig) / gsz;
        if (skip) pm = pm + (pm >> 3) + 1;
        u.pm = pm; return true;
    }
    __device__ __forceinline__ void a_ready(const Unit&) const {}
    __device__ __forceinline__ void done(const Unit&) const {}
};

typedef __bf16 bf16x2_t __attribute__((ext_vector_type(2)));
__device__ __forceinline__ unsigned cvt_pk_bf16(float lo, float hi) { const f32x2 v = {lo, hi}; const bf16x2_t b = __builtin_convertvector(v, bf16x2_t); return __builtin_bit_cast(unsigned, b); }
__device__ __forceinline__ float silu_f(float x) { return x * __builtin_amdgcn_rcpf(1.0f + __builtin_amdgcn_exp2f(-1.44269504f * x)); }
__device__ __forceinline__ float gelu_tanh_f(float x) { const float z = 0.7978845608f * (x + 0.044715f * x * x * x); return x * __builtin_amdgcn_rcpf(1.0f + __builtin_amdgcn_exp2f(-2.88539008f * z)); }
__device__ __forceinline__ u32x4 pack8(const f32x4& a, const f32x4& b) { u32x4 w; w.x = cvt_pk_bf16(a[0], a[1]); w.y = cvt_pk_bf16(a[2], a[3]); w.z = cvt_pk_bf16(b[0], b[1]); w.w = cvt_pk_bf16(b[2], b[3]); return w; }
__device__ __forceinline__ u32x2 pack4(const f32x4& a) { u32x2 w; w.x = cvt_pk_bf16(a[0], a[1]); w.y = cvt_pk_bf16(a[2], a[3]); return w; }

struct EpiF32 {
    static constexpr bool PERM = false, AFTER_DRAIN = false;
    float* C; int ldc;
    __device__ __forceinline__ void operator()(const f32x4 (&acc)[2][2][4][2], const Unit& u, int wr, int wc, int fr, int fq) const {
        const int row0 = u.pm * BM + wr * 64 + fr, col0 = u.pn * BM + wc * 32 + 4 * fq;
#pragma unroll
        for (int ai = 0; ai < 2; ++ai)
#pragma unroll
            for (int m = 0; m < 4; ++m) { float* rowp = C + (size_t)(row0 + ai * HALF + m * 16) * ldc + col0;
#pragma unroll
                for (int bj = 0; bj < 2; ++bj)
#pragma unroll
                    for (int n = 0; n < 2; ++n) *(f32x4*)(rowp + bj * HALF + n * 16) = acc[ai][bj][m][n]; }
    }
};
struct EpiY {
    static constexpr bool PERM = true, AFTER_DRAIN = false;
    bf16_t* Y; bf16_t* P; int ldc;
    __device__ __forceinline__ void operator()(const f32x4 (&acc)[2][2][4][2], const Unit& u, int wr, int wc, int fr, int fq) const {
        const int col0 = u.pn * BM + wc * 32 + 8 * fq;
        bf16_t* base; int row0;
        if (u.part >= 0) { base = P + (size_t)u.part * 1024 * ldc; row0 = (u.pm / 9) * BM + wr * 64 + fr; } else { base = Y; row0 = u.pm * BM + wr * 64 + fr; }
#pragma unroll
        for (int ai = 0; ai < 2; ++ai)
#pragma unroll
            for (int m = 0; m < 4; ++m) { bf16_t* rowp = base + (size_t)(row0 + ai * HALF + m * 16) * ldc + col0;
#pragma unroll
                for (int bj = 0; bj < 2; ++bj) *(u32x4*)(rowp + bj * HALF) = pack8(acc[ai][bj][m][0], acc[ai][bj][m][1]); }
    }
};
struct EpiUp {
    static constexpr bool PERM = true, AFTER_DRAIN = false;
    bf16_t* H; int ldc;
    __device__ __forceinline__ void operator()(const f32x4 (&acc)[2][2][4][2], const Unit& u, int wr, int wc, int fr, int fq) const {
        const int row0 = u.pm * BM + wr * 64 + fr, col0 = u.pn * HALF + wc * 32 + 8 * fq;
#pragma unroll
        for (int ai = 0; ai < 2; ++ai)
#pragma unroll
            for (int m = 0; m < 4; ++m) { bf16_t* rowp = H + (size_t)(row0 + ai * HALF + m * 16) * ldc + col0;
                f32x4 v0, v1;
#pragma unroll
                for (int j = 0; j < 4; ++j) { v0[j] = silu_f(acc[ai][0][m][0][j]) * acc[ai][1][m][0][j]; v1[j] = silu_f(acc[ai][0][m][1][j]) * acc[ai][1][m][1][j]; }
                *(u32x4*)rowp = pack8(v0, v1); }
    }
};
struct EpiGlaIn {
    static constexpr bool PERM = true, AFTER_DRAIN = false;
    bf16_t *Q, *K, *V, *OG; float* A32;
    __device__ __forceinline__ void operator()(const f32x4 (&acc)[2][2][4][2], const Unit& u, int wr, int wc, int fr, int fq) const {
        const int row0 = u.pm * BM + wr * 64 + fr, pn = u.pn;
        if (pn == 24) {
            if (wc == 0) {
#pragma unroll
                for (int ai = 0; ai < 2; ++ai)
#pragma unroll
                    for (int m = 0; m < 4; ++m) { float* ap = A32 + (size_t)(row0 + ai * HALF + m * 16) * 32 + 8 * fq; *(f32x4*)ap = acc[ai][0][m][0]; *(f32x4*)(ap + 4) = acc[ai][0][m][1]; }
            }
            return;
        }
        bf16_t* base; int ldc, colt; float sc = 1.0f; bool act = false;
        if (pn < 4) { base = Q; ldc = 1024; colt = pn * BM; sc = 0.0625f; }
        else if (pn < 8) { base = K; ldc = 1024; colt = (pn - 4) * BM; }
        else if (pn < 16) { base = V; ldc = 2048; colt = (pn - 8) * BM; }
        else { base = OG; ldc = 2048; colt = (pn - 16) * BM; act = true; }
        const int col0 = colt + wc * 32 + 8 * fq;
#pragma unroll
        for (int ai = 0; ai < 2; ++ai)
#pragma unroll
            for (int m = 0; m < 4; ++m) { bf16_t* rowp = base + (size_t)(row0 + ai * HALF + m * 16) * ldc + col0;
#pragma unroll
                for (int bj = 0; bj < 2; ++bj) { f32x4 v0 = acc[ai][bj][m][0] * sc, v1 = acc[ai][bj][m][1] * sc;
                    if (act) {
#pragma unroll
                        for (int j = 0; j < 4; ++j) { v0[j] = silu_f(v0[j]); v1[j] = silu_f(v1[j]); } }
                    *(u32x4*)(rowp + bj * HALF) = pack8(v0, v1); } }
    }
};
struct EpiSwaIn {
    static constexpr bool PERM = false, AFTER_DRAIN = false;
    bf16_t *SQ, *SK, *SV; const float* ropeC; const float* ropeS;
    __device__ __forceinline__ void operator()(const f32x4 (&acc)[2][2][4][2], const Unit& u, int wr, int wc, int fr, int fq) const {
        const int row0 = u.pm * BM + wr * 64 + fr, pn = u.pn;
        bf16_t* base; int ldc, colt; float sc = 1.0f; const bool rope = true;
        if (pn < 8) { base = SQ; ldc = 2048; colt = pn * BM; sc = 0.125f * 1.4426950408889634f; }
        else if (pn == 8) { base = SK; ldc = 256; colt = 0; }
        else {
#pragma unroll
            for (int ai = 0; ai < 2; ++ai)
#pragma unroll
                for (int m = 0; m < 4; ++m) { const int row = row0 + ai * HALF + m * 16, b = row / 2304, t = row - b * 2304;
#pragma unroll
                    for (int bj = 0; bj < 2; ++bj)
#pragma unroll
                        for (int n = 0; n < 2; ++n) { const int c0 = bj * HALF + wc * 32 + n * 16 + 4 * fq; const u32x2 w = pack4(acc[ai][bj][m][n]);
                            bf16_t* vp = SV + ((size_t)(b * 4 + (c0 >> 6)) * 64 + (c0 & 63)) * 2304 + t;
                            vp[0] = (bf16_t)(w.x & 0xffffu); vp[2304] = (bf16_t)(w.x >> 16); vp[2 * 2304] = (bf16_t)(w.y & 0xffffu); vp[3 * 2304] = (bf16_t)(w.y >> 16); } }
            return;
        }
        const int col0 = colt + wc * 32 + 4 * fq, half = wc & 1;
#pragma unroll
        for (int ai = 0; ai < 2; ++ai)
#pragma unroll
            for (int m = 0; m < 4; ++m) { const int row = row0 + ai * HALF + m * 16, t = row % 2304; bf16_t* rowp = base + (size_t)row * ldc + col0;
                f32x4 cs = (f32x4){1.f, 1.f, 1.f, 1.f}, sn = (f32x4){0.f, 0.f, 0.f, 0.f};
                if (rope && t >= 256) { const int tl = t - 256, pos = half ? (tl & 63) : (tl >> 6); cs = *(const f32x4*)(ropeC + pos * 16 + 4 * fq); sn = *(const f32x4*)(ropeS + pos * 16 + 4 * fq); }
#pragma unroll
                for (int bj = 0; bj < 2; ++bj) { const f32x4 x0 = acc[ai][bj][m][0], x1 = acc[ai][bj][m][1];
                    const f32x4 o0 = (x0 * cs - x1 * sn) * sc, o1 = (x1 * cs + x0 * sn) * sc;
                    *(u32x2*)(rowp + bj * HALF) = pack4(o0); *(u32x2*)(rowp + bj * HALF + 16) = pack4(o1); } }
    }
};
struct EpiGmlpIn {
    static constexpr bool PERM = true, AFTER_DRAIN = false;
    bf16_t *U, *V;
    __device__ __forceinline__ void operator()(const f32x4 (&acc)[2][2][4][2], const Unit& u, int wr, int wc, int fr, int fq) const {
        const int row0 = u.pm * BM + wr * 64 + fr, pn = u.pn;
        bf16_t* base = pn < 8 ? U : V; const int col0 = (pn & 7) * BM + wc * 32 + 8 * fq;
#pragma unroll
        for (int ai = 0; ai < 2; ++ai)
#pragma unroll
            for (int m = 0; m < 4; ++m) { bf16_t* rowp = base + (size_t)(row0 + ai * HALF + m * 16) * 2048 + col0;
#pragma unroll
                for (int bj = 0; bj < 2; ++bj) { f32x4 v0, v1;
#pragma unroll
                    for (int j = 0; j < 4; ++j) { v0[j] = gelu_tanh_f(acc[ai][bj][m][0][j]); v1[j] = gelu_tanh_f(acc[ai][bj][m][1][j]); }
                    *(u32x4*)(rowp + bj * HALF) = pack8(v0, v1); } }
    }
};

template <class Epi, class Sched, bool ALIGN_EPI = false, bool SP2 = false>
__device__ __forceinline__ void gemm_phase(PG8_LAS unsigned char* lds, const Gemm g, const Sched& S, const Epi& E) {
    int tid_l = threadIdx.x; asm volatile("" : "+v"(tid_l));
    const int tid = tid_l, wid = __builtin_amdgcn_readfirstlane(tid >> 6), lane = tid & 63, wr = wid >> 2, wc = wid & 3, fr = lane & 15, fq = lane >> 4;
    const int K = g.K, nt = K / BK, LDK = g.ldk;
    unsigned voffA[2], voffB[2];
#pragma unroll
    for (int i = 0; i < 2; ++i) { int R, C; stage_rc(tid * 16 + i * 8192, R, C); const int Rb = Epi::PERM ? ((R & ~31) + perm32(R & 31)) : R;
        voffA[i] = (unsigned)(R * LDK + C) * 2u; voffB[i] = (unsigned)(Rb * LDK + C) * 2u; }
    const size_t kstep = (size_t)(BK * 2);
    const size_t hstep = (size_t)HALF * LDK * 2;
    const size_t tstep = 2 * hstep;
    const unsigned ldsw = (unsigned)wid * 1024u;
    const int aoff = lds_byte(wr * 64 + fr, fq * 8), boff = lds_byte(wc * 32 + fr, fq * 8);
#define PG8_SA(b, h) (((b) * 2 + (h)) * HTB)
#define PG8_SB(b, h) ((4 + (b) * 2 + (h)) * HTB)
#define PG8_STAGE(bufoff, gbase, voff) do { _Pragma("unroll") for (int _i = 0; _i < 2; ++_i) \
        __builtin_amdgcn_global_load_lds((const unsigned*)((const char*)(gbase) + (voff)[_i]), (PG8_LAS unsigned*)(lds + (bufoff) + ldsw + _i * 8192), 16, 0, 0); } while (0)
#define PG8_LDA(dst, b, h) do { _Pragma("unroll") for (int m = 0; m < 4; ++m) _Pragma("unroll") for (int k = 0; k < 2; ++k) dst[m][k] = *(const PG8_LAS bf16x8*)(lds + PG8_SA(b, h) + aoff + m * 2048 + k * 1024); } while (0)
#define PG8_LDB(dst, b, h) do { _Pragma("unroll") for (int n = 0; n < 2; ++n) _Pragma("unroll") for (int k = 0; k < 2; ++k) dst[n][k] = *(const PG8_LAS bf16x8*)(lds + PG8_SB(b, h) + boff + n * 2048 + k * 1024); } while (0)
#define PG8_MMA(ai, bj, At, Bt) do { __builtin_amdgcn_s_setprio(1); _Pragma("unroll") for (int m = 0; m < 4; ++m) _Pragma("unroll") for (int n = 0; n < 2; ++n) _Pragma("unroll") for (int k = 0; k < 2; ++k) \
        acc[ai][bj][m][n] = __builtin_amdgcn_mfma_f32_16x16x32_bf16(Bt[n][k], At[m][k], acc[ai][bj][m][n], 0, 0, 0); __builtin_amdgcn_s_setprio(0); } while (0)
#define PG8_WAIT_V(n) asm volatile("s_waitcnt vmcnt(" #n ")" ::: "memory")
#define PG8_WAIT_L(n) asm volatile("s_waitcnt lgkmcnt(" #n ")" ::: "memory")
#define PG8_BAR __builtin_amdgcn_s_barrier()
#define PG8_SCHED __builtin_amdgcn_sched_barrier(0)
    Unit cur, nxt; int ui = 0;
    if (!S.next(0, cur)) return;
    f32x4 acc[2][2][4][2];
#pragma unroll
    for (int a = 0; a < 2; ++a)
#pragma unroll
        for (int b = 0; b < 2; ++b)
#pragma unroll
            for (int m = 0; m < 4; ++m)
#pragma unroll
                for (int n = 0; n < 2; ++n) acc[a][b][m][n] = (f32x4){0.f, 0.f, 0.f, 0.f};
    bf16x8 At[4][2], B0[2][2], B1[2][2];
    const char* cA = (const char*)g.A + (size_t)cur.pm * tstep + (size_t)cur.k0 * 2; const char* cB = (const char*)g.Bt + (size_t)cur.pn * tstep + (size_t)cur.k0 * 2;
    S.a_ready(cur);
    if constexpr (SP2) {
        PG8_STAGE(PG8_SB(0, 0), cB, voffB); PG8_STAGE(PG8_SB(0, 1), cB + hstep, voffB); PG8_STAGE(PG8_SA(0, 0), cA, voffA); PG8_STAGE(PG8_SA(0, 1), cA + hstep, voffA);
        if (wr == 1) PG8_BAR;
        PG8_WAIT_V(2); PG8_BAR;
        PG8_STAGE(PG8_SB(1, 0), cB + kstep, voffB); PG8_STAGE(PG8_SA(1, 0), cA + kstep, voffA); PG8_STAGE(PG8_SB(1, 1), cB + hstep + kstep, voffB);
        PG8_WAIT_V(6); PG8_BAR;
    } else {
        PG8_STAGE(PG8_SB(0, 0), cB, voffB); PG8_STAGE(PG8_SA(0, 0), cA, voffA); PG8_STAGE(PG8_SB(0, 1), cB + hstep, voffB); PG8_STAGE(PG8_SA(0, 1), cA + hstep, voffA);
        if (wr == 1) PG8_BAR;
        PG8_WAIT_V(4); PG8_BAR;
        PG8_STAGE(PG8_SB(1, 0), cB + kstep, voffB); PG8_STAGE(PG8_SA(1, 0), cA + kstep, voffA); PG8_STAGE(PG8_SB(1, 1), cB + hstep + kstep, voffB);
        PG8_WAIT_V(6); PG8_BAR;
    }
    for (;;) {
        const bool has_next = S.next(ui + 1, nxt);
        const char* nA = has_next ? (const char*)g.A + (size_t)nxt.pm * tstep + (size_t)nxt.k0 * 2 : cA; const char* nB = has_next ? (const char*)g.Bt + (size_t)nxt.pn * tstep + (size_t)nxt.k0 * 2 : cB;
        const int unt = cur.nt ? cur.nt : nt;
        for (int t = 0; t < unt; t += 2) {
            const bool last = (t == unt - 2);
            const char* a1 = cA + (size_t)(t + 1) * kstep;
            const char* a2 = last ? nA : cA + (size_t)(t + 2) * kstep; const char* b2 = last ? nB : cB + (size_t)(t + 2) * kstep;
            const char* a3 = a2 + kstep; const char* b3 = b2 + kstep;
            if (last && has_next) S.a_ready(nxt);
            if constexpr (SP2) {
            PG8_LDB(B0, 0, 0); PG8_LDB(B1, 0, 1); PG8_SCHED; PG8_LDA(At, 0, 0); PG8_STAGE(PG8_SA(1, 1), a1 + hstep, voffA);
            PG8_WAIT_V(8); PG8_WAIT_L(0); PG8_BAR; PG8_MMA(0, 0, At, B0); PG8_MMA(0, 1, At, B1); PG8_BAR; PG8_SCHED;
            PG8_LDA(At, 0, 1); PG8_STAGE(PG8_SB(0, 0), b2, voffB); PG8_STAGE(PG8_SB(0, 1), b2 + hstep, voffB); PG8_STAGE(PG8_SA(0, 0), a2, voffA);
            PG8_WAIT_V(8); PG8_WAIT_L(0); PG8_BAR; PG8_MMA(1, 0, At, B0); PG8_MMA(1, 1, At, B1); PG8_BAR; PG8_SCHED;
            PG8_LDB(B0, 1, 0); PG8_LDB(B1, 1, 1); PG8_SCHED; PG8_LDA(At, 1, 0); PG8_STAGE(PG8_SA(0, 1), a2 + hstep, voffA);
            PG8_WAIT_V(8); PG8_WAIT_L(0); PG8_BAR; PG8_MMA(0, 0, At, B0); PG8_MMA(0, 1, At, B1); PG8_BAR; PG8_SCHED;
            PG8_LDA(At, 1, 1); PG8_STAGE(PG8_SB(1, 0), b3, voffB); PG8_STAGE(PG8_SB(1, 1), b3 + hstep, voffB); PG8_STAGE(PG8_SA(1, 0), a3, voffA);
            PG8_WAIT_V(8); PG8_WAIT_L(0); PG8_BAR; PG8_MMA(1, 0, At, B0); PG8_MMA(1, 1, At, B1); PG8_BAR; PG8_SCHED;
            } else {
            PG8_LDB(B0, 0, 0); PG8_SCHED; PG8_LDA(At, 0, 0); PG8_STAGE(PG8_SA(1, 1), a1 + hstep, voffA);
            PG8_WAIT_L(8); PG8_BAR; PG8_WAIT_L(0); PG8_MMA(0, 0, At, B0); PG8_BAR; PG8_SCHED;
            PG8_LDB(B1, 0, 1); PG8_STAGE(PG8_SB(0, 0), b2, voffB);
            PG8_BAR; PG8_WAIT_L(0); PG8_MMA(0, 1, At, B1); PG8_BAR;
            PG8_LDA(At, 0, 1); PG8_STAGE(PG8_SA(0, 0), a2, voffA);
            PG8_BAR; PG8_WAIT_L(0); PG8_MMA(1, 0, At, B0); PG8_BAR; PG8_SCHED;
            PG8_STAGE(PG8_SB(0, 1), b2 + hstep, voffB);
            PG8_WAIT_V(6); PG8_BAR; PG8_MMA(1, 1, At, B1); PG8_BAR;
            PG8_LDB(B0, 1, 0); PG8_SCHED; PG8_LDA(At, 1, 0); PG8_STAGE(PG8_SA(0, 1), a2 + hstep, voffA);
            PG8_WAIT_L(8); PG8_BAR; PG8_WAIT_L(0); PG8_MMA(0, 0, At, B0); PG8_BAR; PG8_SCHED;
            PG8_LDB(B1, 1, 1); PG8_STAGE(PG8_SB(1, 0), b3, voffB);
            PG8_BAR; PG8_WAIT_L(0); PG8_MMA(0, 1, At, B1); PG8_BAR;
            PG8_LDA(At, 1, 1); PG8_STAGE(PG8_SA(1, 0), a3, voffA);
            PG8_BAR; PG8_WAIT_L(0); PG8_MMA(1, 0, At, B0); PG8_BAR; PG8_SCHED;
            PG8_STAGE(PG8_SB(1, 1), b3 + hstep, voffB);
            PG8_WAIT_V(6); PG8_BAR; PG8_MMA(1, 1, At, B1); PG8_BAR;
            }
        }
        if constexpr (ALIGN_EPI) { if (wr == 0) PG8_BAR; }
        if constexpr (!Epi::AFTER_DRAIN) { E(acc, cur, wr, wc, fr, fq); S.done(cur); }
        if (!has_next) break;
#pragma unroll
        for (int a = 0; a < 2; ++a)
#pragma unroll
            for (int b = 0; b < 2; ++b)
#pragma unroll
                for (int m = 0; m < 4; ++m)
#pragma unroll
                    for (int n = 0; n < 2; ++n) acc[a][b][m][n] = (f32x4){0.f, 0.f, 0.f, 0.f};
        cur = nxt; cA = nA; cB = nB; ++ui;
        if constexpr (ALIGN_EPI) { if (wr == 1) PG8_BAR; }
    }
    PG8_WAIT_V(0);
    if constexpr (!ALIGN_EPI) { if (wr == 0) PG8_BAR; }
    PG8_BAR;
    if constexpr (Epi::AFTER_DRAIN) { E.fused(acc, cur, wr, wc, fr, fq, lds, wid, lane); S.done(cur); }
#undef PG8_SA
#undef PG8_SB
#undef PG8_STAGE
#undef PG8_LDA
#undef PG8_LDB
#undef PG8_MMA
#undef PG8_WAIT_V
#undef PG8_WAIT_L
#undef PG8_BAR
#undef PG8_SCHED
}
}

typedef unsigned short bf16;
typedef float f32x4 __attribute__((ext_vector_type(4)));
typedef float f32x2 __attribute__((ext_vector_type(2)));
typedef unsigned u32x4 __attribute__((ext_vector_type(4)));
typedef unsigned u32x2 __attribute__((ext_vector_type(2)));
typedef GAS unsigned gu32;
#define RLX_AGENT __ATOMIC_RELAXED, __HIP_MEMORY_SCOPE_AGENT

constexpr int D = 2048, NB = 4, SEQ = 2048, LC = 256, TT = SEQ + LC, M = NB * TT, FF = 5632, DEPTH = 4;
constexpr int NWAVES = 8, NTHREADS = 512;
constexpr float EPS = 1e-6f;
constexpr int GLA_N = 6176, GLA_NP = 6400, SWA_N = 2560, GM_N = 4096;
static_assert(M == 9216 && M % 256 == 0, "row panels");

constexpr size_t MiB = 1u << 20;
constexpr size_t WS_CTL = 0, CTL_ZERO_BYTES = 1 * MiB;
constexpr size_t WS_MOD = 1 * MiB;
constexpr size_t WS_ROPE = 2 * MiB;
constexpr size_t WS_STAT = 3 * MiB;
constexpr size_t WS_A32 = 4 * MiB;
constexpr size_t WS_W = 8 * MiB;
constexpr size_t WS_FFNW = WS_W, FFNW_STRIDE = 66 * MiB, FFNW_W2 = 44 * MiB;
constexpr size_t WS_GLAW = WS_W + 264 * MiB, GLAW_STRIDE = 33 * MiB, GLAW_WO = 25 * MiB;
constexpr size_t WS_SWAW = WS_GLAW + 66 * MiB, SWAW_WO = 10 * MiB;
constexpr size_t WS_GMW = WS_SWAW + 18 * MiB, GMW_WO = 16 * MiB;
constexpr size_t WS_X = 384 * MiB;
constexpr size_t WS_Y = 456 * MiB;
constexpr size_t WS_HA = 528 * MiB;
constexpr size_t WS_HFF = 564 * MiB;
constexpr size_t WS_MIX = 664 * MiB;
constexpr size_t MIX_GQ = 0, MIX_GK = 18 * MiB, MIX_GV = 36 * MiB, MIX_GOG = 72 * MiB, MIX_GOF = 108 * MiB, MIX_GOB = 144 * MiB;
constexpr size_t MIX_GQT = 180 * MiB, MIX_GKT = 216 * MiB, MIX_GVT = 252 * MiB, MIX_GATT = 288 * MiB, MIX_GDEC = 298 * MiB;
constexpr size_t MIX_SQ = 0, MIX_SK = 36 * MiB, MIX_SV = 41 * MiB;
constexpr size_t MIX_U = 0, MIX_V = 36 * MiB;
constexpr size_t WS_YP = 968 * MiB;
constexpr size_t WS_END = 1000 * MiB;
static_assert(WS_GMW + 24 * MiB <= WS_X && WS_HFF + (size_t)M * FF * 2 <= WS_MIX, "d_ws map");
constexpr int CW_BAR = 4096;

constexpr int RING_BYTES = 131072, LDS_BYTES = 163840, LDSCTL_OFF = LDS_BYTES - 1024, MISC_OFF = LDSCTL_OFF + 320;

#define LDS_WAIT() asm volatile("s_waitcnt lgkmcnt(0)" ::: "memory")
#define VM_WAIT() asm volatile("s_waitcnt vmcnt(0)" ::: "memory")
__device__ __forceinline__ unsigned pk2(float lo, float hi) { return pg8::cvt_pk_bf16(lo, hi); }
__device__ __forceinline__ unsigned f2bf(float f) { return pg8::cvt_pk_bf16(f, 0.f) & 0xffffu; }
__device__ __forceinline__ float bf2f(unsigned short b) { return __builtin_bit_cast(float, (unsigned)b << 16); }
__device__ __forceinline__ float bflo(unsigned u) { return __builtin_bit_cast(float, u << 16); }
__device__ __forceinline__ float bfhi(unsigned u) { return __builtin_bit_cast(float, u & 0xffff0000u); }
__device__ __forceinline__ float wave_sum(float v) {
#pragma unroll
    for (int o = 1; o < 64; o <<= 1) v += __shfl_xor(v, o);
    return v;
}
__device__ __forceinline__ float wave_max(float v) {
#pragma unroll
    for (int o = 1; o < 64; o <<= 1) v = fmaxf(v, __shfl_xor(v, o));
    return v;
}

#define XB_TMO      128
#define XB_XCNT(j)  (256  + 64 * (j))
#define XB_XSUB(j)  (1280 + 64 * (j))
#define XB_XGEN(j)  (2304 + 64 * (j))
#define XB_TOP      3328
#define XB_TOPGEN   3392
#define XCD_BAR_WORDS 3456
#define XB_SPIN_CAP (1u << 18)

__device__ __forceinline__ unsigned xb_ld(unsigned* p)              { return __hip_atomic_load(p, __ATOMIC_RELAXED, __HIP_MEMORY_SCOPE_AGENT); }
__device__ __forceinline__ unsigned xb_add(unsigned* p, unsigned v) { return __hip_atomic_fetch_add(p, v, __ATOMIC_RELAXED, __HIP_MEMORY_SCOPE_AGENT); }
__device__ __forceinline__ unsigned xb_xcc_id() { return (unsigned)__builtin_amdgcn_s_getreg((3 << 11) | 20) & 0xFu; }
#define XB_SPIN(cond, bar) do { unsigned _sp = 0; while (cond) { __builtin_amdgcn_s_sleep(1); \
    if ((++_sp & 255u) == 0u) { if (xb_ld(&(bar)[XB_TMO])) break; if (_sp > XB_SPIN_CAP) { atomicAdd(&(bar)[XB_TMO], 1u); break; } } } } while (0)

struct XcdBarrier {
    unsigned* bar; unsigned x;
    volatile LAS unsigned* st;
};

__device__ __forceinline__ XcdBarrier xcd_barrier_post(unsigned* bar, volatile LAS unsigned* st) {
    XcdBarrier b; b.bar = bar; b.x = xb_xcc_id(); b.st = st;
    if (threadIdx.x == 0) (void)xb_add(&bar[XB_XCNT(b.x)], 1u);
    return b;
}
__device__ __forceinline__ void xcd_barrier_complete(unsigned* bar, unsigned x, unsigned& nloc, unsigned& nx) {
    const unsigned G = gridDim.x * gridDim.y * gridDim.z;
    unsigned sum, cnt, mine, sp = 0u;
    for (;;) {
        sum = 0u; cnt = 0u; mine = 0u;
#pragma unroll
        for (unsigned j = 0; j < 16; ++j) { const unsigned c = xb_ld(&bar[XB_XCNT(j)]); sum += c; cnt += (c > 0u) ? 1u : 0u; mine = (j == x) ? c : mine; }
        if (sum == G) break;
        __builtin_amdgcn_s_sleep(1);
        if ((++sp & 255u) == 0u) { if (xb_ld(&bar[XB_TMO])) break; if (sp > XB_SPIN_CAP) { atomicAdd(&bar[XB_TMO], 1u); break; } }
    }
    nloc = mine > 0u ? mine : 1u; nx = cnt > 0u ? cnt : 1u;
}

__device__ __forceinline__ void xcd_barrier(const XcdBarrier& b) {
    asm volatile("s_waitcnt vmcnt(0)" ::: "memory");
    __syncthreads();
    if (threadIdx.x == 0) {
        unsigned* bar = b.bar;
        __builtin_amdgcn_s_waitcnt(0);
        unsigned nloc = b.st[0], nx = b.st[1];
        if (nloc == 0u) { xcd_barrier_complete(bar, b.x, nloc, nx); b.st[0] = nloc; b.st[1] = nx; }
        const unsigned old = xb_add(&bar[XB_XSUB(b.x)], 1u);
        const unsigned gen = old / nloc;
        if (old + 1u == (gen + 1u) * nloc) {
            __builtin_amdgcn_fence(__ATOMIC_RELEASE, "agent");
            asm volatile("s_waitcnt vmcnt(0)" ::: "memory");
            const unsigned og = xb_add(&bar[XB_TOP], 1u);
            const unsigned tg = og / nx;
            if (og + 1u == (tg + 1u) * nx) xb_add(&bar[XB_TOPGEN], 1u);
            else XB_SPIN(xb_ld(&bar[XB_TOPGEN]) == tg, bar);
            __builtin_amdgcn_fence(__ATOMIC_ACQUIRE, "agent");
            xb_add(&bar[XB_XGEN(b.x)], 1u);
            asm volatile("s_waitcnt vmcnt(0)" ::: "memory");
        } else {
            XB_SPIN(xb_ld(&bar[XB_XGEN(b.x)]) == gen, bar);
            __builtin_amdgcn_fence(__ATOMIC_ACQUIRE, "agent");
            asm volatile("s_waitcnt vmcnt(0)" ::: "memory");
        }
    }
    __syncthreads();
}

struct Args { const float* in[24]; float* out; unsigned char* ws; int ph_lo, ph_hi; };

__device__ __forceinline__ unsigned char* OPQ(unsigned char* p) { asm volatile("" : "+s"(p)); return p; }
__device__ __forceinline__ const float* OPQF(const float* p) { asm volatile("" : "+s"(p)); return p; }
__device__ __forceinline__ const float* input_row(const float* x, const float* ctx, int r) {
    const int b = r / TT, t = r - b * TT;
    return t < LC ? ctx + ((size_t)b * LC + t) * D : x + ((size_t)b * SEQ + (t - LC)) * D;
}

__device__ __forceinline__ void p0_transpose_item(const float* W, int K, int N, bf16* WT, int drow0, int k0, int n0, LAS float* scr, int lane) {
    const int n4 = lane & 15, kr = lane >> 4; const bool ok = (n0 + 4 * n4) < N;
    const float* wp = W + (size_t)(k0 + kr) * N + n0 + 4 * n4;
    f32x4 v[16];
#pragma unroll
    for (int i = 0; i < 16; ++i) v[i] = ok ? __builtin_nontemporal_load((const GAS f32x4*)(wp + (size_t)(4 * i) * N)) : (f32x4){0.f, 0.f, 0.f, 0.f};
#pragma unroll
    for (int i = 0; i < 16; ++i)
#pragma unroll
        for (int q = 0; q < 4; ++q) scr[(4 * i + kr) * 65 + 4 * n4 + q] = v[i][q];
    LDS_WAIT(); asm volatile("" ::: "memory");
    const int c = lane & 7;
#pragma unroll
    for (int jj = 0; jj < 8; ++jj) { const int n = (lane >> 3) + 8 * jj; const LAS float* s = scr + (8 * c) * 65 + n;
        u32x4 o; o.x = pk2(s[0 * 65], s[1 * 65]); o.y = pk2(s[2 * 65], s[3 * 65]); o.z = pk2(s[4 * 65], s[5 * 65]); o.w = pk2(s[6 * 65], s[7 * 65]);
        if (n0 + n < N) *(GAS u32x4*)(WT + (size_t)(drow0 + n) * K + k0 + 8 * c) = o; }
    LDS_WAIT(); asm volatile("" ::: "memory");
}
constexpr int I_FF = 2816, I_FFL = 3 * I_FF, I_GIN = 32 * 97, I_SQ = 32 * 32, I_GLA = I_GIN + I_SQ, I_SWA = 32 * 40 + I_SQ, I_GM = 32 * 64 + I_SQ;
constexpr int IT_G0 = 0, IT_F0 = IT_G0 + I_GLA, IT_SW = IT_F0 + I_FFL, IT_F1 = IT_SW + I_SWA, IT_GM = IT_F1 + I_FFL, IT_F2 = IT_GM + I_GM, IT_G1 = IT_F2 + I_FFL, IT_F3 = IT_G1 + I_GLA, N_TR_ITEMS = IT_F3 + I_FFL;
static_assert(I_FF == (D / 64) * (FF / 64) && I_FF == (FF / 64) * (D / 64) && GLA_N == 96 * 64 + 32 && N_TR_ITEMS == 47424, "transpose items");
#ifndef REACH
#define REACH 0
#endif
#ifndef Q_IN
#define Q_IN 12
#endif
#ifndef Q_WO
#define Q_WO 3
#endif
#ifndef Q_DN
#define Q_DN 5
#endif
#ifndef PROLOGUE_UNTIL
#define PROLOGUE_UNTIL IT_F0
#endif
constexpr int CW_STEAL = 64;
__device__ __forceinline__ int tr_need(int p) {
    if (p < 8) return IT_F0;
    if (p < 9) return IT_F0 + 2 * I_FF;   if (p < 11) return IT_SW;
    if (p < 17) return IT_F1;             if (p < 18) return IT_F1 + 2 * I_FF;   if (p < 20) return IT_GM;
    if (p < 26) return IT_F2;             if (p < 27) return IT_F2 + 2 * I_FF;   if (p < 29) return IT_G1;
    if (p < 35) return IT_F3;             if (p < 36) return IT_F3 + 2 * I_FF;   return N_TR_ITEMS;
}
__device__ __forceinline__ void tr_do_item(const Args& a, int it, LAS float* scr, int lane) {
    unsigned char* ws = OPQ(a.ws);
    int r = it; const float* src; bf16* dst; int K = D, N, nblk, dmode = 0, l = 0; int grp;
    if (r < IT_F0) { grp = 0; l = 0; } else if (r < IT_SW) { grp = 1; l = 0; r -= IT_F0; } else if (r < IT_F1) { grp = 2; r -= IT_SW; } else if (r < IT_GM) { grp = 1; l = 1; r -= IT_F1; }
    else if (r < IT_F2) { grp = 3; r -= IT_GM; } else if (r < IT_G1) { grp = 1; l = 2; r -= IT_F2; } else if (r < IT_F3) { grp = 0; l = 1; r -= IT_G1; } else { grp = 1; l = 3; r -= IT_F3; }
    if (grp == 1) { const int which = r / I_FF; r -= which * I_FF;
        if (which < 2) { src = OPQF(a.in[which ? 8 : 7]) + (size_t)l * D * FF; N = FF; nblk = FF / 64; dst = (bf16*)(ws + WS_FFNW + l * FFNW_STRIDE); dmode = 1 + which; }
        else { src = OPQF(a.in[9]) + (size_t)l * FF * D; K = FF; N = D; nblk = D / 64; dst = (bf16*)(ws + WS_FFNW + l * FFNW_STRIDE + FFNW_W2); } }
    else if (grp == 0) {
        if (r < I_GIN) { src = OPQF(a.in[10]) + (size_t)l * D * GLA_N; N = GLA_N; nblk = 97; dst = (bf16*)(ws + WS_GLAW + l * GLAW_STRIDE); }
        else { r -= I_GIN; src = OPQF(a.in[14]) + (size_t)l * D * D; N = D; nblk = 32; dst = (bf16*)(ws + WS_GLAW + l * GLAW_STRIDE + GLAW_WO); } }
    else if (grp == 2) {
        if (r < 32 * 40) { src = OPQF(a.in[15]); N = SWA_N; nblk = 40; dst = (bf16*)(ws + WS_SWAW); }
        else { r -= 32 * 40; src = OPQF(a.in[17]); N = D; nblk = 32; dst = (bf16*)(ws + WS_SWAW + SWAW_WO); } }
    else {
        if (r < 32 * 64) { src = OPQF(a.in[18]); N = GM_N; nblk = 64; dst = (bf16*)(ws + WS_GMW); }
        else { r -= 32 * 64; src = OPQF(a.in[23]); N = D; nblk = 32; dst = (bf16*)(ws + WS_GMW + GMW_WO); } }
    const int kb = r / nblk, nb = r - kb * nblk, k0 = 64 * kb, n0 = 64 * nb;
    const int drow0 = dmode == 0 ? n0 : ((n0 >> 7) * 256 + (dmode - 1) * 128 + (n0 & 127));
    p0_transpose_item(src, K, N, dst, drow0, k0, n0, scr, lane);
}
__device__ __forceinline__ void tr_pull(const Args& a, LAS unsigned char* lds, int wave, int lane, int until, int max_batches) {
    gu32* ctr = (gu32*)(OPQ(a.ws) + WS_CTL) + CW_STEAL;
    LAS float* scr = (LAS float*)(lds + wave * 16640);
    volatile LAS unsigned* bc = (volatile LAS unsigned*)(lds + MISC_OFF);
    if (until > N_TR_ITEMS) until = N_TR_ITEMS;
    for (int k = 0; k < max_batches; ++k) {
        __syncthreads();
        if (threadIdx.x == 0) { unsigned v = 0xffffffffu; if ((int)__hip_atomic_load(ctr, RLX_AGENT) < until) v = __hip_atomic_fetch_add(ctr, 16u, RLX_AGENT); bc[0] = v; }
        __syncthreads();
        const unsigned base = bc[0];
        if (base == 0xffffffffu || (int)base >= N_TR_ITEMS) break;
#pragma unroll 1
        for (int q = 0; q < 2; ++q) { const int it = (int)base + 8 * q + wave; if (it < N_TR_ITEMS) tr_do_item(a, it, scr, lane); }
    }
}
__device__ __forceinline__ void adaln_unit(const Args& a, LAS unsigned char* lds, int tid, int wave, int lane, int l, int cb) {
    LAS float* SL = (LAS float*)lds;
    LAS float* PART = (LAS float*)(lds + 40960);
    const float* cvec = OPQF(a.in[1]); const float* cctx = OPQF(a.in[3]); const float* ada_w = OPQF(a.in[4]); const float* ada_b = OPQF(a.in[5]);
    float* MOD = (float*)(OPQ(a.ws) + WS_MOD);
    __syncthreads();
    for (int e = tid; e < 5 * D; e += NTHREADS) { const int mi = e / D, k = e - mi * D; const float cv = mi < 4 ? cvec[mi * D + k] : cctx[k]; SL[e] = cv / (1.0f + expf(-cv)); }
    __syncthreads();
    {
        const bool on = lane < 48;
        f32x4 acc[5];
#pragma unroll
        for (int mi = 0; mi < 5; ++mi) acc[mi] = (f32x4){0.f, 0.f, 0.f, 0.f};
        const float* wp = ada_w + ((size_t)l * D + 256 * wave) * (6 * D) + 192 * cb + 4 * (on ? lane : 0);
        const LAS float* sl = SL + 256 * wave;
#pragma unroll 2
        for (int k4 = 0; k4 < 256; k4 += 8) {
            f32x4 wv[8];
#pragma unroll
            for (int q = 0; q < 8; ++q) wv[q] = *(const GAS f32x4*)(wp + (size_t)(k4 + q) * (6 * D));
#pragma unroll
            for (int mi = 0; mi < 5; ++mi) { const f32x4 s4 = *(const LAS f32x4*)(sl + mi * D + k4), s5 = *(const LAS f32x4*)(sl + mi * D + k4 + 4);
#pragma unroll
                for (int q = 0; q < 4; ++q) { acc[mi] += wv[q] * s4[q]; acc[mi] += wv[4 + q] * s5[q]; } }
        }
        if (on) {
#pragma unroll
            for (int mi = 0; mi < 5; ++mi) *(LAS f32x4*)(PART + (wave * 5 + mi) * 192 + 4 * lane) = acc[mi]; }
        __syncthreads();
        for (int e = tid; e < 5 * 192; e += NTHREADS) { const int mi = e / 192, cc = e - mi * 192; float s = ada_b[l * 6 * D + 192 * cb + cc];
#pragma unroll
            for (int w = 0; w < 8; ++w) s += PART[(w * 5 + mi) * 192 + cc];
            MOD[(size_t)(l * 5 + mi) * (6 * D) + 192 * cb + cc] = s; }
        __syncthreads();
    }
}
__device__ __forceinline__ void p0_rope(const Args& a, int tid) {
    float* RC = (float*)(OPQ(a.ws) + WS_ROPE); float* RS = RC + 1024;
    for (int e = tid; e < 1024; e += NTHREADS) {
        const int pos = e >> 4, f = e & 15;
        double inv = 1.0; for (int i = 0; i < f; ++i) inv *= 0.56234132519034908;
        const double x = (double)pos * (double)(float)inv;
        const double twopi = 6.283185307179586476925;
        const double n = __builtin_rint(x * (1.0 / twopi)); const double r = x - n * twopi;
        double s = r, c = 1.0, ts = r, tc = 1.0; const double r2 = r * r;
#pragma unroll
        for (int i = 1; i <= 16; ++i) { tc = -tc * r2 * (1.0 / (double)((2 * i - 1) * (2 * i))); c += tc; ts = -ts * r2 * (1.0 / (double)((2 * i) * (2 * i + 1))); s += ts; }
        RC[e] = (float)c; RS[e] = (float)s;
    }
}

__device__ __forceinline__ void load_row8(const float* p, int lane, f32x4 (&v)[8]) {
#pragma unroll
    for (int j = 0; j < 8; ++j) v[j] = *(const GAS f32x4*)(p + (64 * j + lane) * 4);
}
__device__ __forceinline__ float sumsq8(const f32x4 (&v)[8]) { float s = 0.f;
#pragma unroll
    for (int j = 0; j < 8; ++j) s += (v[j].x * v[j].x + v[j].y * v[j].y) + (v[j].z * v[j].z + v[j].w * v[j].w);
    return s; }
__device__ __forceinline__ void store_h8(bf16* hrow, int lane, const f32x4 (&v)[8]) {
#pragma unroll
    for (int j = 0; j < 8; ++j) { u32x2 w; w.x = pk2(v[j].x, v[j].y); w.y = pk2(v[j].z, v[j].w); *(GAS u32x2*)(hrow + (64 * j + lane) * 4) = w; }
}
__device__ __forceinline__ void wave_rows(int rb, int wave, int& r0, int& nr) { nr = wave < 4 ? 5 : 4; r0 = rb * 36 + (wave < 4 ? 5 * wave : 20 + 4 * (wave - 4)); }

__device__ __forceinline__ void norm0_phase(const Args& a, int wave, int lane, int wg, int G) {
    const float* MOD = (const float*)(OPQ(a.ws) + WS_MOD); const float* ng = OPQF(a.in[6]); bf16* HA = (bf16*)(OPQ(a.ws) + WS_HA);
    for (int rb = wg; rb < 256; rb += G) {
        int r0, nr; wave_rows(rb, wave, r0, nr);
        int cur = -1; f32x4 cB[8], cC[8];
        for (int r = r0; r < r0 + nr; ++r) {
            const int b = r / TT, t = r - b * TT, mi = t < LC ? 4 : b;
            if (mi != cur) { cur = mi; const float* mod = MOD + (size_t)mi * (6 * D); f32x4 g[8], sc[8];
                load_row8(ng, lane, g); load_row8(mod + D, lane, sc); load_row8(mod, lane, cC);
#pragma unroll
                for (int j = 0; j < 8; ++j) cB[j] = g[j] * (1.0f + sc[j]); }
            f32x4 x[8]; load_row8(input_row(OPQF(a.in[0]), OPQF(a.in[2]), r), lane, x);
            const float rs = 1.0f / sqrtf(wave_sum(sumsq8(x)) * (1.0f / D) + EPS);
#pragma unroll
            for (int j = 0; j < 8; ++j) x[j] = x[j] * rs * cB[j] + cC[j];
            store_h8(HA + (size_t)r * D, lane, x);
        }
    }
}
__device__ __forceinline__ void load_xrow(const float* fin, const bf16* Xb, bool from_input, int lane, f32x4 (&x)[8]) {
    if (from_input) load_row8(fin, lane, x);
    else {
#pragma unroll
        for (int j = 0; j < 8; ++j) { const u32x2 w = *(const GAS u32x2*)(Xb + (64 * j + lane) * 4); x[j] = (f32x4){bflo(w.x), bfhi(w.x), bflo(w.y), bfhi(w.y)}; } }
}
template <int WHICH> __device__ __forceinline__ void resid_phase(const Args& a, int l, LAS unsigned char* lds, int tid, int wave, int lane, int wg, int G) {
    const float* MOD = (const float*)(OPQ(a.ws) + WS_MOD); const float* ng = OPQF(a.in[6]);
    bf16* X = (bf16*)(OPQ(a.ws) + WS_X); const bf16* Y = (const bf16*)(OPQ(a.ws) + WS_Y); bf16* HA = (bf16*)(OPQ(a.ws) + WS_HA);
    const bf16* YP = (const bf16*)(OPQ(a.ws) + WS_YP); const float* xin = OPQF(a.in[0]); const float* cin = OPQF(a.in[2]);
    const bool last = (l == DEPTH - 1), final_out = last && WHICH == 1, from_input = (l == 0 && WHICH == 0);
    LAS float* PAR = (LAS float*)lds;
    for (int rb = wg; rb < 256; rb += G) {
        const int bb = (rb * 36) / TT;
        __syncthreads();
#pragma unroll
        for (int slot = 0; slot < 2; ++slot) { const int mi = slot ? bb : 4; const float* mod = MOD + (size_t)(l * 5 + mi) * (6 * D);
            const f32x4 gt = *(const GAS f32x4*)(mod + (WHICH ? 5 : 2) * D + 4 * tid), gy = *(const GAS f32x4*)(ng + (size_t)(l * 4 + (WHICH ? 3 : 1)) * D + 4 * tid);
            *(LAS f32x4*)(PAR + (slot * 3 + 0) * D + 4 * tid) = gt * gy;
            if (!final_out) { const float* gn = WHICH ? ng + (size_t)((l + 1) * 4) * D : ng + (size_t)(l * 4 + 2) * D;
                const float* modn = WHICH ? MOD + (size_t)((l + 1) * 5 + mi) * (6 * D) : mod;
                const f32x4 g = *(const GAS f32x4*)(gn + 4 * tid), sc = *(const GAS f32x4*)(modn + (WHICH ? 1 : 4) * D + 4 * tid), sh = *(const GAS f32x4*)(modn + (WHICH ? 0 : 3) * D + 4 * tid);
                *(LAS f32x4*)(PAR + (slot * 3 + 1) * D + 4 * tid) = g * (1.0f + sc); *(LAS f32x4*)(PAR + (slot * 3 + 2) * D + 4 * tid) = sh; } }
        __syncthreads();
        int r0, nr; wave_rows(rb, wave, r0, nr);
        f32x4 x[8], xn[8]; u32x2 yb[8], ybn[8];
        { const int r = r0; const int b = r / TT, t = r - b * TT;
          load_xrow(from_input ? input_row(xin, cin, r) : nullptr, X + (size_t)r * D, from_input, lane, x);
          if (t >= LC) {
#pragma unroll
              for (int j = 0; j < 8; ++j) yb[j] = *(const GAS u32x2*)(Y + (size_t)r * D + (64 * j + lane) * 4); } }
#pragma unroll 1
        for (int r = r0; r < r0 + nr; ++r) {
            const int b = r / TT, t = r - b * TT;
            if (r + 1 < r0 + nr) { const int rn = r + 1, bn = rn / TT, tn = rn - bn * TT;
                load_xrow(from_input ? input_row(xin, cin, rn) : nullptr, X + (size_t)rn * D, from_input, lane, xn);
                if (tn >= LC) {
#pragma unroll
                    for (int j = 0; j < 8; ++j) ybn[j] = *(const GAS u32x2*)(Y + (size_t)rn * D + (64 * j + lane) * 4); } }
            if (!(last && t < LC)) {
            const LAS float* par = PAR + (t < LC ? 0 : 3 * D);
            f32x4 y[8];
            if (t < LC) { const bf16* yp = YP + (size_t)(b * LC + t) * D;
#pragma unroll
                for (int j = 0; j < 8; ++j) y[j] = (f32x4){0.f, 0.f, 0.f, 0.f};
#pragma unroll
                for (int sl = 0; sl < 8; ++sl) {
#pragma unroll
                    for (int j = 0; j < 8; ++j) { const u32x2 w = *(const GAS u32x2*)(yp + (size_t)sl * (NB * LC) * D + (64 * j + lane) * 4); y[j] += (f32x4){bflo(w.x), bfhi(w.x), bflo(w.y), bfhi(w.y)}; } } }
            else {
#pragma unroll
                for (int j = 0; j < 8; ++j) y[j] = (f32x4){bflo(yb[j].x), bfhi(yb[j].x), bflo(yb[j].y), bfhi(yb[j].y)}; }
            const float rs = 1.0f / sqrtf(wave_sum(sumsq8(y)) * (1.0f / D) + EPS);
#pragma unroll
            for (int j = 0; j < 8; ++j) x[j] = x[j] + *(const LAS f32x4*)(par + (64 * j + lane) * 4) * (y[j] * rs);
            if (final_out) { float* xd = a.out + ((size_t)b * SEQ + (t - LC)) * D;
#pragma unroll
                for (int j = 0; j < 8; ++j) *(GAS f32x4*)(xd + (64 * j + lane) * 4) = x[j]; }
            else {
                store_h8(X + (size_t)r * D, lane, x);
                const float rs2 = 1.0f / sqrtf(wave_sum(sumsq8(x)) * (1.0f / D) + EPS);
#pragma unroll
                for (int j = 0; j < 8; ++j) x[j] = x[j] * rs2 * *(const LAS f32x4*)(par + D + (64 * j + lane) * 4) + *(const LAS f32x4*)(par + 2 * D + (64 * j + lane) * 4);
                store_h8(HA + (size_t)r * D, lane, x);
            }
            }
#pragma unroll
            for (int j = 0; j < 8; ++j) { x[j] = xn[j]; yb[j] = ybn[j]; }
        }
    }
}

typedef float f32x16 __attribute__((ext_vector_type(16)));
typedef short bf16x8v __attribute__((ext_vector_type(8)));
constexpr int GL_ST = 528;
__device__ __forceinline__ float log_sigmoid_f(float z) { return fminf(z, 0.f) - __logf(1.0f + __expf(-fabsf(z))); }
template <int DIR> __device__ __forceinline__ void gla_prep_unit(const Args& a, int slot, int u, LAS unsigned char* lds, int tid, int wave, int lane) {
    LAS float* As = (LAS float*)lds;
    LAS float* TOT = (LAS float*)(lds + 4096);
    LAS unsigned char* Qs = lds + 8192;
    LAS unsigned char* Ks = lds + 8192 + 64 * GL_ST;
    LAS unsigned char* Vs = lds + 8192 + 128 * GL_ST;
    const bf16* Q = (const bf16*)(OPQ(a.ws) + WS_MIX + MIX_GQ); const bf16* Kb = (const bf16*)(OPQ(a.ws) + WS_MIX + MIX_GK); const bf16* V = (const bf16*)(OPQ(a.ws) + WS_MIX + MIX_GV);
    bf16* QT = (bf16*)(OPQ(a.ws) + WS_MIX + MIX_GQT); bf16* KT = (bf16*)(OPQ(a.ws) + WS_MIX + MIX_GKT); bf16* VT = (bf16*)(OPQ(a.ws) + WS_MIX + MIX_GVT); bf16* ATT = (bf16*)(OPQ(a.ws) + WS_MIX + MIX_GATT); float* DEC = (float*)(OPQ(a.ws) + WS_MIX + MIX_GDEC);
    const float* A32 = (const float*)(OPQ(a.ws) + WS_A32);
    const int c = (u >> 1) % 36, bh = (u >> 1) / 36, h = bh & 3, b = bh >> 2;
    const size_t row0 = (size_t)b * TT + 64 * c;
    const int kk = tid & 255, hf = tid >> 8;
    __syncthreads();
    for (int e = tid; e < 1024; e += NTHREADS) As[e] = A32[(row0 + (e >> 4)) * 32 + 16 * DIR + (e & 15)];
#pragma unroll
    for (int q = 0; q < 4; ++q) { const int e = tid + NTHREADS * q, i = e >> 5, ch = e & 31; *(LAS u32x4*)(Vs + i * GL_ST + 16 * ch) = *(const GAS u32x4*)(V + (row0 + i) * 2048 + h * 512 + 256 * DIR + 8 * ch); }
    unsigned short qraw[32], kraw[32];
    { const bf16* qp = Q + (row0 + 32 * hf) * 1024 + h * 256 + kk; const bf16* kp = Kb + (row0 + 32 * hf) * 1024 + h * 256 + kk;
#pragma unroll
      for (int p = 0; p < 32; ++p) { qraw[p] = qp[(size_t)p * 1024]; kraw[p] = kp[(size_t)p * 1024]; } }
    const float bias = OPQF(a.in[12])[(size_t)(slot * 2 + DIR) * 1024 + h * 256 + kk];
    LAS float* Zs = (LAS float*)(lds + 8192);
    float bq[2][4];
    { const float* wp = OPQF(a.in[11]) + (size_t)(slot * 2 + DIR) * 16 * 1024 + h * 256 + (lane & 15);
#pragma unroll
      for (int t2 = 0; t2 < 2; ++t2)
#pragma unroll
          for (int ks = 0; ks < 4; ++ks) bq[t2][ks] = wp[(size_t)(4 * ks + (lane >> 4)) * 1024 + 16 * (2 * wave + t2)]; }
    __syncthreads();
#pragma unroll
    for (int tm = 0; tm < 4; ++tm) { float aq[4];
#pragma unroll
        for (int ks = 0; ks < 4; ++ks) aq[ks] = As[(16 * tm + (lane & 15)) * 16 + 4 * ks + (lane >> 4)];
#pragma unroll
        for (int t2 = 0; t2 < 2; ++t2) { f32x4 zc = (f32x4){0.f, 0.f, 0.f, 0.f};
#pragma unroll
            for (int ks = 0; ks < 4; ++ks) zc = __builtin_amdgcn_mfma_f32_16x16x4f32(aq[ks], bq[t2][ks], zc, 0, 0, 0);
#pragma unroll
            for (int r = 0; r < 4; ++r) Zs[(16 * tm + 4 * (lane >> 4) + r) * 256 + 16 * (2 * wave + t2) + (lane & 15)] = zc[r]; } }
    __syncthreads();
    float lc[32]; float run = 0.f;
#pragma unroll
    for (int s = 0; s < 32; ++s) { const int p = DIR ? 31 - s : s, i = 32 * hf + p; const float z = bias + Zs[i * 256 + kk];
        run += log_sigmoid_f(z) * 0.0625f; lc[p] = run; }
    TOT[hf * 256 + kk] = run;
    __syncthreads();
    const float tot0 = TOT[kk], tot1 = TOT[256 + kk];
    const float off = DIR ? (hf == 0 ? tot1 : 0.f) : (hf == 1 ? tot0 : 0.f);
    const float dec = expf(tot0 + tot1);
    {
#pragma unroll
      for (int p = 0; p < 32; ++p) { const int i = 32 * hf + p; const float bb = lc[p] + off, eb = __expf(bb), ebi = __expf(-bb);
        const float qv = bf2f(qraw[p]), kv = bf2f(kraw[p]);
        const unsigned short qt = (unsigned short)f2bf(qv * eb); *(LAS unsigned short*)(Qs + i * GL_ST + 2 * kk) = qt;
        const float kh = kv * ebi; *(LAS unsigned short*)(Ks + i * GL_ST + 2 * kk) = (unsigned short)f2bf(kh); lc[p] = kh * dec; } }
#pragma unroll
    for (int g = 0; g < 4; ++g) { u32x4 o;
#pragma unroll
        for (int q = 0; q < 4; ++q) o[q] = pk2(lc[8 * g + 2 * q], lc[8 * g + 2 * q + 1]);
        *(GAS u32x4*)(KT + ((size_t)u * 256 + kk) * 64 + 32 * hf + 8 * g) = o; }
    if (hf == 0) DEC[(size_t)u * 256 + kk] = dec;
    __syncthreads();
#pragma unroll
    for (int q = 0; q < 4; ++q) { const int e = tid + NTHREADS * q, i = e >> 5, ch = e & 31; *(GAS u32x4*)(QT + ((size_t)u * 64 + i) * 256 + 8 * ch) = *(const LAS u32x4*)(Qs + i * GL_ST + 16 * ch); }
    { const int tr = wave >> 1, tc0 = (wave & 1) * 2, l15 = lane & 15, kq = lane >> 4;
      f32x4 acc[2] = {(f32x4){0.f, 0.f, 0.f, 0.f}, (f32x4){0.f, 0.f, 0.f, 0.f}};
#pragma unroll
      for (int s = 0; s < 8; ++s) { const bf16x8v af = *(const LAS bf16x8v*)(Qs + (16 * tr + l15) * GL_ST + (32 * s + 8 * kq) * 2);
#pragma unroll
          for (int t2 = 0; t2 < 2; ++t2) { const bf16x8v bfr = *(const LAS bf16x8v*)(Ks + (16 * (tc0 + t2) + l15) * GL_ST + (32 * s + 8 * kq) * 2);
              acc[t2] = __builtin_amdgcn_mfma_f32_16x16x32_bf16(af, bfr, acc[t2], 0, 0, 0); } }
#pragma unroll
      for (int t2 = 0; t2 < 2; ++t2)
#pragma unroll
          for (int r = 0; r < 4; ++r) { const int i = 16 * tr + 4 * kq + r, j = 16 * (tc0 + t2) + l15; const bool keep = DIR ? (j >= i) : (j <= i);
              ATT[((size_t)u * 64 + i) * 64 + j] = (bf16)f2bf(keep ? acc[t2][r] : 0.f); } }
    { bf16* vt = VT + ((size_t)(u >> 1) * 512 + 256 * DIR + kk) * 64 + 32 * hf;
#pragma unroll
      for (int g = 0; g < 4; ++g) { u32x4 o;
#pragma unroll
          for (int q = 0; q < 4; ++q) { const int i = 32 * hf + 8 * g + 2 * q;
              o[q] = (unsigned)*(const LAS unsigned short*)(Vs + i * GL_ST + 2 * kk) | ((unsigned)*(const LAS unsigned short*)(Vs + (i + 1) * GL_ST + 2 * kk) << 16); }
          *(GAS u32x4*)(vt + 8 * g) = o; } }
}
__device__ __forceinline__ void gla_prep_phase(const Args& a, int slot, LAS unsigned char* lds, int tid, int wave, int lane, int wg, int G) {
    for (int u = wg; u < 1152; u += G) { if (u & 1) gla_prep_unit<1>(a, slot, u, lds, tid, wave, lane); else gla_prep_unit<0>(a, slot, u, lds, tid, wave, lane); }
}
constexpr int GS_VST = 144, GS_STB = 64 * GL_ST, GS_VSB = 64 * GS_VST;
struct ScanB { bf16x8v Qf[8], Af[2]; };
struct ScanC { bf16x8v Kf[2][4]; };
__device__ __forceinline__ int scan_chunk(int dir, int n) { return dir ? (n < 4 ? 3 - n : 39 - n) : n; }
__device__ __forceinline__ void scan_load_b(ScanB& o, const bf16* QT, const bf16* ATT, size_t u, int wave, int l15, int kq) {
#pragma unroll
    for (int s = 0; s < 8; ++s) o.Qf[s] = *(const GAS bf16x8v*)(QT + (u * 64 + 16 * wave + l15) * 256 + 32 * s + 8 * kq);
#pragma unroll
    for (int s = 0; s < 2; ++s) o.Af[s] = *(const GAS bf16x8v*)(ATT + (u * 64 + 16 * wave + l15) * 64 + 32 * s + 8 * kq);
}
__device__ __forceinline__ void scan_load_c(ScanC& o, const bf16* KT, size_t u, int cw, int r32, int hi) {
#pragma unroll
    for (int mt = 0; mt < 2; ++mt)
#pragma unroll
        for (int s = 0; s < 4; ++s) o.Kf[mt][s] = *(const GAS bf16x8v*)(KT + (u * 256 + 64 * cw + 32 * mt + r32) * 64 + 16 * s + 8 * hi);
}
__device__ __forceinline__ void scan_part_o(const ScanB& o, LAS unsigned char* os, const LAS unsigned char* stp, const LAS unsigned char* vs, int wave, int l15, int kq) {
    f32x4 oacc[4];
#pragma unroll
    for (int t4 = 0; t4 < 4; ++t4) oacc[t4] = (f32x4){0.f, 0.f, 0.f, 0.f};
    bf16x8v bfr[2][4];
#pragma unroll
    for (int t4 = 0; t4 < 4; ++t4) bfr[0][t4] = *(const LAS bf16x8v*)(stp + (16 * t4 + l15) * GL_ST + (8 * kq) * 2);
#pragma unroll
    for (int g = 0; g < 10; ++g) {
        if (g + 1 < 10) { const int s = g + 1;
#pragma unroll
            for (int t4 = 0; t4 < 4; ++t4) bfr[(g + 1) & 1][t4] = s < 8 ? *(const LAS bf16x8v*)(stp + (16 * t4 + l15) * GL_ST + (32 * s + 8 * kq) * 2)
                                                                         : *(const LAS bf16x8v*)(vs + (16 * t4 + l15) * GS_VST + (32 * (s - 8) + 8 * kq) * 2); }
#pragma unroll
        for (int t4 = 0; t4 < 4; ++t4) oacc[t4] = __builtin_amdgcn_mfma_f32_16x16x32_bf16(g < 8 ? o.Qf[g] : o.Af[g - 8], bfr[g & 1][t4], oacc[t4], 0, 0, 0);
    }
#pragma unroll
    for (int t4 = 0; t4 < 4; ++t4)
#pragma unroll
        for (int r = 0; r < 4; ++r) *(LAS unsigned short*)(os + (16 * wave + 4 * kq + r) * GS_VST + (16 * t4 + l15) * 2) = (unsigned short)f2bf(oacc[t4][r]);
}
__device__ __forceinline__ void scan_part_s(const ScanC& oc, f32x16 (&S)[2][2], LAS unsigned char* stn, const LAS unsigned char* vs, const LAS float* decs, int cw, int r32, int hi) {
    bf16x8v vfr[4][2];
#pragma unroll
    for (int s = 0; s < 4; ++s)
#pragma unroll
        for (int nt = 0; nt < 2; ++nt) vfr[s][nt] = *(const LAS bf16x8v*)(vs + (32 * nt + r32) * GS_VST + (16 * s + 8 * hi) * 2);
#pragma unroll
    for (int mt = 0; mt < 2; ++mt)
#pragma unroll
        for (int g = 0; g < 4; ++g) { const f32x4 dc = *(const LAS f32x4*)(decs + 64 * cw + 32 * mt + 8 * g + 4 * hi);
#pragma unroll
            for (int nt = 0; nt < 2; ++nt)
#pragma unroll
                for (int q = 0; q < 4; ++q) S[mt][nt][4 * g + q] *= dc[q]; }
#pragma unroll
    for (int s = 0; s < 4; ++s)
#pragma unroll
        for (int mt = 0; mt < 2; ++mt)
#pragma unroll
            for (int nt = 0; nt < 2; ++nt) S[mt][nt] = __builtin_amdgcn_mfma_f32_32x32x16_bf16(oc.Kf[mt][s], vfr[s][nt], S[mt][nt], 0, 0, 0);
#pragma unroll
    for (int mt = 0; mt < 2; ++mt)
#pragma unroll
        for (int nt = 0; nt < 2; ++nt)
#pragma unroll
            for (int g = 0; g < 4; ++g) { u32x2 w2; w2.x = pg8::cvt_pk_bf16(S[mt][nt][4 * g], S[mt][nt][4 * g + 1]); w2.y = pg8::cvt_pk_bf16(S[mt][nt][4 * g + 2], S[mt][nt][4 * g + 3]);
                *(LAS u32x2*)(stn + (32 * nt + r32) * GL_ST + (64 * cw + 32 * mt + 8 * g + 4 * hi) * 2) = w2; }
}
__device__ __forceinline__ void scan_flush_o(const LAS unsigned char* os, bf16* O, int b, int h, int c, int dvs, int tid) {
    const u32x4 v = *(const LAS u32x4*)(os + (tid >> 3) * GS_VST + 16 * (tid & 7));
    bf16* op = O + ((size_t)b * TT + 64 * c + (tid >> 3)) * 2048 + h * 512 + 64 * dvs + 8 * (tid & 7);
    asm volatile("s_waitcnt lgkmcnt(0)\n\tglobal_store_dwordx4 %0, %1, off\n\ts_nop 2" :: "v"(op), "v"(v) : "memory");
}
template <bool OW> __device__ __forceinline__ void gla_scan_body(const Args& a, LAS unsigned char* lds, int tid, int wave, int lane, int wg, int G) {
    const bf16* QT = (const bf16*)(OPQ(a.ws) + WS_MIX + MIX_GQT); const bf16* KT = (const bf16*)(OPQ(a.ws) + WS_MIX + MIX_GKT); const bf16* VT = (const bf16*)(OPQ(a.ws) + WS_MIX + MIX_GVT);
    const bf16* ATT = (const bf16*)(OPQ(a.ws) + WS_MIX + MIX_GATT); const float* DEC = (const float*)(OPQ(a.ws) + WS_MIX + MIX_GDEC);
    LAS unsigned char* ST = lds; LAS unsigned char* Vs = lds + 2 * GS_STB; LAS unsigned char* Os = lds + 2 * GS_STB + 2 * GS_VSB; LAS float* DECs = (LAS float*)(lds + 2 * GS_STB + 4 * GS_VSB);
    const int l15 = lane & 15, kq = lane >> 4, r32 = lane & 31, hi = lane >> 5, cw = wave & 3;
    const int vso = (tid >> 3) * GS_VST + 16 * (tid & 7);
    for (int item = wg; item < 256; item += G) {
        const int dvs = (item >> 3) & 7, combo = (item & 7) * 4 + (item >> 6), dir = combo & 1, h = (combo >> 1) & 3, b = combo >> 3, bh = b * 4 + h;
        bf16* O = (bf16*)(OPQ(a.ws) + WS_MIX + (dir ? MIX_GOB : MIX_GOF));
        __syncthreads();
        for (int e = tid; e < GS_STB / 16; e += NTHREADS) *(LAS u32x4*)(ST + GS_STB + 16 * e) = (u32x4){0u, 0u, 0u, 0u};
        f32x16 S[2][2];
#pragma unroll
        for (int mt = 0; mt < 2; ++mt)
#pragma unroll
            for (int nt = 0; nt < 2; ++nt)
#pragma unroll
                for (int i = 0; i < 16; ++i) S[mt][nt][i] = 0.f;
        ScanB BA, BB; ScanC CA, CB; u32x4 vA, vB; f32x4 dA = (f32x4){0.f, 0.f, 0.f, 0.f}, dB = dA;
#define SCAN_BAR() do { asm volatile("s_waitcnt lgkmcnt(0)" ::: "memory"); __builtin_amdgcn_s_barrier(); asm volatile("" ::: "memory"); } while (0)
#define SCAN_LOAD(BS, CS, vr, dr, n_) do { const int c_ = scan_chunk(dir, (n_)); const size_t uv_ = (size_t)bh * 36 + c_, u_ = uv_ * 2 + dir; \
            vr = *(const GAS u32x4*)(VT + (uv_ * 512 + 64 * dvs + (tid >> 3)) * 64 + 8 * (tid & 7)); if (tid < 64) dr = *(const GAS f32x4*)(DEC + u_ * 256 + 4 * tid); \
            if constexpr (OW) scan_load_b(BS, QT, ATT, u_, wave, l15, kq); else scan_load_c(CS, KT, u_, cw, r32, hi); } while (0)
#define SCAN_STAGE(vr, dr, buf) do { *(LAS u32x4*)(Vs + (buf) * GS_VSB + vso) = vr; if (tid < 64) *(LAS f32x4*)(DECs + (buf) * 256 + 4 * tid) = dr; } while (0)
#define SCAN_STEP(BS, CS, n_) do { const int n__ = (n_); if constexpr (OW) scan_part_o(BS, Os + (n__ & 1) * GS_VSB, ST + ((n__ + 1) & 1) * GS_STB, Vs + (n__ & 1) * GS_VSB, wave, l15, kq); \
            else scan_part_s(CS, S, ST + (n__ & 1) * GS_STB, Vs + (n__ & 1) * GS_VSB, DECs + (n__ & 1) * 256, cw, r32, hi); } while (0)
        SCAN_LOAD(BA, CA, vA, dA, 0);
        SCAN_STAGE(vA, dA, 0);
        SCAN_LOAD(BB, CB, vB, dB, 1);
        SCAN_BAR();
#pragma unroll 1
        for (int n = 0; n < 36; n += 2) {
            SCAN_STEP(BA, CA, n);
            SCAN_STAGE(vB, dB, 1);
            if (n > 0) scan_flush_o(Os + GS_VSB, O, b, h, scan_chunk(dir, n - 1), dvs, tid);
            SCAN_LOAD(BA, CA, vA, dA, n + 2 < 36 ? n + 2 : 35);
            SCAN_BAR();
            SCAN_STEP(BB, CB, n + 1);
            SCAN_STAGE(vA, dA, 0);
            scan_flush_o(Os, O, b, h, scan_chunk(dir, n), dvs, tid);
            SCAN_LOAD(BB, CB, vB, dB, n + 3 < 36 ? n + 3 : 35);
            SCAN_BAR();
        }
        scan_flush_o(Os + GS_VSB, O, b, h, scan_chunk(dir, 35), dvs, tid);
#undef SCAN_BAR
#undef SCAN_LOAD
#undef SCAN_STAGE
#undef SCAN_STEP
    }
}
__device__ __forceinline__ void gla_scan_phase(const Args& a, LAS unsigned char* lds, int tid, int wave, int lane, int wg, int G) {
    if (wave < 4) gla_scan_body<true>(a, lds, tid, wave, lane, wg, G); else gla_scan_body<false>(a, lds, tid, wave, lane, wg, G);
}
__device__ __forceinline__ void gla_onorm_phase(const Args& a, int slot, bool skip_ctx, int lane, int gw, int ngw) {
    const bf16* OF = (const bf16*)(OPQ(a.ws) + WS_MIX + MIX_GOF); const bf16* OB = (const bf16*)(OPQ(a.ws) + WS_MIX + MIX_GOB); const bf16* OG = (const bf16*)(OPQ(a.ws) + WS_MIX + MIX_GOG);
    const float* og_g = OPQF(a.in[13]) + (size_t)slot * D; bf16* HA = (bf16*)(OPQ(a.ws) + WS_HA);
    for (int r = gw; r < M; r += ngw) {
        if (skip_ctx && (r % TT) < LC) continue;
#pragma unroll
        for (int hh = 0; hh < 4; ++hh) {
            const size_t off = (size_t)r * D + hh * 512 + 8 * lane;
            const u32x4 f = *(const GAS u32x4*)(OF + off), bk = *(const GAS u32x4*)(OB + off), g = *(const GAS u32x4*)(OG + off);
            float o[8];
#pragma unroll
            for (int q = 0; q < 4; ++q) { o[2 * q] = bflo(f[q]) + bflo(bk[q]); o[2 * q + 1] = bfhi(f[q]) + bfhi(bk[q]); }
            float ss = 0.f;
#pragma unroll
            for (int q = 0; q < 8; ++q) ss += o[q] * o[q];
            const float rs = 1.0f / sqrtf(wave_sum(ss) * (1.0f / 512.0f) + EPS);
            const f32x4 w0 = *(const GAS f32x4*)(og_g + hh * 512 + 8 * lane), w1 = *(const GAS f32x4*)(og_g + hh * 512 + 8 * lane + 4);
            u32x4 w;
#pragma unroll
            for (int q = 0; q < 4; ++q) { const float wa = q < 2 ? w0[2 * q] : w1[2 * q - 4], wb = q < 2 ? w0[2 * q + 1] : w1[2 * q - 3];
                w[q] = pk2(o[2 * q] * rs * wa * bflo(g[q]), o[2 * q + 1] * rs * wb * bfhi(g[q])); }
            *(GAS u32x4*)(HA + off) = w;
        }
    }
}

constexpr int ATT_KST = 144, ATT_VST = 136, ATT_KB = 64 * ATT_KST, ATT_VB = 64 * ATT_VST;
__device__ __forceinline__ void swa_attn_phase(const Args& a, bool skip_ctx, LAS unsigned char* lds, int tid, int wave, int lane, int wg, int G) {
    const bf16* SQ = (const bf16*)(OPQ(a.ws) + WS_MIX + MIX_SQ); const bf16* SK = (const bf16*)(OPQ(a.ws) + WS_MIX + MIX_SK); const bf16* SVT = (const bf16*)(OPQ(a.ws) + WS_MIX + MIX_SV);
    const float* sink = OPQF(a.in[16]); bf16* HA = (bf16*)(OPQ(a.ws) + WS_HA);
    LAS unsigned char* Kb = lds; LAS unsigned char* Vb = lds + 2 * ATT_KB;
    const int r32 = lane & 31, hi = lane >> 5, srow = tid >> 3, sch = tid & 7;
    const int nunits = skip_ctx ? 512 : 576;
    for (int ui = wg; ui < nunits; ui += G) {
        const bool lat = ui < 512;
        int b, kvh, qb; { const int w = ui & 255, x = w & 7, s = w >> 3;
            if (lat) { const int combo = 2 * x + (ui >> 8); b = combo >> 2; kvh = combo & 3; qb = s; }
            else { const int combo = 2 * x + (s & 1); b = combo >> 2; kvh = combo & 3; qb = (s >> 1) & 3; } }
        const int head = kvh * 8 + wave;
        const int tq0 = lat ? LC + 64 * qb : 64 * qb;
        const int w_lo = qb - 2 < 0 ? 0 : qb - 2, w_hi = qb + 2 > 31 ? 31 : qb + 2;
        const int ntile = lat ? 4 + (w_hi - w_lo + 1) : 4;
        const bf16* kbase = SK + (size_t)b * TT * 256 + kvh * 64 + (size_t)srow * 256 + 8 * sch;
        const bf16* vbase = SVT + ((size_t)(b * 4 + kvh) * 64 + srow) * TT + 8 * sch;
        bf16x8v Qf[2][4];
#pragma unroll
        for (int nt = 0; nt < 2; ++nt)
#pragma unroll
            for (int ks = 0; ks < 4; ++ks) Qf[nt][ks] = *(const GAS bf16x8v*)(SQ + ((size_t)b * TT + tq0 + 32 * nt + r32) * D + head * 64 + 16 * ks + 8 * hi);
        const float sink2 = sink[head] * 1.4426950408889634f;
        float m2[2] = {sink2, sink2}, ls[2] = {hi ? 0.f : 1.f, hi ? 0.f : 1.f};
        f32x16 O[2][2];
#pragma unroll
        for (int dt = 0; dt < 2; ++dt)
#pragma unroll
            for (int nt = 0; nt < 2; ++nt)
#pragma unroll
                for (int i = 0; i < 16; ++i) O[dt][nt][i] = 0.f;
        u32x4 kreg, vreg;
        { const int t0 = 0; kreg = *(const GAS u32x4*)(kbase + (size_t)t0 * 256); vreg = *(const GAS u32x4*)(vbase + t0); }
        *(LAS u32x4*)(Kb + srow * ATT_KST + 16 * sch) = kreg;
        *(LAS u32x2*)(Vb + srow * ATT_VST + 16 * sch) = (u32x2){vreg.x, vreg.y}; *(LAS u32x2*)(Vb + srow * ATT_VST + 16 * sch + 8) = (u32x2){vreg.z, vreg.w};
        __syncthreads();
#pragma unroll 1
        for (int j = 0; j < ntile; ++j) {
            const int buf = j & 1;
            if (j + 1 < ntile) { const int jn = j + 1; const int t0 = jn < 4 ? 64 * jn : LC + 64 * (w_lo + jn - 4);
                kreg = *(const GAS u32x4*)(kbase + (size_t)t0 * 256); vreg = *(const GAS u32x4*)(vbase + t0); }
            const int rel = j < 4 ? 0 : (w_lo + j - 4) - qb;
            const bool masked = (rel == 2 || rel == -2);
            const LAS unsigned char* kt = Kb + buf * ATT_KB; const LAS unsigned char* vt = Vb + buf * ATT_VB;
#pragma unroll
            for (int nt = 0; nt < 2; ++nt) {
                f32x16 s[2];
#pragma unroll
                for (int mt = 0; mt < 2; ++mt) {
#pragma unroll
                    for (int i = 0; i < 16; ++i) s[mt][i] = -m2[nt];
#pragma unroll
                    for (int ks = 0; ks < 4; ++ks) { const bf16x8v kf = *(const LAS bf16x8v*)(kt + (32 * mt + r32) * ATT_KST + (16 * ks + 8 * hi) * 2);
                        s[mt] = __builtin_amdgcn_mfma_f32_32x32x16_bf16(kf, Qf[nt][ks], s[mt], 0, 0, 0); }
                }
                __builtin_amdgcn_sched_barrier(0);
                if (masked) {
                    int mb = r32 - 4 * hi - 64 * rel; asm volatile("" : "+v"(mb));
#pragma unroll
                    for (int mt = 0; mt < 2; ++mt)
#pragma unroll
                        for (int i = 0; i < 16; ++i) { const int cc = 32 * mt + (i & 3) + 8 * (i >> 2) - 32 * nt;
                            if (mb > 128 + cc || mb < cc - 128) s[mt][i] = -1e30f; }
                }
                float mx = s[0][0];
#pragma unroll
                for (int i = 1; i < 16; ++i) mx = fmaxf(mx, s[0][i]);
#pragma unroll
                for (int i = 0; i < 16; ++i) mx = fmaxf(mx, s[1][i]);
                mx = fmaxf(mx, __shfl_xor(mx, 32));
                if (__any(mx > 8.0f)) { const float dlt = fmaxf(mx, 0.f), alpha = __builtin_amdgcn_exp2f(-dlt); m2[nt] += dlt; ls[nt] *= alpha;
#pragma unroll
                    for (int mt = 0; mt < 2; ++mt)
#pragma unroll
                        for (int i = 0; i < 16; ++i) s[mt][i] -= dlt;
#pragma unroll
                    for (int dt = 0; dt < 2; ++dt)
#pragma unroll
                        for (int i = 0; i < 16; ++i) O[dt][nt][i] *= alpha; }
                float psum = 0.f;
#pragma unroll
                for (int mt = 0; mt < 2; ++mt)
#pragma unroll
                    for (int i = 0; i < 16; ++i) { s[mt][i] = __builtin_amdgcn_exp2f(s[mt][i]); psum += s[mt][i]; }
                ls[nt] += psum;
                __builtin_amdgcn_sched_barrier(0);
                bf16x8v Pf[2][2];
#pragma unroll
                for (int mt = 0; mt < 2; ++mt)
#pragma unroll
                    for (int s2 = 0; s2 < 2; ++s2) { u32x4 w;
#pragma unroll
                        for (int q = 0; q < 4; ++q) w[q] = pg8::cvt_pk_bf16(s[mt][8 * s2 + 2 * q], s[mt][8 * s2 + 2 * q + 1]);
                        Pf[mt][s2] = __builtin_bit_cast(bf16x8v, w); }
#pragma unroll
                for (int dt = 0; dt < 2; ++dt)
#pragma unroll
                    for (int mt = 0; mt < 2; ++mt)
#pragma unroll
                        for (int s2 = 0; s2 < 2; ++s2) { const LAS unsigned char* vp = vt + (32 * dt + r32) * ATT_VST + (32 * mt + 16 * s2 + 4 * hi) * 2;
                            const u32x2 lo = *(const LAS u32x2*)vp, hh = *(const LAS u32x2*)(vp + 16);
                            const bf16x8v vf = __builtin_bit_cast(bf16x8v, (u32x4){lo.x, lo.y, hh.x, hh.y});
                            O[dt][nt] = __builtin_amdgcn_mfma_f32_32x32x16_bf16(vf, Pf[mt][s2], O[dt][nt], 0, 0, 0); }
                __builtin_amdgcn_sched_barrier(0);
            }
            if (j + 1 < ntile) { const int nb = buf ^ 1;
                *(LAS u32x4*)(Kb + nb * ATT_KB + srow * ATT_KST + 16 * sch) = kreg;
                *(LAS u32x2*)(Vb + nb * ATT_VB + srow * ATT_VST + 16 * sch) = (u32x2){vreg.x, vreg.y}; *(LAS u32x2*)(Vb + nb * ATT_VB + srow * ATT_VST + 16 * sch + 8) = (u32x2){vreg.z, vreg.w}; }
            __syncthreads();
        }
#pragma unroll
        for (int nt = 0; nt < 2; ++nt) {
            const float lt = ls[nt] + __shfl_xor(ls[nt], 32), inv = 1.0f / lt;
            bf16* op = HA + ((size_t)b * TT + tq0 + 32 * nt + r32) * D + head * 64 + 4 * hi;
#pragma unroll
            for (int dt = 0; dt < 2; ++dt)
#pragma unroll
                for (int g = 0; g < 4; ++g) { u32x2 w; w.x = pg8::cvt_pk_bf16(O[dt][nt][4 * g] * inv, O[dt][nt][4 * g + 1] * inv); w.y = pg8::cvt_pk_bf16(O[dt][nt][4 * g + 2] * inv, O[dt][nt][4 * g + 3] * inv);
                    *(GAS u32x2*)(op + 32 * dt + 8 * g) = w; }
        }
    }
}

__device__ __forceinline__ void gmlp_stats_phase(const Args& a, bool skip_ctx, int lane, int gw, int ngw) {
    const bf16* V = (const bf16*)(OPQ(a.ws) + WS_MIX + MIX_V); float* MU = (float*)(OPQ(a.ws) + WS_STAT); float* RS = MU + M;
    for (int r = gw; r < M; r += ngw) {
        if (skip_ctx && (r % TT) < LC) continue;
        float v[32];
#pragma unroll
        for (int j = 0; j < 4; ++j) { const u32x4 w = *(const GAS u32x4*)(V + (size_t)r * D + 512 * j + 8 * lane);
#pragma unroll
            for (int q = 0; q < 4; ++q) { v[8 * j + 2 * q] = bflo(w[q]); v[8 * j + 2 * q + 1] = bfhi(w[q]); } }
        float s = 0.f;
#pragma unroll
        for (int j = 0; j < 32; ++j) s += v[j];
        const float mean = wave_sum(s) * (1.0f / D); float q2 = 0.f;
#pragma unroll
        for (int j = 0; j < 32; ++j) { const float d = v[j] - mean; q2 += d * d; }
        const float var = wave_sum(q2) * (1.0f / D);
        if (lane == 0) { MU[r] = mean; RS[r] = 1.0f / sqrtf(var + EPS); }
    }
}
constexpr int GM_ST = 272;
__device__ __forceinline__ void gmlp_spatial_phase(const Args& a, bool skip_ctx, LAS unsigned char* lds, int tid, int wave, int lane, int wg, int G) {
    LAS unsigned char* VT = lds;
    LAS unsigned char* WSs = lds + 128 * GM_ST;
    const bf16* U = (const bf16*)(OPQ(a.ws) + WS_MIX + MIX_U); const bf16* V = (const bf16*)(OPQ(a.ws) + WS_MIX + MIX_V);
    const float* MU = (const float*)(OPQ(a.ws) + WS_STAT); const float* RS = MU + M;
    const float* lng = OPQF(a.in[19]); const float* lnb = OPQF(a.in[20]); const float* wsp = OPQF(a.in[21]); const float* bs = OPQF(a.in[22]); bf16* HA = (bf16*)(OPQ(a.ws) + WS_HA);
    const int l15 = lane & 15, kq = lane >> 4;
    for (int g = wg & 15; g < 16; g += (G >= 16 ? 16 : G)) {
        if (G < 16 && false) {}
        const int C0 = 128 * g;
        __syncthreads();
        for (int e = tid; e < 128 * 32; e += NTHREADS) { const int i = e >> 5, j4 = e & 31; const f32x4 w = *(const GAS f32x4*)(wsp + (size_t)g * 16384 + i * 128 + 4 * j4);
            u32x2 o; o.x = pk2(w[0], w[1]); o.y = pk2(w[2], w[3]); *(LAS u32x2*)(WSs + i * GM_ST + 8 * j4) = o; }
        for (int n = wg >> 4; n < 72; n += (G >> 4 > 0 ? G >> 4 : 1)) {
            const int R0 = 128 * n;
            if (skip_ctx && (R0 % TT) < LC) continue;
            __syncthreads();
#pragma unroll
            for (int q = 0; q < 4; ++q) { const int e = tid + NTHREADS * q, j = e >> 4, c8 = (e & 15) * 8;
                const u32x4 vv = *(const GAS u32x4*)(V + (size_t)(R0 + j) * D + C0 + c8); const float mu = MU[R0 + j], rs = RS[R0 + j];
                const f32x4 g0 = *(const GAS f32x4*)(lng + C0 + c8), g1 = *(const GAS f32x4*)(lng + C0 + c8 + 4), b0 = *(const GAS f32x4*)(lnb + C0 + c8), b1 = *(const GAS f32x4*)(lnb + C0 + c8 + 4);
#pragma unroll
                for (int k = 0; k < 4; ++k) { const float x0 = (bflo(vv[k]) - mu) * rs, x1 = (bfhi(vv[k]) - mu) * rs;
                    const float ga = k < 2 ? g0[2 * k] : g1[2 * k - 4], gb = k < 2 ? g0[2 * k + 1] : g1[2 * k - 3], ba_ = k < 2 ? b0[2 * k] : b1[2 * k - 4], bb = k < 2 ? b0[2 * k + 1] : b1[2 * k - 3];
                    const int sw = ((((j >> 3) ^ (c8 >> 3)) & 15) << 4) + (j & 7) * 2;
                    *(LAS unsigned short*)(VT + (c8 + 2 * k) * GM_ST + sw) = (unsigned short)f2bf(x0 * ga + ba_);
                    *(LAS unsigned short*)(VT + (c8 + 2 * k + 1) * GM_ST + sw) = (unsigned short)f2bf(x1 * gb + bb); } }
            __syncthreads();
            bf16x8v Bf[4];
#pragma unroll
            for (int ks = 0; ks < 4; ++ks) Bf[ks] = *(const LAS bf16x8v*)(WSs + (16 * wave + l15) * GM_ST + (32 * ks + 8 * kq) * 2);
            const int i = 16 * wave + l15; const float bsv = bs[g * 128 + i];
            const size_t orow = (size_t)(R0 + i) * D + C0 + 4 * kq;
#pragma unroll
            for (int ct = 0; ct < 8; ++ct) { f32x4 acc = (f32x4){0.f, 0.f, 0.f, 0.f};
#pragma unroll
                for (int ks = 0; ks < 4; ++ks) { const int cr = 16 * ct + l15; const bf16x8v af = *(const LAS bf16x8v*)(VT + cr * GM_ST + ((((4 * ks + kq) ^ (cr >> 3)) & 15) << 4));
                    acc = __builtin_amdgcn_mfma_f32_16x16x32_bf16(af, Bf[ks], acc, 0, 0, 0); }
                const u32x2 uu = *(const GAS u32x2*)(U + orow + 16 * ct);
                u32x2 o; o.x = pk2(bflo(uu.x) * (acc[0] + bsv), bfhi(uu.x) * (acc[1] + bsv)); o.y = pk2(bflo(uu.y) * (acc[2] + bsv), bfhi(uu.y) * (acc[3] + bsv));
                *(GAS u32x2*)(HA + orow + 16 * ct) = o; }
        }
    }
}

#ifndef SITE_MASK
#define SITE_MASK 0x1ff
#endif
#define SITE(n) (((SITE_MASK) >> (n)) & 1)
#ifndef DUP_PHASE
#define DUP_PHASE (-1)
#endif
#define REPS(p) for (int rep_ = 0; rep_ < (((p) == DUP_PHASE) ? 2 : 1); ++rep_)
constexpr int N_PHASES = 2 + 9 * DEPTH;
__host__ __device__ constexpr bool phase_exists(int p) { if (p < 2) return true; const int q = (p - 2) % 9, kind = ((p - 2) / 9) % 3; return !((q == 2 && kind == 1) || (q == 3 && kind != 0)); }

__global__ void __launch_bounds__(NTHREADS, 2) trunk_fwd(Args args) {
    extern __shared__ __attribute__((aligned(16))) unsigned char lds_raw[];
    LAS unsigned char* lds = (LAS unsigned char*)lds_raw;
    const int wave = __builtin_amdgcn_readfirstlane((int)threadIdx.x >> 6);
#define FRESH_WS() unsigned char* ws = args.ws; asm volatile("" : "+s"(ws))
#define FRESH_TID() int tid_f = threadIdx.x; asm volatile("" : "+v"(tid_f)); const int tid = tid_f, lane = tid & 63; (void)lane
    const int G = gridDim.x, wg = blockIdx.x;
    const int gw = wg * NWAVES + wave, ngw = G * NWAVES;
    unsigned char* ws = args.ws;
    gu32* ctl = (gu32*)(OPQ(args.ws) + WS_CTL);
    for (int u = threadIdx.x; u < (LDS_BYTES - LDSCTL_OFF) / 4; u += NTHREADS) ((LAS unsigned*)(lds + LDSCTL_OFF))[u] = 0u;
    __syncthreads();
    XcdBarrier bar = xcd_barrier_post((unsigned*)(ctl + CW_BAR), (volatile LAS unsigned*)(lds + MISC_OFF) + 8);
    const int lo = args.ph_lo, hi = args.ph_hi;
#define IN(k) (lo <= (k) && (k) < hi)
#define PULL(until, quota) do { int tp_ = threadIdx.x; asm volatile("" : "+v"(tp_)); tr_pull(args, lds, wave, tp_ & 63, (until), (quota)); } while (0)
#define LIGHT(nunits) (((nunits) % G) != 0 && wg >= ((nunits) % G))
#define SEAM(k) do { if ((k) + 1 < hi) { XcdBarrier bl = bar; asm volatile("" : "+s"(bl.bar)); xcd_barrier(bl); } } while (0)

    if (IN(0) && SITE(8)) { FRESH_TID(); REPS(0) { if (wg < 64) adaln_unit(args, lds, tid, wave, lane, 0, wg); if (wg == G - 1) p0_rope(args, tid); tr_pull(args, lds, wave, lane, PROLOGUE_UNTIL, 1 << 20); __syncthreads(); } SEAM(0); }
    if (IN(1) && SITE(8)) { FRESH_TID(); norm0_phase(args, wave, lane, wg, G); SEAM(1); }

    const pg8::bf16_t* HA = (const pg8::bf16_t*)(OPQ(args.ws) + WS_HA);
#pragma unroll 1
    for (int l = 0; l < DEPTH; ++l) {
        const int base = 2 + 9 * l, kind = l % 3, slot = l / 3;
        const bool last = (l == DEPTH - 1);
        if (IN(base + 0)) { REPS(base + 0) {
            if (kind == 0) {
                pg8::Gemm g{HA, (const pg8::bf16_t*)(OPQ(args.ws) + WS_GLAW + slot * GLAW_STRIDE), M, GLA_NP, D, D}; pg8::Sched S; S.init(M / 256, GLA_NP / 256, G, wg, 0);
                pg8::EpiGlaIn E{(pg8::bf16_t*)(OPQ(args.ws) + WS_MIX + MIX_GQ), (pg8::bf16_t*)(OPQ(args.ws) + WS_MIX + MIX_GK), (pg8::bf16_t*)(OPQ(args.ws) + WS_MIX + MIX_GV), (pg8::bf16_t*)(OPQ(args.ws) + WS_MIX + MIX_GOG), (float*)(OPQ(args.ws) + WS_A32)};
                if (SITE(0)) pg8::gemm_phase<pg8::EpiGlaIn, pg8::Sched, true, true>(lds, g, S, E);
            } else if (kind == 1) {
                pg8::Gemm g{HA, (const pg8::bf16_t*)(OPQ(args.ws) + WS_SWAW), M, SWA_N, D, D}; pg8::Sched S; S.init(M / 256, SWA_N / 256, G, wg, 0);
                pg8::EpiSwaIn E{(pg8::bf16_t*)(OPQ(args.ws) + WS_MIX + MIX_SQ), (pg8::bf16_t*)(OPQ(args.ws) + WS_MIX + MIX_SK), (pg8::bf16_t*)(OPQ(args.ws) + WS_MIX + MIX_SV), (const float*)(OPQ(args.ws) + WS_ROPE), (const float*)(OPQ(args.ws) + WS_ROPE) + 1024};
                if (SITE(1)) pg8::gemm_phase<pg8::EpiSwaIn, pg8::Sched, true, true>(lds, g, S, E);
            } else {
                pg8::Gemm g{HA, (const pg8::bf16_t*)(OPQ(args.ws) + WS_GMW), M, GM_N, D, D}; pg8::Sched S; S.init(M / 256, GM_N / 256, G, wg, 0);
                pg8::EpiGmlpIn E{(pg8::bf16_t*)(OPQ(args.ws) + WS_MIX + MIX_U), (pg8::bf16_t*)(OPQ(args.ws) + WS_MIX + MIX_V)};
                if (SITE(2)) pg8::gemm_phase<pg8::EpiGmlpIn, pg8::Sched, true, true>(lds, g, S, E);
            }
            { const int nun = 36 * (kind == 0 ? GLA_NP / 256 : (kind == 1 ? SWA_N / 256 : GM_N / 256)); if (LIGHT(nun)) { const int li = wg - (nun % G); if (!last && li < 64) { FRESH_TID(); adaln_unit(args, lds, tid, wave, lane, l + 1, li); } PULL(tr_need(base + 6 + REACH), Q_IN); } }
            } SEAM(base + 0);
        }
        if (IN(base + 1)) { FRESH_TID(); REPS(base + 1) {
            if (kind == 0) gla_prep_phase(args, slot, lds, tid, wave, lane, wg, G);
            else if (kind == 1) swa_attn_phase(args, last, lds, tid, wave, lane, wg, G);
            else gmlp_stats_phase(args, last, lane, gw, ngw);
            __syncthreads(); } SEAM(base + 1);
        }
        if (IN(base + 2) && kind != 1) { FRESH_TID(); REPS(base + 2) {
            if (kind == 0) gla_scan_phase(args, lds, tid, wave, lane, wg, G);
            else gmlp_spatial_phase(args, last, lds, tid, wave, lane, wg, G);
            __syncthreads(); } SEAM(base + 2);
        }
        if (IN(base + 3) && kind == 0) { FRESH_TID(); REPS(base + 3) {
            gla_onorm_phase(args, slot, last, lane, gw, ngw);
            __syncthreads(); } SEAM(base + 3);
        }
        if (IN(base + 4)) { REPS(base + 4) {
            const size_t wo = kind == 0 ? WS_GLAW + slot * GLAW_STRIDE + GLAW_WO : (kind == 1 ? WS_SWAW + SWAW_WO : WS_GMW + GMW_WO);
            { pg8::Gemm g{HA, (const pg8::bf16_t*)(OPQ(args.ws) + wo), M, D, D, D}; pg8::Sched S; S.init(32, D / 256, G, wg, 1); if (!last) { S.dual = 1; S.se = 4; S.so = 4; }
              pg8::EpiY E{(pg8::bf16_t*)(OPQ(args.ws) + WS_Y), (pg8::bf16_t*)(OPQ(args.ws) + WS_YP), D};
              if (SITE(3)) pg8::gemm_phase<pg8::EpiY, pg8::Sched, true, true>(lds, g, S, E); }
            } SEAM(base + 4);
        }
        if (IN(base + 5)) { FRESH_TID(); if (SITE(7)) resid_phase<0>(args, l, lds, tid, wave, lane, wg, G); PULL(tr_need(base + 6), 1 << 20); SEAM(base + 5); }
        if (IN(base + 6)) { REPS(base + 6) {
            pg8::Gemm g{HA, (const pg8::bf16_t*)(OPQ(args.ws) + WS_FFNW + l * FFNW_STRIDE), M, 2 * FF, D, D}; pg8::Sched S; S.init(last ? 32 : 36, 2 * FF / 256, G, wg, last ? 1 : 0);
            pg8::EpiUp E{(pg8::bf16_t*)(OPQ(args.ws) + WS_HFF), FF};
            if (SITE(4)) pg8::gemm_phase<pg8::EpiUp, pg8::Sched, true, true>(lds, g, S, E);
            PULL(tr_need(base + 7), 1 << 20);
            } SEAM(base + 6);
        }
        if (IN(base + 7)) { REPS(base + 7) {
            { pg8::Gemm g{(const pg8::bf16_t*)(OPQ(args.ws) + WS_HFF), (const pg8::bf16_t*)(OPQ(args.ws) + WS_FFNW + l * FFNW_STRIDE + FFNW_W2), M, D, FF, FF}; pg8::Sched S; S.init(32, D / 256, G, wg, 1);
              if (!last) { S.dual = 1; S.se = 12; S.so = 10; }
              pg8::EpiY E{(pg8::bf16_t*)(OPQ(args.ws) + WS_Y), (pg8::bf16_t*)(OPQ(args.ws) + WS_YP), D};
              if (SITE(5)) pg8::gemm_phase<pg8::EpiY, pg8::Sched, true, true>(lds, g, S, E); }
            } SEAM(base + 7);
        }
        if (IN(base + 8)) { FRESH_TID(); if (SITE(7)) resid_phase<1>(args, l, lds, tid, wave, lane, wg, G); if (!last) PULL(tr_need(base + 9), 1 << 20); SEAM(base + 8); }
    }
#undef IN
#undef SEAM
}

#ifndef MK_ONE_LAUNCH
#define MK_ONE_LAUNCH 0
#endif
extern "C" void kernel_launch(void* const* d_in, const int* in_sizes, int n_in, void* d_out, int out_size, void* d_ws, size_t ws_size, hipStream_t stream) {
    static int grid = 0;
    if (grid == 0) {
        if (n_in != 24 || out_size != NB * SEQ * D || ws_size < WS_END) { fprintf(stderr, "kernel_launch: unexpected problem (n_in %d, out %d, ws %zu); nothing launched\n", n_in, out_size, ws_size); grid = -1; return; }
        int dev = 0, cus = 0, per_cu = 0;
        if (hipGetDevice(&dev) != hipSuccess || hipDeviceGetAttribute(&cus, hipDeviceAttributeMultiprocessorCount, dev) != hipSuccess) { grid = -1; return; }
        if (hipFuncSetAttribute((const void*)trunk_fwd, hipFuncAttributeMaxDynamicSharedMemorySize, LDS_BYTES) != hipSuccess) { fprintf(stderr, "kernel_launch: hipFuncSetAttribute failed\n"); grid = -1; return; }
        if (hipOccupancyMaxActiveBlocksPerMultiprocessor(&per_cu, (const void*)trunk_fwd, NTHREADS, LDS_BYTES) != hipSuccess || per_cu < 1) { fprintf(stderr, "kernel_launch: occupancy query says %d\n", per_cu); }
        (void)hipGetLastError();
        grid = cus;
    }
    if (grid < 0) return;
    if (hipMemsetAsync((char*)d_ws + WS_CTL, 0, CTL_ZERO_BYTES, stream) != hipSuccess) return;
    Args a{};
    for (int i = 0; i < 24; ++i) a.in[i] = (const float*)d_in[i];
    a.out = (float*)d_out; a.ws = (unsigned char*)d_ws;
#if MK_ONE_LAUNCH
    a.ph_lo = 0; a.ph_hi = N_PHASES;
    hipLaunchKernelGGL(trunk_fwd, dim3(grid), dim3(NTHREADS), LDS_BYTES, stream, a);
#else
#ifndef HOST_DUP_PHASE
#define HOST_DUP_PHASE (-1)
#endif
#ifndef HOST_DUP_REPS
#define HOST_DUP_REPS 2
#endif
    for (int p = 0; p < N_PHASES; ++p) { if (!phase_exists(p)) continue; a.ph_lo = p; a.ph_hi = p + 1;
        for (int rep = 0; rep < (p == HOST_DUP_PHASE ? HOST_DUP_REPS : 1); ++rep) hipLaunchKernelGGL(trunk_fwd, dim3(grid), dim3(NTHREADS), LDS_BYTES, stream, a); }
#endif
}
```

```cpp
#define MK_ONE_LAUNCH 1
#define Q_IN 0
#define Q_WO 0
#define Q_DN 0
#include <hip/hip_runtime.h>
#include <cstdio>
#include <cstdint>

#define LAS __attribute__((address_space(3)))
#define GAS __attribute__((address_space(1)))

namespace pg8 {
#define PG8_LAS __attribute__((address_space(3)))
typedef unsigned short bf16_t;
typedef short bf16x8 __attribute__((ext_vector_type(8)));
typedef float f32x4 __attribute__((ext_vector_type(4)));
typedef float f32x2 __attribute__((ext_vector_type(2)));
typedef unsigned u32x4 __attribute__((ext_vector_type(4)));
typedef unsigned u32x2 __attribute__((ext_vector_type(2)));
constexpr int BM = 256, BK = 64, HALF = 128, HTB = HALF * BK * 2  , STAGE_BYTES = 8 * HTB, NXCD = 8, WGM = 4;

__host__ __device__ __forceinline__ int lds_byte(int r, int c) { const int st = (r >> 4) * 2 + (c >> 5), rr = r & 15, cc = c & 31, ob = rr * 64 + cc * 2; return st * 1024 + (ob ^ (((ob >> 9) & 1) << 5)); }
__host__ __device__ __forceinline__ void stage_rc(int b, int& R, int& C) { const int st = b / 1024, sb = b % 1024, swz = sb ^ (((sb >> 9) & 1) << 5); R = (st >> 1) * 16 + swz / 64; C = (st & 1) * 32 + (swz % 64) / 2; }
__host__ __device__ __forceinline__ int perm32(int rho) { const int n = rho >> 4, i = rho & 15; return 8 * (i >> 2) + 4 * n + (i & 3); }

struct Unit { int pm, pn; };
struct Gemm { const bf16_t* A; const bf16_t* Bt; int M, N, K, ldk; };

struct Sched {
    int nM, nN, nwg, G, c, skip;
    __device__ __forceinline__ void init(int nM_, int nN_, int G_, int c_, int skip_) { nM = nM_; nN = nN_; nwg = nM * nN; G = G_; c = c_; skip = skip_; one = 0; opm = 0; opn = 0; }
    int one, opm, opn;
    __device__ __forceinline__ void init_one(bool valid, int pm_, int pn_) { nM = nN = nwg = G = c = skip = 0; one = valid ? 1 : -1; opm = pm_; opn = pn_; }
    __device__ __forceinline__ bool next(int i, Unit& u) const {
        if (one) { if (one < 0 || i > 0) return false; u.pm = opm; u.pn = opn; return true; }
        const long L = (long)i * G + c; if (L >= nwg) return false;
        int wgid = (int)L; { const int q = nwg / NXCD, r = nwg % NXCD, xcd = wgid % NXCD, off = wgid / NXCD; wgid = (xcd < r ? xcd * (q + 1) : r * (q + 1) + (xcd - r) * q) + off; }
        const int nig = WGM * nN, gid = wgid / nig, fm = gid * WGM, gsz = (nM - fm) < WGM ? (nM - fm) : WGM;
        int pm = fm + ((wgid % nig) % gsz); u.pn = (wgid % nig) / gsz;
        if (skip) pm = pm + (pm >> 3) + 1;
        u.pm = pm; return true;
    }
    __device__ __forceinline__ void a_ready(const Unit&) const {}
    __device__ __forceinline__ void done(const Unit&) const {}
};

typedef __bf16 bf16x2_t __attribute__((ext_vector_type(2)));
__device__ __forceinline__ unsigned cvt_pk_bf16(float lo, float hi) { const f32x2 v = {lo, hi}; const bf16x2_t b = __builtin_convertvector(v, bf16x2_t); return __builtin_bit_cast(unsigned, b); }
__device__ __forceinline__ float silu_f(float x) { return x * __builtin_amdgcn_rcpf(1.0f + __builtin_amdgcn_exp2f(-1.44269504f * x)); }
__device__ __forceinline__ float gelu_tanh_f(float x) { const float z = 0.7978845608f * (x + 0.044715f * x * x * x); return x * __builtin_amdgcn_rcpf(1.0f + __builtin_amdgcn_exp2f(-2.88539008f * z)); }
__device__ __forceinline__ u32x4 pack8(const f32x4& a, const f32x4& b) { u32x4 w; w.x = cvt_pk_bf16(a[0], a[1]); w.y = cvt_pk_bf16(a[2], a[3]); w.z = cvt_pk_bf16(b[0], b[1]); w.w = cvt_pk_bf16(b[2], b[3]); return w; }
__device__ __forceinline__ u32x2 pack4(const f32x4& a) { u32x2 w; w.x = cvt_pk_bf16(a[0], a[1]); w.y = cvt_pk_bf16(a[2], a[3]); return w; }

struct EpiF32 {
    static constexpr bool PERM = false, AFTER_DRAIN = false;
    float* C; int ldc;
    __device__ __forceinline__ void operator()(const f32x4 (&acc)[2][2][4][2], const Unit& u, int wr, int wc, int fr, int fq) const {
        const int row0 = u.pm * BM + wr * 64 + fr, col0 = u.pn * BM + wc * 32 + 4 * fq;
#pragma unroll
        for (int ai = 0; ai < 2; ++ai)
#pragma unroll
            for (int m = 0; m < 4; ++m) { float* rowp = C + (size_t)(row0 + ai * HALF + m * 16) * ldc + col0;
#pragma unroll
                for (int bj = 0; bj < 2; ++bj)
#pragma unroll
                    for (int n = 0; n < 2; ++n) *(f32x4*)(rowp + bj * HALF + n * 16) = acc[ai][bj][m][n]; }
    }
};
struct EpiY {
    static constexpr bool PERM = true, AFTER_DRAIN = false;
    bf16_t* Y; float* P; int ldc;
    __device__ __forceinline__ void operator()(const f32x4 (&acc)[2][2][4][2], const Unit& u, int wr, int wc, int fr, int fq) const {
        const int row0 = u.pm * BM + wr * 64 + fr, col0 = u.pn * BM + wc * 32 + 8 * fq;
        if (P) {
#pragma unroll
            for (int ai = 0; ai < 2; ++ai)
#pragma unroll
                for (int m = 0; m < 4; ++m) { float* rowp = P + (ptrdiff_t)(row0 + ai * HALF + m * 16) * ldc + col0;
#pragma unroll
                    for (int bj = 0; bj < 2; ++bj) { *(f32x4*)(rowp + bj * HALF) = acc[ai][bj][m][0]; *(f32x4*)(rowp + bj * HALF + 4) = acc[ai][bj][m][1]; } }
        } else {
#pragma unroll
            for (int ai = 0; ai < 2; ++ai)
#pragma unroll
                for (int m = 0; m < 4; ++m) { bf16_t* rowp = Y + (size_t)(row0 + ai * HALF + m * 16) * ldc + col0;
#pragma unroll
                    for (int bj = 0; bj < 2; ++bj) *(u32x4*)(rowp + bj * HALF) = pack8(acc[ai][bj][m][0], acc[ai][bj][m][1]); }
        }
    }
};
struct EpiUp {
    static constexpr bool PERM = true, AFTER_DRAIN = false;
    bf16_t* H; int ldc;
    __device__ __forceinline__ void operator()(const f32x4 (&acc)[2][2][4][2], const Unit& u, int wr, int wc, int fr, int fq) const {
        const int row0 = u.pm * BM + wr * 64 + fr, col0 = u.pn * HALF + wc * 32 + 8 * fq;
#pragma unroll
        for (int ai = 0; ai < 2; ++ai)
#pragma unroll
            for (int m = 0; m < 4; ++m) { bf16_t* rowp = H + (size_t)(row0 + ai * HALF + m * 16) * ldc + col0;
                f32x4 v0, v1;
#pragma unroll
                for (int j = 0; j < 4; ++j) { v0[j] = silu_f(acc[ai][0][m][0][j]) * acc[ai][1][m][0][j]; v1[j] = silu_f(acc[ai][0][m][1][j]) * acc[ai][1][m][1][j]; }
                *(u32x4*)rowp = pack8(v0, v1); }
    }
};
struct EpiGlaIn {
    static constexpr bool PERM = true, AFTER_DRAIN = false;
    bf16_t *Q, *K, *V, *OG; float* A32;
    __device__ __forceinline__ void operator()(const f32x4 (&acc)[2][2][4][2], const Unit& u, int wr, int wc, int fr, int fq) const {
        const int row0 = u.pm * BM + wr * 64 + fr, pn = u.pn;
        if (pn == 24) {
            if (wc == 0) {
#pragma unroll
                for (int ai = 0; ai < 2; ++ai)
#pragma unroll
                    for (int m = 0; m < 4; ++m) { float* ap = A32 + (size_t)(row0 + ai * HALF + m * 16) * 32 + 8 * fq; *(f32x4*)ap = acc[ai][0][m][0]; *(f32x4*)(ap + 4) = acc[ai][0][m][1]; }
            }
            return;
        }
        bf16_t* base; int ldc, colt; float sc = 1.0f; bool act = false;
        if (pn < 4) { base = Q; ldc = 1024; colt = pn * BM; sc = 0.0625f; }
        else if (pn < 8) { base = K; ldc = 1024; colt = (pn - 4) * BM; }
        else if (pn < 16) { base = V; ldc = 2048; colt = (pn - 8) * BM; }
        else { base = OG; ldc = 2048; colt = (pn - 16) * BM; act = true; }
        const int col0 = colt + wc * 32 + 8 * fq;
#pragma unroll
        for (int ai = 0; ai < 2; ++ai)
#pragma unroll
            for (int m = 0; m < 4; ++m) { bf16_t* rowp = base + (size_t)(row0 + ai * HALF + m * 16) * ldc + col0;
#pragma unroll
                for (int bj = 0; bj < 2; ++bj) { f32x4 v0 = acc[ai][bj][m][0] * sc, v1 = acc[ai][bj][m][1] * sc;
                    if (act) {
#pragma unroll
                        for (int j = 0; j < 4; ++j) { v0[j] = silu_f(v0[j]); v1[j] = silu_f(v1[j]); } }
                    *(u32x4*)(rowp + bj * HALF) = pack8(v0, v1); } }
    }
};
struct EpiSwaIn {
    static constexpr bool PERM = false, AFTER_DRAIN = false;
    bf16_t *SQ, *SK, *SV; const float* ropeC; const float* ropeS;
    __device__ __forceinline__ void operator()(const f32x4 (&acc)[2][2][4][2], const Unit& u, int wr, int wc, int fr, int fq) const {
        const int row0 = u.pm * BM + wr * 64 + fr, pn = u.pn;
        bf16_t* base; int ldc, colt; float sc = 1.0f; const bool rope = true;
        if (pn < 8) { base = SQ; ldc = 2048; colt = pn * BM; sc = 0.125f * 1.4426950408889634f; }
        else if (pn == 8) { base = SK; ldc = 256; colt = 0; }
        else {
#pragma unroll
            for (int ai = 0; ai < 2; ++ai)
#pragma unroll
                for (int m = 0; m < 4; ++m) { const int row = row0 + ai * HALF + m * 16, b = row / 2304, t = row - b * 2304;
#pragma unroll
                    for (int bj = 0; bj < 2; ++bj)
#pragma unroll
                        for (int n = 0; n < 2; ++n) { const int c0 = bj * HALF + wc * 32 + n * 16 + 4 * fq; const u32x2 w = pack4(acc[ai][bj][m][n]);
                            bf16_t* vp = SV + ((size_t)(b * 4 + (c0 >> 6)) * 64 + (c0 & 63)) * 2304 + t;
                            vp[0] = (bf16_t)(w.x & 0xffffu); vp[2304] = (bf16_t)(w.x >> 16); vp[2 * 2304] = (bf16_t)(w.y & 0xffffu); vp[3 * 2304] = (bf16_t)(w.y >> 16); } }
            return;
        }
        const int col0 = colt + wc * 32 + 4 * fq, half = wc & 1;
#pragma unroll
        for (int ai = 0; ai < 2; ++ai)
#pragma unroll
            for (int m = 0; m < 4; ++m) { const int row = row0 + ai * HALF + m * 16, t = row % 2304; bf16_t* rowp = base + (size_t)row * ldc + col0;
                f32x4 cs = (f32x4){1.f, 1.f, 1.f, 1.f}, sn = (f32x4){0.f, 0.f, 0.f, 0.f};
                if (rope && t >= 256) { const int tl = t - 256, pos = half ? (tl & 63) : (tl >> 6); cs = *(const f32x4*)(ropeC + pos * 16 + 4 * fq); sn = *(const f32x4*)(ropeS + pos * 16 + 4 * fq); }
#pragma unroll
                for (int bj = 0; bj < 2; ++bj) { const f32x4 x0 = acc[ai][bj][m][0], x1 = acc[ai][bj][m][1];
                    const f32x4 o0 = (x0 * cs - x1 * sn) * sc, o1 = (x1 * cs + x0 * sn) * sc;
                    *(u32x2*)(rowp + bj * HALF) = pack4(o0); *(u32x2*)(rowp + bj * HALF + 16) = pack4(o1); } }
    }
};
struct EpiGmlpIn {
    static constexpr bool PERM = true, AFTER_DRAIN = false;
    bf16_t *U, *V;
    __device__ __forceinline__ void operator()(const f32x4 (&acc)[2][2][4][2], const Unit& u, int wr, int wc, int fr, int fq) const {
        const int row0 = u.pm * BM + wr * 64 + fr, pn = u.pn;
        bf16_t* base = pn < 8 ? U : V; const int col0 = (pn & 7) * BM + wc * 32 + 8 * fq;
#pragma unroll
        for (int ai = 0; ai < 2; ++ai)
#pragma unroll
            for (int m = 0; m < 4; ++m) { bf16_t* rowp = base + (size_t)(row0 + ai * HALF + m * 16) * 2048 + col0;
#pragma unroll
                for (int bj = 0; bj < 2; ++bj) { f32x4 v0, v1;
#pragma unroll
                    for (int j = 0; j < 4; ++j) { v0[j] = gelu_tanh_f(acc[ai][bj][m][0][j]); v1[j] = gelu_tanh_f(acc[ai][bj][m][1][j]); }
                    *(u32x4*)(rowp + bj * HALF) = pack8(v0, v1); } }
    }
};

template <class Epi, class Sched, bool ALIGN_EPI = false, bool SP2 = false>
__device__ __forceinline__ void gemm_phase(PG8_LAS unsigned char* lds, const Gemm g, const Sched& S, const Epi& E) {
    int tid_l = threadIdx.x; asm volatile("" : "+v"(tid_l));
    const int tid = tid_l, wid = __builtin_amdgcn_readfirstlane(tid >> 6), lane = tid & 63, wr = wid >> 2, wc = wid & 3, fr = lane & 15, fq = lane >> 4;
    const int K = g.K, nt = K / BK, LDK = g.ldk;
    unsigned voffA[2], voffB[2];
#pragma unroll
    for (int i = 0; i < 2; ++i) { int R, C; stage_rc(tid * 16 + i * 8192, R, C); const int Rb = Epi::PERM ? ((R & ~31) + perm32(R & 31)) : R;
        voffA[i] = (unsigned)(R * LDK + C) * 2u; voffB[i] = (unsigned)(Rb * LDK + C) * 2u; }
    const size_t kstep = (size_t)(BK * 2);
    const size_t hstep = (size_t)HALF * LDK * 2;
    const size_t tstep = 2 * hstep;
    const unsigned ldsw = (unsigned)wid * 1024u;
    const int aoff = lds_byte(wr * 64 + fr, fq * 8), boff = lds_byte(wc * 32 + fr, fq * 8);
#define PG8_SA(b, h) (((b) * 2 + (h)) * HTB)
#define PG8_SB(b, h) ((4 + (b) * 2 + (h)) * HTB)
#define PG8_STAGE(bufoff, gbase, voff) do { _Pragma("unroll") for (int _i = 0; _i < 2; ++_i) \
        __builtin_amdgcn_global_load_lds((const unsigned*)((const char*)(gbase) + (voff)[_i]), (PG8_LAS unsigned*)(lds + (bufoff) + ldsw + _i * 8192), 16, 0, 0); } while (0)
#define PG8_LDA(dst, b, h) do { _Pragma("unroll") for (int m = 0; m < 4; ++m) _Pragma("unroll") for (int k = 0; k < 2; ++k) dst[m][k] = *(const PG8_LAS bf16x8*)(lds + PG8_SA(b, h) + aoff + m * 2048 + k * 1024); } while (0)
#define PG8_LDB(dst, b, h) do { _Pragma("unroll") for (int n = 0; n < 2; ++n) _Pragma("unroll") for (int k = 0; k < 2; ++k) dst[n][k] = *(const PG8_LAS bf16x8*)(lds + PG8_SB(b, h) + boff + n * 2048 + k * 1024); } while (0)
#define PG8_MMA(ai, bj, At, Bt) do { __builtin_amdgcn_s_setprio(1); _Pragma("unroll") for (int m = 0; m < 4; ++m) _Pragma("unroll") for (int n = 0; n < 2; ++n) _Pragma("unroll") for (int k = 0; k < 2; ++k) \
        acc[ai][bj][m][n] = __builtin_amdgcn_mfma_f32_16x16x32_bf16(Bt[n][k], At[m][k], acc[ai][bj][m][n], 0, 0, 0); __builtin_amdgcn_s_setprio(0); } while (0)
#define PG8_WAIT_V(n) asm volatile("s_waitcnt vmcnt(" #n ")" ::: "memory")
#define PG8_WAIT_L(n) asm volatile("s_waitcnt lgkmcnt(" #n ")" ::: "memory")
#define PG8_BAR __builtin_amdgcn_s_barrier()
#define PG8_SCHED __builtin_amdgcn_sched_barrier(0)
    Unit cur, nxt; int ui = 0;
    if (!S.next(0, cur)) return;
    f32x4 acc[2][2][4][2];
#pragma unroll
    for (int a = 0; a < 2; ++a)
#pragma unroll
        for (int b = 0; b < 2; ++b)
#pragma unroll
            for (int m = 0; m < 4; ++m)
#pragma unroll
                for (int n = 0; n < 2; ++n) acc[a][b][m][n] = (f32x4){0.f, 0.f, 0.f, 0.f};
    bf16x8 At[4][2], B0[2][2], B1[2][2];
    const char* cA = (const char*)g.A + (size_t)cur.pm * tstep; const char* cB = (const char*)g.Bt + (size_t)cur.pn * tstep;
    S.a_ready(cur);
    if constexpr (SP2) {
        PG8_STAGE(PG8_SB(0, 0), cB, voffB); PG8_STAGE(PG8_SB(0, 1), cB + hstep, voffB); PG8_STAGE(PG8_SA(0, 0), cA, voffA); PG8_STAGE(PG8_SA(0, 1), cA + hstep, voffA);
        if (wr == 1) PG8_BAR;
        PG8_WAIT_V(2); PG8_BAR;
        PG8_STAGE(PG8_SB(1, 0), cB + kstep, voffB); PG8_STAGE(PG8_SA(1, 0), cA + kstep, voffA); PG8_STAGE(PG8_SB(1, 1), cB + hstep + kstep, voffB);
        PG8_WAIT_V(6); PG8_BAR;
    } else {
        PG8_STAGE(PG8_SB(0, 0), cB, voffB); PG8_STAGE(PG8_SA(0, 0), cA, voffA); PG8_STAGE(PG8_SB(0, 1), cB + hstep, voffB); PG8_STAGE(PG8_SA(0, 1), cA + hstep, voffA);
        if (wr == 1) PG8_BAR;
        PG8_WAIT_V(4); PG8_BAR;
        PG8_STAGE(PG8_SB(1, 0), cB + kstep, voffB); PG8_STAGE(PG8_SA(1, 0), cA + kstep, voffA); PG8_STAGE(PG8_SB(1, 1), cB + hstep + kstep, voffB);
        PG8_WAIT_V(6); PG8_BAR;
    }
    for (;;) {
        const bool has_next = S.next(ui + 1, nxt);
        const char* nA = has_next ? (const char*)g.A + (size_t)nxt.pm * tstep : cA; const char* nB = has_next ? (const char*)g.Bt + (size_t)nxt.pn * tstep : cB;
        for (int t = 0; t < nt; t += 2) {
            const bool last = (t == nt - 2);
            const char* a1 = cA + (size_t)(t + 1) * kstep;
            const char* a2 = last ? nA : cA + (size_t)(t + 2) * kstep; const char* b2 = last ? nB : cB + (size_t)(t + 2) * kstep;
            const char* a3 = a2 + kstep; const char* b3 = b2 + kstep;
            if (last && has_next) S.a_ready(nxt);
            if constexpr (SP2) {
            PG8_LDB(B0, 0, 0); PG8_LDB(B1, 0, 1); PG8_SCHED; PG8_LDA(At, 0, 0); PG8_STAGE(PG8_SA(1, 1), a1 + hstep, voffA);
            PG8_WAIT_V(8); PG8_WAIT_L(0); PG8_BAR; PG8_MMA(0, 0, At, B0); PG8_MMA(0, 1, At, B1); PG8_BAR; PG8_SCHED;
            PG8_LDA(At, 0, 1); PG8_STAGE(PG8_SB(0, 0), b2, voffB); PG8_STAGE(PG8_SB(0, 1), b2 + hstep, voffB); PG8_STAGE(PG8_SA(0, 0), a2, voffA);
            PG8_WAIT_V(8); PG8_WAIT_L(0); PG8_BAR; PG8_MMA(1, 0, At, B0); PG8_MMA(1, 1, At, B1); PG8_BAR; PG8_SCHED;
            PG8_LDB(B0, 1, 0); PG8_LDB(B1, 1, 1); PG8_SCHED; PG8_LDA(At, 1, 0); PG8_STAGE(PG8_SA(0, 1), a2 + hstep, voffA);
            PG8_WAIT_V(8); PG8_WAIT_L(0); PG8_BAR; PG8_MMA(0, 0, At, B0); PG8_MMA(0, 1, At, B1); PG8_BAR; PG8_SCHED;
            PG8_LDA(At, 1, 1); PG8_STAGE(PG8_SB(1, 0), b3, voffB); PG8_STAGE(PG8_SB(1, 1), b3 + hstep, voffB); PG8_STAGE(PG8_SA(1, 0), a3, voffA);
            PG8_WAIT_V(8); PG8_WAIT_L(0); PG8_BAR; PG8_MMA(1, 0, At, B0); PG8_MMA(1, 1, At, B1); PG8_BAR; PG8_SCHED;
            } else {
            PG8_LDB(B0, 0, 0); PG8_SCHED; PG8_LDA(At, 0, 0); PG8_STAGE(PG8_SA(1, 1), a1 + hstep, voffA);
            PG8_WAIT_L(8); PG8_BAR; PG8_WAIT_L(0); PG8_MMA(0, 0, At, B0); PG8_BAR; PG8_SCHED;
            PG8_LDB(B1, 0, 1); PG8_STAGE(PG8_SB(0, 0), b2, voffB);
            PG8_BAR; PG8_WAIT_L(0); PG8_MMA(0, 1, At, B1); PG8_BAR;
            PG8_LDA(At, 0, 1); PG8_STAGE(PG8_SA(0, 0), a2, voffA);
            PG8_BAR; PG8_WAIT_L(0); PG8_MMA(1, 0, At, B0); PG8_BAR; PG8_SCHED;
            PG8_STAGE(PG8_SB(0, 1), b2 + hstep, voffB);
            PG8_WAIT_V(6); PG8_BAR; PG8_MMA(1, 1, At, B1); PG8_BAR;
            PG8_LDB(B0, 1, 0); PG8_SCHED; PG8_LDA(At, 1, 0); PG8_STAGE(PG8_SA(0, 1), a2 + hstep, voffA);
            PG8_WAIT_L(8); PG8_BAR; PG8_WAIT_L(0); PG8_MMA(0, 0, At, B0); PG8_BAR; PG8_SCHED;
            PG8_LDB(B1, 1, 1); PG8_STAGE(PG8_SB(1, 0), b3, voffB);
            PG8_BAR; PG8_WAIT_L(0); PG8_MMA(0, 1, At, B1); PG8_BAR;
            PG8_LDA(At, 1, 1); PG8_STAGE(PG8_SA(1, 0), a3, voffA);
            PG8_BAR; PG8_WAIT_L(0); PG8_MMA(1, 0, At, B0); PG8_BAR; PG8_SCHED;
            PG8_STAGE(PG8_SB(1, 1), b3 + hstep, voffB);
            PG8_WAIT_V(6); PG8_BAR; PG8_MMA(1, 1, At, B1); PG8_BAR;
            }
        }
        if constexpr (ALIGN_EPI) { if (wr == 0) PG8_BAR; }
        if constexpr (!Epi::AFTER_DRAIN) { E(acc, cur, wr, wc, fr, fq); S.done(cur); }
        if (!has_next) break;
#pragma unroll
        for (int a = 0; a < 2; ++a)
#pragma unroll
            for (int b = 0; b < 2; ++b)
#pragma unroll
                for (int m = 0; m < 4; ++m)
#pragma unroll
                    for (int n = 0; n < 2; ++n) acc[a][b][m][n] = (f32x4){0.f, 0.f, 0.f, 0.f};
        cur = nxt; cA = nA; cB = nB; ++ui;
        if constexpr (ALIGN_EPI) { if (wr == 1) PG8_BAR; }
    }
    PG8_WAIT_V(0);
    if constexpr (!ALIGN_EPI) { if (wr == 0) PG8_BAR; }
    PG8_BAR;
    if constexpr (Epi::AFTER_DRAIN) { E.fused(acc, cur, wr, wc, fr, fq, lds, wid, lane); S.done(cur); }
#undef PG8_SA
#undef PG8_SB
#undef PG8_STAGE
#undef PG8_LDA
#undef PG8_LDB
#undef PG8_MMA
#undef PG8_WAIT_V
#undef PG8_WAIT_L
#undef PG8_BAR
#undef PG8_SCHED
}
}

typedef unsigned short bf16;
typedef float f32x4 __attribute__((ext_vector_type(4)));
typedef float f32x2 __attribute__((ext_vector_type(2)));
typedef unsigned u32x4 __attribute__((ext_vector_type(4)));
typedef unsigned u32x2 __attribute__((ext_vector_type(2)));
typedef GAS unsigned gu32;
#define RLX_AGENT __ATOMIC_RELAXED, __HIP_MEMORY_SCOPE_AGENT

constexpr int D = 2048, NB = 4, SEQ = 2048, LC = 256, TT = SEQ + LC, M = NB * TT, FF = 5632, DEPTH = 4;
constexpr int NWAVES = 8, NTHREADS = 512;
constexpr float EPS = 1e-6f;
constexpr int GLA_N = 6176, GLA_NP = 6400, SWA_N = 2560, GM_N = 4096;
static_assert(M == 9216 && M % 256 == 0, "row panels");

constexpr size_t MiB = 1u << 20;
constexpr size_t WS_CTL = 0, CTL_ZERO_BYTES = 1 * MiB;
constexpr size_t WS_MOD = 1 * MiB;
constexpr size_t WS_ROPE = 2 * MiB;
constexpr size_t WS_STAT = 3 * MiB;
constexpr size_t WS_A32 = 4 * MiB;
constexpr size_t WS_W = 8 * MiB;
constexpr size_t WS_FFNW = WS_W, FFNW_STRIDE = 66 * MiB, FFNW_W2 = 44 * MiB;
constexpr size_t WS_GLAW = WS_W + 264 * MiB, GLAW_STRIDE = 33 * MiB, GLAW_WO = 25 * MiB;
constexpr size_t WS_SWAW = WS_GLAW + 66 * MiB, SWAW_WO = 10 * MiB;
constexpr size_t WS_GMW = WS_SWAW + 18 * MiB, GMW_WO = 16 * MiB;
constexpr size_t WS_X = 384 * MiB;
constexpr size_t WS_Y = 456 * MiB;
constexpr size_t WS_HA = 528 * MiB;
constexpr size_t WS_HFF = 564 * MiB;
constexpr size_t WS_MIX = 664 * MiB;
constexpr size_t MIX_GQ = 0, MIX_GK = 18 * MiB, MIX_GV = 36 * MiB, MIX_GOG = 72 * MiB, MIX_GOF = 108 * MiB, MIX_GOB = 144 * MiB;
constexpr size_t MIX_GQT = 180 * MiB, MIX_GKT = 216 * MiB, MIX_GVT = 252 * MiB, MIX_GATT = 288 * MiB, MIX_GDEC = 298 * MiB;
constexpr size_t MIX_SQ = 0, MIX_SK = 36 * MiB, MIX_SV = 41 * MiB;
constexpr size_t MIX_U = 0, MIX_V = 36 * MiB;
constexpr size_t WS_YP = 968 * MiB;
constexpr size_t WS_END = 1000 * MiB;
static_assert(WS_GMW + 24 * MiB <= WS_X && WS_HFF + (size_t)M * FF * 2 <= WS_MIX, "d_ws map");
constexpr int CW_BAR = 4096;

constexpr int RING_BYTES = 131072, LDS_BYTES = 163840, LDSCTL_OFF = LDS_BYTES - 1024, MISC_OFF = LDSCTL_OFF + 320;

#define LDS_WAIT() asm volatile("s_waitcnt lgkmcnt(0)" ::: "memory")
#define VM_WAIT() asm volatile("s_waitcnt vmcnt(0)" ::: "memory")
__device__ __forceinline__ unsigned pk2(float lo, float hi) { return pg8::cvt_pk_bf16(lo, hi); }
__device__ __forceinline__ unsigned f2bf(float f) { return pg8::cvt_pk_bf16(f, 0.f) & 0xffffu; }
__device__ __forceinline__ float bf2f(unsigned short b) { return __builtin_bit_cast(float, (unsigned)b << 16); }
__device__ __forceinline__ float bflo(unsigned u) { return __builtin_bit_cast(float, u << 16); }
__device__ __forceinline__ float bfhi(unsigned u) { return __builtin_bit_cast(float, u & 0xffff0000u); }
__device__ __forceinline__ float wave_sum(float v) {
#pragma unroll
    for (int o = 1; o < 64; o <<= 1) v += __shfl_xor(v, o);
    return v;
}
__device__ __forceinline__ float wave_max(float v) {
#pragma unroll
    for (int o = 1; o < 64; o <<= 1) v = fmaxf(v, __shfl_xor(v, o));
    return v;
}

#define XB_TMO      128
#define XB_XCNT(j)  (256  + 64 * (j))
#define XB_XSUB(j)  (1280 + 64 * (j))
#define XB_XGEN(j)  (2304 + 64 * (j))
#define XB_TOP      3328
#define XB_TOPGEN   3392
#define XCD_BAR_WORDS 3456
#define XB_SPIN_CAP (1u << 18)

__device__ __forceinline__ unsigned xb_ld(unsigned* p)              { return __hip_atomic_load(p, __ATOMIC_RELAXED, __HIP_MEMORY_SCOPE_AGENT); }
__device__ __forceinline__ unsigned xb_add(unsigned* p, unsigned v) { return __hip_atomic_fetch_add(p, v, __ATOMIC_RELAXED, __HIP_MEMORY_SCOPE_AGENT); }
__device__ __forceinline__ unsigned xb_xcc_id() { return (unsigned)__builtin_amdgcn_s_getreg((3 << 11) | 20) & 0xFu; }
#define XB_SPIN(cond, bar) do { unsigned _sp = 0; while (cond) { __builtin_amdgcn_s_sleep(1); \
    if ((++_sp & 255u) == 0u) { if (xb_ld(&(bar)[XB_TMO])) break; if (_sp > XB_SPIN_CAP) { atomicAdd(&(bar)[XB_TMO], 1u); break; } } } } while (0)

struct XcdBarrier {
    unsigned* bar; unsigned x;
    volatile LAS unsigned* st;
};

__device__ __forceinline__ XcdBarrier xcd_barrier_post(unsigned* bar, volatile LAS unsigned* st) {
    XcdBarrier b; b.bar = bar; b.x = xb_xcc_id(); b.st = st;
    if (threadIdx.x == 0) (void)xb_add(&bar[XB_XCNT(b.x)], 1u);
    return b;
}
__device__ __forceinline__ void xcd_barrier_complete(unsigned* bar, unsigned x, unsigned& nloc, unsigned& nx) {
    const unsigned G = gridDim.x * gridDim.y * gridDim.z;
    unsigned sum, cnt, mine, sp = 0u;
    for (;;) {
        sum = 0u; cnt = 0u; mine = 0u;
#pragma unroll
        for (unsigned j = 0; j < 16; ++j) { const unsigned c = xb_ld(&bar[XB_XCNT(j)]); sum += c; cnt += (c > 0u) ? 1u : 0u; mine = (j == x) ? c : mine; }
        if (sum == G) break;
        __builtin_amdgcn_s_sleep(1);
        if ((++sp & 255u) == 0u) { if (xb_ld(&bar[XB_TMO])) break; if (sp > XB_SPIN_CAP) { atomicAdd(&bar[XB_TMO], 1u); break; } }
    }
    nloc = mine > 0u ? mine : 1u; nx = cnt > 0u ? cnt : 1u;
}

__device__ __forceinline__ void xcd_barrier(const XcdBarrier& b) {
    asm volatile("s_waitcnt vmcnt(0)" ::: "memory");
    __syncthreads();
    if (threadIdx.x == 0) {
        unsigned* bar = b.bar;
        __builtin_amdgcn_s_waitcnt(0);
        unsigned nloc = b.st[0], nx = b.st[1];
        if (nloc == 0u) { xcd_barrier_complete(bar, b.x, nloc, nx); b.st[0] = nloc; b.st[1] = nx; }
        const unsigned old = xb_add(&bar[XB_XSUB(b.x)], 1u);
        const unsigned gen = old / nloc;
        if (old + 1u == (gen + 1u) * nloc) {
            __builtin_amdgcn_fence(__ATOMIC_RELEASE, "agent");
            asm volatile("s_waitcnt vmcnt(0)" ::: "memory");
            const unsigned og = xb_add(&bar[XB_TOP], 1u);
            const unsigned tg = og / nx;
            if (og + 1u == (tg + 1u) * nx) xb_add(&bar[XB_TOPGEN], 1u);
            else XB_SPIN(xb_ld(&bar[XB_TOPGEN]) == tg, bar);
            __builtin_amdgcn_fence(__ATOMIC_ACQUIRE, "agent");
            xb_add(&bar[XB_XGEN(b.x)], 1u);
            asm volatile("s_waitcnt vmcnt(0)" ::: "memory");
        } else {
            XB_SPIN(xb_ld(&bar[XB_XGEN(b.x)]) == gen, bar);
            __builtin_amdgcn_fence(__ATOMIC_ACQUIRE, "agent");
            asm volatile("s_waitcnt vmcnt(0)" ::: "memory");
        }
    }
    __syncthreads();
}

struct Args { const float* in[24]; float* out; unsigned char* ws; int ph_lo, ph_hi; };

__device__ __forceinline__ unsigned char* OPQ(unsigned char* p) { asm volatile("" : "+s"(p)); return p; }
__device__ __forceinline__ const float* OPQF(const float* p) { asm volatile("" : "+s"(p)); return p; }
__device__ __forceinline__ const float* input_row(const float* x, const float* ctx, int r) {
    const int b = r / TT, t = r - b * TT;
    return t < LC ? ctx + ((size_t)b * LC + t) * D : x + ((size_t)b * SEQ + (t - LC)) * D;
}

__device__ __forceinline__ void p0_transpose_item(const float* W, int K, int N, bf16* WT, int drow0, int k0, int n0, LAS float* scr, int lane) {
    const int n4 = lane & 15, kr = lane >> 4; const bool ok = (n0 + 4 * n4) < N;
    const float* wp = W + (size_t)(k0 + kr) * N + n0 + 4 * n4;
    f32x4 v[16];
#pragma unroll
    for (int i = 0; i < 16; ++i) v[i] = ok ? __builtin_nontemporal_load((const GAS f32x4*)(wp + (size_t)(4 * i) * N)) : (f32x4){0.f, 0.f, 0.f, 0.f};
#pragma unroll
    for (int i = 0; i < 16; ++i)
#pragma unroll
        for (int q = 0; q < 4; ++q) scr[(4 * i + kr) * 65 + 4 * n4 + q] = v[i][q];
    LDS_WAIT(); asm volatile("" ::: "memory");
    const int c = lane & 7;
#pragma unroll
    for (int jj = 0; jj < 8; ++jj) { const int n = (lane >> 3) + 8 * jj; const LAS float* s = scr + (8 * c) * 65 + n;
        u32x4 o; o.x = pk2(s[0 * 65], s[1 * 65]); o.y = pk2(s[2 * 65], s[3 * 65]); o.z = pk2(s[4 * 65], s[5 * 65]); o.w = pk2(s[6 * 65], s[7 * 65]);
        if (n0 + n < N) *(GAS u32x4*)(WT + (size_t)(drow0 + n) * K + k0 + 8 * c) = o; }
    LDS_WAIT(); asm volatile("" ::: "memory");
}
constexpr int I_FF = 2816, I_FFL = 3 * I_FF, I_GIN = 32 * 97, I_SQ = 32 * 32, I_GLA = I_GIN + I_SQ, I_SWA = 32 * 40 + I_SQ, I_GM = 32 * 64 + I_SQ;
constexpr int IT_G0 = 0, IT_F0 = IT_G0 + I_GLA, IT_SW = IT_F0 + I_FFL, IT_F1 = IT_SW + I_SWA, IT_GM = IT_F1 + I_FFL, IT_F2 = IT_GM + I_GM, IT_G1 = IT_F2 + I_FFL, IT_F3 = IT_G1 + I_GLA, N_TR_ITEMS = IT_F3 + I_FFL;
static_assert(I_FF == (D / 64) * (FF / 64) && I_FF == (FF / 64) * (D / 64) && GLA_N == 96 * 64 + 32 && N_TR_ITEMS == 47424, "transpose items");
#ifndef REACH
#define REACH 0
#endif
#ifndef Q_IN
#define Q_IN 12
#endif
#ifndef Q_WO
#define Q_WO 3
#endif
#ifndef Q_DN
#define Q_DN 5
#endif
#ifndef PROLOGUE_UNTIL
#define PROLOGUE_UNTIL IT_F0
#endif
constexpr int CW_STEAL = 64;
__device__ __forceinline__ int tr_need(int p) {
    if (p < 8) return IT_F0;
    if (p < 9) return IT_F0 + 2 * I_FF;   if (p < 11) return IT_SW;
    if (p < 17) return IT_F1;             if (p < 18) return IT_F1 + 2 * I_FF;   if (p < 20) return IT_GM;
    if (p < 26) return IT_F2;             if (p < 27) return IT_F2 + 2 * I_FF;   if (p < 29) return IT_G1;
    if (p < 35) return IT_F3;             if (p < 36) return IT_F3 + 2 * I_FF;   return N_TR_ITEMS;
}
__device__ __forceinline__ void tr_do_item(const Args& a, int it, LAS float* scr, int lane) {
    unsigned char* ws = OPQ(a.ws);
    int r = it; const float* src; bf16* dst; int K = D, N, nblk, dmode = 0, l = 0; int grp;
    if (r < IT_F0) { grp = 0; l = 0; } else if (r < IT_SW) { grp = 1; l = 0; r -= IT_F0; } else if (r < IT_F1) { grp = 2; r -= IT_SW; } else if (r < IT_GM) { grp = 1; l = 1; r -= IT_F1; }
    else if (r < IT_F2) { grp = 3; r -= IT_GM; } else if (r < IT_G1) { grp = 1; l = 2; r -= IT_F2; } else if (r < IT_F3) { grp = 0; l = 1; r -= IT_G1; } else { grp = 1; l = 3; r -= IT_F3; }
    if (grp == 1) { const int which = r / I_FF; r -= which * I_FF;
        if (which < 2) { src = OPQF(a.in[which ? 8 : 7]) + (size_t)l * D * FF; N = FF; nblk = FF / 64; dst = (bf16*)(ws + WS_FFNW + l * FFNW_STRIDE); dmode = 1 + which; }
        else { src = OPQF(a.in[9]) + (size_t)l * FF * D; K = FF; N = D; nblk = D / 64; dst = (bf16*)(ws + WS_FFNW + l * FFNW_STRIDE + FFNW_W2); } }
    else if (grp == 0) {
        if (r < I_GIN) { src = OPQF(a.in[10]) + (size_t)l * D * GLA_N; N = GLA_N; nblk = 97; dst = (bf16*)(ws + WS_GLAW + l * GLAW_STRIDE); }
        else { r -= I_GIN; src = OPQF(a.in[14]) + (size_t)l * D * D; N = D; nblk = 32; dst = (bf16*)(ws + WS_GLAW + l * GLAW_STRIDE + GLAW_WO); } }
    else if (grp == 2) {
        if (r < 32 * 40) { src = OPQF(a.in[15]); N = SWA_N; nblk = 40; dst = (bf16*)(ws + WS_SWAW); }
        else { r -= 32 * 40; src = OPQF(a.in[17]); N = D; nblk = 32; dst = (bf16*)(ws + WS_SWAW + SWAW_WO); } }
    else {
        if (r < 32 * 64) { src = OPQF(a.in[18]); N = GM_N; nblk = 64; dst = (bf16*)(ws + WS_GMW); }
        else { r -= 32 * 64; src = OPQF(a.in[23]); N = D; nblk = 32; dst = (bf16*)(ws + WS_GMW + GMW_WO); } }
    const int kb = r / nblk, nb = r - kb * nblk, k0 = 64 * kb, n0 = 64 * nb;
    const int drow0 = dmode == 0 ? n0 : ((n0 >> 7) * 256 + (dmode - 1) * 128 + (n0 & 127));
    p0_transpose_item(src, K, N, dst, drow0, k0, n0, scr, lane);
}
__device__ __forceinline__ void tr_pull(const Args& a, LAS unsigned char* lds, int wave, int lane, int until, int max_batches) {
    gu32* ctr = (gu32*)(OPQ(a.ws) + WS_CTL) + CW_STEAL;
    LAS float* scr = (LAS float*)(lds + wave * 16640);
    volatile LAS unsigned* bc = (volatile LAS unsigned*)(lds + MISC_OFF);
    if (until > N_TR_ITEMS) until = N_TR_ITEMS;
    for (int k = 0; k < max_batches; ++k) {
        __syncthreads();
        if (threadIdx.x == 0) { unsigned v = 0xffffffffu; if ((int)__hip_atomic_load(ctr, RLX_AGENT) < until) v = __hip_atomic_fetch_add(ctr, 16u, RLX_AGENT); bc[0] = v; }
        __syncthreads();
        const unsigned base = bc[0];
        if (base == 0xffffffffu || (int)base >= N_TR_ITEMS) break;
#pragma unroll 1
        for (int q = 0; q < 2; ++q) { const int it = (int)base + 8 * q + wave; if (it < N_TR_ITEMS) tr_do_item(a, it, scr, lane); }
    }
}
__device__ __forceinline__ void xcd_barrier_steal(const XcdBarrier& b, const Args& a, LAS unsigned char* lds, int wave, int lane) {
    asm volatile("s_waitcnt vmcnt(0)" ::: "memory");
    __syncthreads();
    volatile LAS unsigned* bc = (volatile LAS unsigned*)(lds + MISC_OFF);
    LAS float* scr = (LAS float*)(lds + wave * 16640);
    unsigned gen = 0u; bool waiter = false;
    if (threadIdx.x == 0) {
        unsigned* bar = b.bar;
        __builtin_amdgcn_s_waitcnt(0);
        unsigned nloc = b.st[0], nx = b.st[1];
        if (nloc == 0u) { xcd_barrier_complete(bar, b.x, nloc, nx); b.st[0] = nloc; b.st[1] = nx; }
        const unsigned old = xb_add(&bar[XB_XSUB(b.x)], 1u);
        gen = old / nloc;
        if (old + 1u == (gen + 1u) * nloc) {
            __builtin_amdgcn_fence(__ATOMIC_RELEASE, "agent");
            asm volatile("s_waitcnt vmcnt(0)" ::: "memory");
            const unsigned og = xb_add(&bar[XB_TOP], 1u);
            const unsigned tg = og / nx;
            if (og + 1u == (tg + 1u) * nx) xb_add(&bar[XB_TOPGEN], 1u);
            else XB_SPIN(xb_ld(&bar[XB_TOPGEN]) == tg, bar);
            __builtin_amdgcn_fence(__ATOMIC_ACQUIRE, "agent");
            xb_add(&bar[XB_XGEN(b.x)], 1u);
            asm volatile("s_waitcnt vmcnt(0)" ::: "memory");
        } else waiter = true;
    }
#pragma unroll 1
    for (;;) {
        if (threadIdx.x == 0) {
            unsigned v = 0xffffffffu;
            if (waiter) {
                unsigned* bar = b.bar;
                gu32* ctr = (gu32*)(OPQ(a.ws) + WS_CTL) + CW_STEAL;
                if (xb_ld(&bar[XB_XGEN(b.x)]) == gen) {
                    if ((int)__hip_atomic_load(ctr, RLX_AGENT) < N_TR_ITEMS) v = __hip_atomic_fetch_add(ctr, 8u, RLX_AGENT);
                    if ((int)v >= N_TR_ITEMS || v == 0xffffffffu) { v = 0xffffffffu; XB_SPIN(xb_ld(&bar[XB_XGEN(b.x)]) == gen, bar); }
                }
                if (v == 0xffffffffu) { __builtin_amdgcn_fence(__ATOMIC_ACQUIRE, "agent"); asm volatile("s_waitcnt vmcnt(0)" ::: "memory"); }
            }
            bc[0] = v;
        }
        __syncthreads();
        const unsigned base = bc[0];
        if (base == 0xffffffffu) break;
        { const int it = (int)base + wave; if (it < N_TR_ITEMS) tr_do_item(a, it, scr, lane); }
        __syncthreads();
    }
    __syncthreads();
}
__device__ __forceinline__ void adaln_unit(const Args& a, LAS unsigned char* lds, int tid, int wave, int lane, int l, int cb) {
    LAS float* SL = (LAS float*)lds;
    LAS float* PART = (LAS float*)(lds + 40960);
    const float* cvec = OPQF(a.in[1]); const float* cctx = OPQF(a.in[3]); const float* ada_w = OPQF(a.in[4]); const float* ada_b = OPQF(a.in[5]);
    float* MOD = (float*)(OPQ(a.ws) + WS_MOD);
    __syncthreads();
    for (int e = tid; e < 5 * D; e += NTHREADS) { const int mi = e / D, k = e - mi * D; const float cv = mi < 4 ? cvec[mi * D + k] : cctx[k]; SL[e] = cv / (1.0f + expf(-cv)); }
    __syncthreads();
    {
        const bool on = lane < 48;
        f32x4 acc[5];
#pragma unroll
        for (int mi = 0; mi < 5; ++mi) acc[mi] = (f32x4){0.f, 0.f, 0.f, 0.f};
        const float* wp = ada_w + ((size_t)l * D + 256 * wave) * (6 * D) + 192 * cb + 4 * (on ? lane : 0);
        const LAS float* sl = SL + 256 * wave;
#pragma unroll 2
        for (int k4 = 0; k4 < 256; k4 += 8) {
            f32x4 wv[8];
#pragma unroll
            for (int q = 0; q < 8; ++q) wv[q] = *(const GAS f32x4*)(wp + (size_t)(k4 + q) * (6 * D));
#pragma unroll
            for (int mi = 0; mi < 5; ++mi) { const f32x4 s4 = *(const LAS f32x4*)(sl + mi * D + k4), s5 = *(const LAS f32x4*)(sl + mi * D + k4 + 4);
#pragma unroll
                for (int q = 0; q < 4; ++q) { acc[mi] += wv[q] * s4[q]; acc[mi] += wv[4 + q] * s5[q]; } }
        }
        if (on) {
#pragma unroll
            for (int mi = 0; mi < 5; ++mi) *(LAS f32x4*)(PART + (wave * 5 + mi) * 192 + 4 * lane) = acc[mi]; }
        __syncthreads();
        for (int e = tid; e < 5 * 192; e += NTHREADS) { const int mi = e / 192, cc = e - mi * 192; float s = ada_b[l * 6 * D + 192 * cb + cc];
#pragma unroll
            for (int w = 0; w < 8; ++w) s += PART[(w * 5 + mi) * 192 + cc];
            MOD[(size_t)(l * 5 + mi) * (6 * D) + 192 * cb + cc] = s; }
        __syncthreads();
    }
}
__device__ __forceinline__ void p0_rope(const Args& a, int tid) {
    float* RC = (float*)(OPQ(a.ws) + WS_ROPE); float* RS = RC + 1024;
    for (int e = tid; e < 1024; e += NTHREADS) {
        const int pos = e >> 4, f = e & 15;
        double inv = 1.0; for (int i = 0; i < f; ++i) inv *= 0.56234132519034908;
        const double x = (double)pos * (double)(float)inv;
        const double twopi = 6.283185307179586476925;
        const double n = __builtin_rint(x * (1.0 / twopi)); const double r = x - n * twopi;
        double s = r, c = 1.0, ts = r, tc = 1.0; const double r2 = r * r;
#pragma unroll
        for (int i = 1; i <= 16; ++i) { tc = -tc * r2 * (1.0 / (double)((2 * i - 1) * (2 * i))); c += tc; ts = -ts * r2 * (1.0 / (double)((2 * i) * (2 * i + 1))); s += ts; }
        RC[e] = (float)c; RS[e] = (float)s;
    }
}

__device__ __forceinline__ void load_row8(const float* p, int lane, f32x4 (&v)[8]) {
#pragma unroll
    for (int j = 0; j < 8; ++j) v[j] = *(const GAS f32x4*)(p + (64 * j + lane) * 4);
}
__device__ __forceinline__ float sumsq8(const f32x4 (&v)[8]) { float s = 0.f;
#pragma unroll
    for (int j = 0; j < 8; ++j) s += (v[j].x * v[j].x + v[j].y * v[j].y) + (v[j].z * v[j].z + v[j].w * v[j].w);
    return s; }
__device__ __forceinline__ void store_h8(bf16* hrow, int lane, const f32x4 (&v)[8]) {
#pragma unroll
    for (int j = 0; j < 8; ++j) { u32x2 w; w.x = pk2(v[j].x, v[j].y); w.y = pk2(v[j].z, v[j].w); *(GAS u32x2*)(hrow + (64 * j + lane) * 4) = w; }
}
__device__ __forceinline__ void wave_rows(int rb, int wave, int& r0, int& nr) { nr = wave < 4 ? 5 : 4; r0 = rb * 36 + (wave < 4 ? 5 * wave : 20 + 4 * (wave - 4)); }

__device__ __forceinline__ void norm0_phase(const Args& a, int wave, int lane, int wg, int G) {
    const float* MOD = (const float*)(OPQ(a.ws) + WS_MOD); const float* ng = OPQF(a.in[6]); bf16* HA = (bf16*)(OPQ(a.ws) + WS_HA);
    for (int rb = wg; rb < 256; rb += G) {
        int r0, nr; wave_rows(rb, wave, r0, nr);
        int cur = -1; f32x4 cB[8], cC[8];
        for (int r = r0; r < r0 + nr; ++r) {
            const int b = r / TT, t = r - b * TT, mi = t < LC ? 4 : b;
            if (mi != cur) { cur = mi; const float* mod = MOD + (size_t)mi * (6 * D); f32x4 g[8], sc[8];
                load_row8(ng, lane, g); load_row8(mod + D, lane, sc); load_row8(mod, lane, cC);
#pragma unroll
                for (int j = 0; j < 8; ++j) cB[j] = g[j] * (1.0f + sc[j]); }
            f32x4 x[8]; load_row8(input_row(OPQF(a.in[0]), OPQF(a.in[2]), r), lane, x);
            const float rs = 1.0f / sqrtf(wave_sum(sumsq8(x)) * (1.0f / D) + EPS);
#pragma unroll
            for (int j = 0; j < 8; ++j) x[j] = x[j] * rs * cB[j] + cC[j];
            store_h8(HA + (size_t)r * D, lane, x);
        }
    }
}
__device__ __forceinline__ void load_xrow(const float* fin, const bf16* Xb, bool from_input, int lane, f32x4 (&x)[8]) {
    if (from_input) load_row8(fin, lane, x);
    else {
#pragma unroll
        for (int j = 0; j < 8; ++j) { const u32x2 w = *(const GAS u32x2*)(Xb + (64 * j + lane) * 4); x[j] = (f32x4){bflo(w.x), bfhi(w.x), bflo(w.y), bfhi(w.y)}; } }
}
template <int WHICH> __device__ __forceinline__ void resid_phase(const Args& a, int l, LAS unsigned char* lds, int tid, int wave, int lane, int wg, int G) {
    const float* MOD = (const float*)(OPQ(a.ws) + WS_MOD); const float* ng = OPQF(a.in[6]);
    bf16* X = (bf16*)(OPQ(a.ws) + WS_X); const bf16* Y = (const bf16*)(OPQ(a.ws) + WS_Y); bf16* HA = (bf16*)(OPQ(a.ws) + WS_HA);
    const float* YP = (const float*)(OPQ(a.ws) + WS_YP); const float* xin = OPQF(a.in[0]); const float* cin = OPQF(a.in[2]);
    const bool last = (l == DEPTH - 1), final_out = last && WHICH == 1, from_input = (l == 0 && WHICH == 0);
    LAS float* PAR = (LAS float*)lds;
    for (int rb = wg; rb < 256; rb += G) {
        const int bb = (rb * 36) / TT;
        __syncthreads();
#pragma unroll
        for (int slot = 0; slot < 2; ++slot) { const int mi = slot ? bb : 4; const float* mod = MOD + (size_t)(l * 5 + mi) * (6 * D);
            const f32x4 gt = *(const GAS f32x4*)(mod + (WHICH ? 5 : 2) * D + 4 * tid), gy = *(const GAS f32x4*)(ng + (size_t)(l * 4 + (WHICH ? 3 : 1)) * D + 4 * tid);
            *(LAS f32x4*)(PAR + (slot * 3 + 0) * D + 4 * tid) = gt * gy;
            if (!final_out) { const float* gn = WHICH ? ng + (size_t)((l + 1) * 4) * D : ng + (size_t)(l * 4 + 2) * D;
                const float* modn = WHICH ? MOD + (size_t)((l + 1) * 5 + mi) * (6 * D) : mod;
                const f32x4 g = *(const GAS f32x4*)(gn + 4 * tid), sc = *(const GAS f32x4*)(modn + (WHICH ? 1 : 4) * D + 4 * tid), sh = *(const GAS f32x4*)(modn + (WHICH ? 0 : 3) * D + 4 * tid);
                *(LAS f32x4*)(PAR + (slot * 3 + 1) * D + 4 * tid) = g * (1.0f + sc); *(LAS f32x4*)(PAR + (slot * 3 + 2) * D + 4 * tid) = sh; } }
        __syncthreads();
        int r0, nr; wave_rows(rb, wave, r0, nr);
        f32x4 x[8], xn[8]; u32x2 yb[8], ybn[8];
        { const int r = r0; const int b = r / TT, t = r - b * TT;
          load_xrow(from_input ? input_row(xin, cin, r) : nullptr, X + (size_t)r * D, from_input, lane, x);
          if (t >= LC) {
#pragma unroll
              for (int j = 0; j < 8; ++j) yb[j] = *(const GAS u32x2*)(Y + (size_t)r * D + (64 * j + lane) * 4); } }
#pragma unroll 1
        for (int r = r0; r < r0 + nr; ++r) {
            const int b = r / TT, t = r - b * TT;
            if (r + 1 < r0 + nr) { const int rn = r + 1, bn = rn / TT, tn = rn - bn * TT;
                load_xrow(from_input ? input_row(xin, cin, rn) : nullptr, X + (size_t)rn * D, from_input, lane, xn);
                if (tn >= LC) {
#pragma unroll
                    for (int j = 0; j < 8; ++j) ybn[j] = *(const GAS u32x2*)(Y + (size_t)rn * D + (64 * j + lane) * 4); } }
            if (!(last && t < LC)) {
            const LAS float* par = PAR + (t < LC ? 0 : 3 * D);
            f32x4 y[8];
            if (t < LC) { const float* yp = YP + (size_t)(b * LC + t) * D; load_row8(yp, lane, y);
#pragma unroll
                for (int sl = 1; sl < 4; ++sl) { f32x4 pp[8]; load_row8(yp + (size_t)sl * (NB * LC) * D, lane, pp);
#pragma unroll
                    for (int j = 0; j < 8; ++j) y[j] += pp[j]; } }
            else {
#pragma unroll
                for (int j = 0; j < 8; ++j) y[j] = (f32x4){bflo(yb[j].x), bfhi(yb[j].x), bflo(yb[j].y), bfhi(yb[j].y)}; }
            const float rs = 1.0f / sqrtf(wave_sum(sumsq8(y)) * (1.0f / D) + EPS);
#pragma unroll
            for (int j = 0; j < 8; ++j) x[j] = x[j] + *(const LAS f32x4*)(par + (64 * j + lane) * 4) * (y[j] * rs);
            if (final_out) { float* xd = a.out + ((size_t)b * SEQ + (t - LC)) * D;
#pragma unroll
                for (int j = 0; j < 8; ++j) *(GAS f32x4*)(xd + (64 * j + lane) * 4) = x[j]; }
            else {
                store_h8(X + (size_t)r * D, lane, x);
                const float rs2 = 1.0f / sqrtf(wave_sum(sumsq8(x)) * (1.0f / D) + EPS);
#pragma unroll
                for (int j = 0; j < 8; ++j) x[j] = x[j] * rs2 * *(const LAS f32x4*)(par + D + (64 * j + lane) * 4) + *(const LAS f32x4*)(par + 2 * D + (64 * j + lane) * 4);
                store_h8(HA + (size_t)r * D, lane, x);
            }
            }
#pragma unroll
            for (int j = 0; j < 8; ++j) { x[j] = xn[j]; yb[j] = ybn[j]; }
        }
    }
}

typedef float f32x16 __attribute__((ext_vector_type(16)));
typedef short bf16x8v __attribute__((ext_vector_type(8)));
constexpr int GL_ST = 528;
__device__ __forceinline__ float log_sigmoid_f(float z) { return fminf(z, 0.f) - __logf(1.0f + __expf(-fabsf(z))); }
template <int DIR> __device__ __forceinline__ void gla_prep_unit(const Args& a, int slot, int u, LAS unsigned char* lds, int tid, int wave, int lane) {
    LAS float* As = (LAS float*)lds;
    LAS float* TOT = (LAS float*)(lds + 4096);
    LAS unsigned char* Qs = lds + 8192;
    LAS unsigned char* Ks = lds + 8192 + 64 * GL_ST;
    LAS unsigned char* Vs = lds + 8192 + 128 * GL_ST;
    const bf16* Q = (const bf16*)(OPQ(a.ws) + WS_MIX + MIX_GQ); const bf16* Kb = (const bf16*)(OPQ(a.ws) + WS_MIX + MIX_GK); const bf16* V = (const bf16*)(OPQ(a.ws) + WS_MIX + MIX_GV);
    bf16* QT = (bf16*)(OPQ(a.ws) + WS_MIX + MIX_GQT); bf16* KT = (bf16*)(OPQ(a.ws) + WS_MIX + MIX_GKT); bf16* VT = (bf16*)(OPQ(a.ws) + WS_MIX + MIX_GVT); bf16* ATT = (bf16*)(OPQ(a.ws) + WS_MIX + MIX_GATT); float* DEC = (float*)(OPQ(a.ws) + WS_MIX + MIX_GDEC);
    const float* A32 = (const float*)(OPQ(a.ws) + WS_A32);
    const int c = (u >> 1) % 36, bh = (u >> 1) / 36, h = bh & 3, b = bh >> 2;
    const size_t row0 = (size_t)b * TT + 64 * c;
    const int kk = tid & 255, hf = tid >> 8;
    __syncthreads();
    for (int e = tid; e < 1024; e += NTHREADS) As[e] = A32[(row0 + (e >> 4)) * 32 + 16 * DIR + (e & 15)];
#pragma unroll
    for (int q = 0; q < 4; ++q) { const int e = tid + NTHREADS * q, i = e >> 5, ch = e & 31; *(LAS u32x4*)(Vs + i * GL_ST + 16 * ch) = *(const GAS u32x4*)(V + (row0 + i) * 2048 + h * 512 + 256 * DIR + 8 * ch); }
    unsigned short qraw[32], kraw[32];
    { const bf16* qp = Q + (row0 + 32 * hf) * 1024 + h * 256 + kk; const bf16* kp = Kb + (row0 + 32 * hf) * 1024 + h * 256 + kk;
#pragma unroll
      for (int p = 0; p < 32; ++p) { qraw[p] = qp[(size_t)p * 1024]; kraw[p] = kp[(size_t)p * 1024]; } }
    const float bias = OPQF(a.in[12])[(size_t)(slot * 2 + DIR) * 1024 + h * 256 + kk];
    LAS float* Zs = (LAS float*)(lds + 8192);
    float bq[2][4];
    { const float* wp = OPQF(a.in[11]) + (size_t)(slot * 2 + DIR) * 16 * 1024 + h * 256 + (lane & 15);
#pragma unroll
      for (int t2 = 0; t2 < 2; ++t2)
#pragma unroll
          for (int ks = 0; ks < 4; ++ks) bq[t2][ks] = wp[(size_t)(4 * ks + (lane >> 4)) * 1024 + 16 * (2 * wave + t2)]; }
    __syncthreads();
#pragma unroll
    for (int tm = 0; tm < 4; ++tm) { float aq[4];
#pragma unroll
        for (int ks = 0; ks < 4; ++ks) aq[ks] = As[(16 * tm + (lane & 15)) * 16 + 4 * ks + (lane >> 4)];
#pragma unroll
        for (int t2 = 0; t2 < 2; ++t2) { f32x4 zc = (f32x4){0.f, 0.f, 0.f, 0.f};
#pragma unroll
            for (int ks = 0; ks < 4; ++ks) zc = __builtin_amdgcn_mfma_f32_16x16x4f32(aq[ks], bq[t2][ks], zc, 0, 0, 0);
#pragma unroll
            for (int r = 0; r < 4; ++r) Zs[(16 * tm + 4 * (lane >> 4) + r) * 256 + 16 * (2 * wave + t2) + (lane & 15)] = zc[r]; } }
    __syncthreads();
    float lc[32]; float run = 0.f;
#pragma unroll
    for (int s = 0; s < 32; ++s) { const int p = DIR ? 31 - s : s, i = 32 * hf + p; const float z = bias + Zs[i * 256 + kk];
        run += log_sigmoid_f(z) * 0.0625f; lc[p] = run; }
    TOT[hf * 256 + kk] = run;
    __syncthreads();
    const float tot0 = TOT[kk], tot1 = TOT[256 + kk];
    const float off = DIR ? (hf == 0 ? tot1 : 0.f) : (hf == 1 ? tot0 : 0.f);
    const float dec = expf(tot0 + tot1);
    {
#pragma unroll
      for (int p = 0; p < 32; ++p) { const int i = 32 * hf + p; const float bb = lc[p] + off, eb = __expf(bb), ebi = __expf(-bb);
        const float qv = bf2f(qraw[p]), kv = bf2f(kraw[p]);
        const unsigned short qt = (unsigned short)f2bf(qv * eb); *(LAS unsigned short*)(Qs + i * GL_ST + 2 * kk) = qt;
        const float kh = kv * ebi; *(LAS unsigned short*)(Ks + i * GL_ST + 2 * kk) = (unsigned short)f2bf(kh); lc[p] = kh * dec; } }
#pragma unroll
    for (int g = 0; g < 4; ++g) { u32x4 o;
#pragma unroll
        for (int q = 0; q < 4; ++q) o[q] = pk2(lc[8 * g + 2 * q], lc[8 * g + 2 * q + 1]);
        *(GAS u32x4*)(KT + ((size_t)u * 256 + kk) * 64 + 32 * hf + 8 * g) = o; }
    if (hf == 0) DEC[(size_t)u * 256 + kk] = dec;
    __syncthreads();
#pragma unroll
    for (int q = 0; q < 4; ++q) { const int e = tid + NTHREADS * q, i = e >> 5, ch = e & 31; *(GAS u32x4*)(QT + ((size_t)u * 64 + i) * 256 + 8 * ch) = *(const LAS u32x4*)(Qs + i * GL_ST + 16 * ch); }
    { const int tr = wave >> 1, tc0 = (wave & 1) * 2, l15 = lane & 15, kq = lane >> 4;
      f32x4 acc[2] = {(f32x4){0.f, 0.f, 0.f, 0.f}, (f32x4){0.f, 0.f, 0.f, 0.f}};
#pragma unroll
      for (int s = 0; s < 8; ++s) { const bf16x8v af = *(const LAS bf16x8v*)(Qs + (16 * tr + l15) * GL_ST + (32 * s + 8 * kq) * 2);
#pragma unroll
          for (int t2 = 0; t2 < 2; ++t2) { const bf16x8v bfr = *(const LAS bf16x8v*)(Ks + (16 * (tc0 + t2) + l15) * GL_ST + (32 * s + 8 * kq) * 2);
              acc[t2] = __builtin_amdgcn_mfma_f32_16x16x32_bf16(af, bfr, acc[t2], 0, 0, 0); } }
#pragma unroll
      for (int t2 = 0; t2 < 2; ++t2)
#pragma unroll
          for (int r = 0; r < 4; ++r) { const int i = 16 * tr + 4 * kq + r, j = 16 * (tc0 + t2) + l15; const bool keep = DIR ? (j >= i) : (j <= i);
              ATT[((size_t)u * 64 + i) * 64 + j] = (bf16)f2bf(keep ? acc[t2][r] : 0.f); } }
    { bf16* vt = VT + ((size_t)(u >> 1) * 512 + 256 * DIR + kk) * 64 + 32 * hf;
#pragma unroll
      for (int g = 0; g < 4; ++g) { u32x4 o;
#pragma unroll
          for (int q = 0; q < 4; ++q) { const int i = 32 * hf + 8 * g + 2 * q;
              o[q] = (unsigned)*(const LAS unsigned short*)(Vs + i * GL_ST + 2 * kk) | ((unsigned)*(const LAS unsigned short*)(Vs + (i + 1) * GL_ST + 2 * kk) << 16); }
          *(GAS u32x4*)(vt + 8 * g) = o; } }
}
__device__ __forceinline__ void gla_prep_phase(const Args& a, int slot, LAS unsigned char* lds, int tid, int wave, int lane, int wg, int G) {
    for (int u = wg; u < 1152; u += G) { if (u & 1) gla_prep_unit<1>(a, slot, u, lds, tid, wave, lane); else gla_prep_unit<0>(a, slot, u, lds, tid, wave, lane); }
}
constexpr int GS_VST = 144, GS_STB = 64 * GL_ST, GS_VSB = 64 * GS_VST;
struct ScanB { bf16x8v Qf[8], Af[2]; };
struct ScanC { bf16x8v Kf[2][4]; };
__device__ __forceinline__ int scan_chunk(int dir, int n) { return dir ? (n < 4 ? 3 - n : 39 - n) : n; }
__device__ __forceinline__ void scan_load_b(ScanB& o, const bf16* QT, const bf16* ATT, size_t u, int wave, int l15, int kq) {
#pragma unroll
    for (int s = 0; s < 8; ++s) o.Qf[s] = *(const GAS bf16x8v*)(QT + (u * 64 + 16 * wave + l15) * 256 + 32 * s + 8 * kq);
#pragma unroll
    for (int s = 0; s < 2; ++s) o.Af[s] = *(const GAS bf16x8v*)(ATT + (u * 64 + 16 * wave + l15) * 64 + 32 * s + 8 * kq);
}
__device__ __forceinline__ void scan_load_c(ScanC& o, const bf16* KT, size_t u, int cw, int r32, int hi) {
#pragma unroll
    for (int mt = 0; mt < 2; ++mt)
#pragma unroll
        for (int s = 0; s < 4; ++s) o.Kf[mt][s] = *(const GAS bf16x8v*)(KT + (u * 256 + 64 * cw + 32 * mt + r32) * 64 + 16 * s + 8 * hi);
}
__device__ __forceinline__ void scan_part_o(const ScanB& o, LAS unsigned char* os, const LAS unsigned char* stp, const LAS unsigned char* vs, int wave, int l15, int kq) {
    f32x4 oacc[4];
#pragma unroll
    for (int t4 = 0; t4 < 4; ++t4) oacc[t4] = (f32x4){0.f, 0.f, 0.f, 0.f};
    bf16x8v bfr[2][4];
#pragma unroll
    for (int t4 = 0; t4 < 4; ++t4) bfr[0][t4] = *(const LAS bf16x8v*)(stp + (16 * t4 + l15) * GL_ST + (8 * kq) * 2);
#pragma unroll
    for (int g = 0; g < 10; ++g) {
        if (g + 1 < 10) { const int s = g + 1;
#pragma unroll
            for (int t4 = 0; t4 < 4; ++t4) bfr[(g + 1) & 1][t4] = s < 8 ? *(const LAS bf16x8v*)(stp + (16 * t4 + l15) * GL_ST + (32 * s + 8 * kq) * 2)
                                                                         : *(const LAS bf16x8v*)(vs + (16 * t4 + l15) * GS_VST + (32 * (s - 8) + 8 * kq) * 2); }
#pragma unroll
        for (int t4 = 0; t4 < 4; ++t4) oacc[t4] = __builtin_amdgcn_mfma_f32_16x16x32_bf16(g < 8 ? o.Qf[g] : o.Af[g - 8], bfr[g & 1][t4], oacc[t4], 0, 0, 0);
    }
#pragma unroll
    for (int t4 = 0; t4 < 4; ++t4)
#pragma unroll
        for (int r = 0; r < 4; ++r) *(LAS unsigned short*)(os + (16 * wave + 4 * kq + r) * GS_VST + (16 * t4 + l15) * 2) = (unsigned short)f2bf(oacc[t4][r]);
}
__device__ __forceinline__ void scan_part_s(const ScanC& oc, f32x16 (&S)[2][2], LAS unsigned char* stn, const LAS unsigned char* vs, const LAS float* decs, int cw, int r32, int hi) {
    bf16x8v vfr[4][2];
#pragma unroll
    for (int s = 0; s < 4; ++s)
#pragma unroll
        for (int nt = 0; nt < 2; ++nt) vfr[s][nt] = *(const LAS bf16x8v*)(vs + (32 * nt + r32) * GS_VST + (16 * s + 8 * hi) * 2);
#pragma unroll
    for (int mt = 0; mt < 2; ++mt)
#pragma unroll
        for (int g = 0; g < 4; ++g) { const f32x4 dc = *(const LAS f32x4*)(decs + 64 * cw + 32 * mt + 8 * g + 4 * hi);
#pragma unroll
            for (int nt = 0; nt < 2; ++nt)
#pragma unroll
                for (int q = 0; q < 4; ++q) S[mt][nt][4 * g + q] *= dc[q]; }
#pragma unroll
    for (int s = 0; s < 4; ++s)
#pragma unroll
        for (int mt = 0; mt < 2; ++mt)
#pragma unroll
            for (int nt = 0; nt < 2; ++nt) S[mt][nt] = __builtin_amdgcn_mfma_f32_32x32x16_bf16(oc.Kf[mt][s], vfr[s][nt], S[mt][nt], 0, 0, 0);
#pragma unroll
    for (int mt = 0; mt < 2; ++mt)
#pragma unroll
        for (int nt = 0; nt < 2; ++nt)
#pragma unroll
            for (int g = 0; g < 4; ++g) { u32x2 w2; w2.x = pg8::cvt_pk_bf16(S[mt][nt][4 * g], S[mt][nt][4 * g + 1]); w2.y = pg8::cvt_pk_bf16(S[mt][nt][4 * g + 2], S[mt][nt][4 * g + 3]);
                *(LAS u32x2*)(stn + (32 * nt + r32) * GL_ST + (64 * cw + 32 * mt + 8 * g + 4 * hi) * 2) = w2; }
}
__device__ __forceinline__ void scan_flush_o(const LAS unsigned char* os, bf16* O, int b, int h, int c, int dvs, int tid) {
    const u32x4 v = *(const LAS u32x4*)(os + (tid >> 3) * GS_VST + 16 * (tid & 7));
    bf16* op = O + ((size_t)b * TT + 64 * c + (tid >> 3)) * 2048 + h * 512 + 64 * dvs + 8 * (tid & 7);
    asm volatile("s_waitcnt lgkmcnt(0)\n\tglobal_store_dwordx4 %0, %1, off\n\ts_nop 2" :: "v"(op), "v"(v) : "memory");
}
template <bool OW> __device__ __forceinline__ void gla_scan_body(const Args& a, LAS unsigned char* lds, int tid, int wave, int lane, int wg, int G) {
    const bf16* QT = (const bf16*)(OPQ(a.ws) + WS_MIX + MIX_GQT); const bf16* KT = (const bf16*)(OPQ(a.ws) + WS_MIX + MIX_GKT); const bf16* VT = (const bf16*)(OPQ(a.ws) + WS_MIX + MIX_GVT);
    const bf16* ATT = (const bf16*)(OPQ(a.ws) + WS_MIX + MIX_GATT); const float* DEC = (const float*)(OPQ(a.ws) + WS_MIX + MIX_GDEC);
    LAS unsigned char* ST = lds; LAS unsigned char* Vs = lds + 2 * GS_STB; LAS unsigned char* Os = lds + 2 * GS_STB + 2 * GS_VSB; LAS float* DECs = (LAS float*)(lds + 2 * GS_STB + 4 * GS_VSB);
    const int l15 = lane & 15, kq = lane >> 4, r32 = lane & 31, hi = lane >> 5, cw = wave & 3;
    const int vso = (tid >> 3) * GS_VST + 16 * (tid & 7);
    for (int item = wg; item < 256; item += G) {
        const int dvs = (item >> 3) & 7, combo = (item & 7) * 4 + (item >> 6), dir = combo & 1, h = (combo >> 1) & 3, b = combo >> 3, bh = b * 4 + h;
        bf16* O = (bf16*)(OPQ(a.ws) + WS_MIX + (dir ? MIX_GOB : MIX_GOF));
        __syncthreads();
        for (int e = tid; e < GS_STB / 16; e += NTHREADS) *(LAS u32x4*)(ST + GS_STB + 16 * e) = (u32x4){0u, 0u, 0u, 0u};
        f32x16 S[2][2];
#pragma unroll
        for (int mt = 0; mt < 2; ++mt)
#pragma unroll
            for (int nt = 0; nt < 2; ++nt)
#pragma unroll
                for (int i = 0; i < 16; ++i) S[mt][nt][i] = 0.f;
        ScanB BA, BB; ScanC CA, CB; u32x4 vA, vB; f32x4 dA = (f32x4){0.f, 0.f, 0.f, 0.f}, dB = dA;
#define SCAN_BAR() do { asm volatile("s_waitcnt lgkmcnt(0)" ::: "memory"); __builtin_amdgcn_s_barrier(); asm volatile("" ::: "memory"); } while (0)
#define SCAN_LOAD(BS, CS, vr, dr, n_) do { const int c_ = scan_chunk(dir, (n_)); const size_t uv_ = (size_t)bh * 36 + c_, u_ = uv_ * 2 + dir; \
            vr = *(const GAS u32x4*)(VT + (uv_ * 512 + 64 * dvs + (tid >> 3)) * 64 + 8 * (tid & 7)); if (tid < 64) dr = *(const GAS f32x4*)(DEC + u_ * 256 + 4 * tid); \
            if constexpr (OW) scan_load_b(BS, QT, ATT, u_, wave, l15, kq); else scan_load_c(CS, KT, u_, cw, r32, hi); } while (0)
#define SCAN_STAGE(vr, dr, buf) do { *(LAS u32x4*)(Vs + (buf) * GS_VSB + vso) = vr; if (tid < 64) *(LAS f32x4*)(DECs + (buf) * 256 + 4 * tid) = dr; } while (0)
#define SCAN_STEP(BS, CS, n_) do { const int n__ = (n_); if constexpr (OW) scan_part_o(BS, Os + (n__ & 1) * GS_VSB, ST + ((n__ + 1) & 1) * GS_STB, Vs + (n__ & 1) * GS_VSB, wave, l15, kq); \
            else scan_part_s(CS, S, ST + (n__ & 1) * GS_STB, Vs + (n__ & 1) * GS_VSB, DECs + (n__ & 1) * 256, cw, r32, hi); } while (0)
        SCAN_LOAD(BA, CA, vA, dA, 0);
        SCAN_STAGE(vA, dA, 0);
        SCAN_LOAD(BB, CB, vB, dB, 1);
        SCAN_BAR();
#pragma unroll 1
        for (int n = 0; n < 36; n += 2) {
            SCAN_STEP(BA, CA, n);
            SCAN_STAGE(vB, dB, 1);
            if (n > 0) scan_flush_o(Os + GS_VSB, O, b, h, scan_chunk(dir, n - 1), dvs, tid);
            SCAN_LOAD(BA, CA, vA, dA, n + 2 < 36 ? n + 2 : 35);
            SCAN_BAR();
            SCAN_STEP(BB, CB, n + 1);
            SCAN_STAGE(vA, dA, 0);
            scan_flush_o(Os, O, b, h, scan_chunk(dir, n), dvs, tid);
            SCAN_LOAD(BB, CB, vB, dB, n + 3 < 36 ? n + 3 : 35);
            SCAN_BAR();
        }
        scan_flush_o(Os + GS_VSB, O, b, h, scan_chunk(dir, 35), dvs, tid);
#undef SCAN_BAR
#undef SCAN_LOAD
#undef SCAN_STAGE
#undef SCAN_STEP
    }
}
__device__ __forceinline__ void gla_scan_phase(const Args& a, LAS unsigned char* lds, int tid, int wave, int lane, int wg, int G) {
    if (wave < 4) gla_scan_body<true>(a, lds, tid, wave, lane, wg, G); else gla_scan_body<false>(a, lds, tid, wave, lane, wg, G);
}
__device__ __forceinline__ void gla_onorm_phase(const Args& a, int slot, bool skip_ctx, int lane, int gw, int ngw) {
    const bf16* OF = (const bf16*)(OPQ(a.ws) + WS_MIX + MIX_GOF); const bf16* OB = (const bf16*)(OPQ(a.ws) + WS_MIX + MIX_GOB); const bf16* OG = (const bf16*)(OPQ(a.ws) + WS_MIX + MIX_GOG);
    const float* og_g = OPQF(a.in[13]) + (size_t)slot * D; bf16* HA = (bf16*)(OPQ(a.ws) + WS_HA);
    for (int r = gw; r < M; r += ngw) {
        if (skip_ctx && (r % TT) < LC) continue;
#pragma unroll
        for (int hh = 0; hh < 4; ++hh) {
            const size_t off = (size_t)r * D + hh * 512 + 8 * lane;
            const u32x4 f = *(const GAS u32x4*)(OF + off), bk = *(const GAS u32x4*)(OB + off), g = *(const GAS u32x4*)(OG + off);
            float o[8];
#pragma unroll
            for (int q = 0; q < 4; ++q) { o[2 * q] = bflo(f[q]) + bflo(bk[q]); o[2 * q + 1] = bfhi(f[q]) + bfhi(bk[q]); }
            float ss = 0.f;
#pragma unroll
            for (int q = 0; q < 8; ++q) ss += o[q] * o[q];
            const float rs = 1.0f / sqrtf(wave_sum(ss) * (1.0f / 512.0f) + EPS);
            const f32x4 w0 = *(const GAS f32x4*)(og_g + hh * 512 + 8 * lane), w1 = *(const GAS f32x4*)(og_g + hh * 512 + 8 * lane + 4);
            u32x4 w;
#pragma unroll
            for (int q = 0; q < 4; ++q) { const float wa = q < 2 ? w0[2 * q] : w1[2 * q - 4], wb = q < 2 ? w0[2 * q + 1] : w1[2 * q - 3];
                w[q] = pk2(o[2 * q] * rs * wa * bflo(g[q]), o[2 * q + 1] * rs * wb * bfhi(g[q])); }
            *(GAS u32x4*)(HA + off) = w;
        }
    }
}

constexpr int ATT_KST = 144, ATT_VST = 136, ATT_KB = 64 * ATT_KST, ATT_VB = 64 * ATT_VST;
__device__ __forceinline__ void swa_attn_phase(const Args& a, bool skip_ctx, LAS unsigned char* lds, int tid, int wave, int lane, int wg, int G) {
    const bf16* SQ = (const bf16*)(OPQ(a.ws) + WS_MIX + MIX_SQ); const bf16* SK = (const bf16*)(OPQ(a.ws) + WS_MIX + MIX_SK); const bf16* SVT = (const bf16*)(OPQ(a.ws) + WS_MIX + MIX_SV);
    const float* sink = OPQF(a.in[16]); bf16* HA = (bf16*)(OPQ(a.ws) + WS_HA);
    LAS unsigned char* Kb = lds; LAS unsigned char* Vb = lds + 2 * ATT_KB;
    const int r32 = lane & 31, hi = lane >> 5, srow = tid >> 3, sch = tid & 7;
    const int nunits = skip_ctx ? 512 : 576;
    for (int ui = wg; ui < nunits; ui += G) {
        const bool lat = ui < 512;
        int b, kvh, qb; { const int w = ui & 255, x = w & 7, s = w >> 3;
            if (lat) { const int combo = 2 * x + (ui >> 8); b = combo >> 2; kvh = combo & 3; qb = s; }
            else { const int combo = 2 * x + (s & 1); b = combo >> 2; kvh = combo & 3; qb = (s >> 1) & 3; } }
        const int head = kvh * 8 + wave;
        const int tq0 = lat ? LC + 64 * qb : 64 * qb;
        const int w_lo = qb - 2 < 0 ? 0 : qb - 2, w_hi = qb + 2 > 31 ? 31 : qb + 2;
        const int ntile = lat ? 4 + (w_hi - w_lo + 1) : 4;
        const bf16* kbase = SK + (size_t)b * TT * 256 + kvh * 64 + (size_t)srow * 256 + 8 * sch;
        const bf16* vbase = SVT + ((size_t)(b * 4 + kvh) * 64 + srow) * TT + 8 * sch;
        bf16x8v Qf[2][4];
#pragma unroll
        for (int nt = 0; nt < 2; ++nt)
#pragma unroll
            for (int ks = 0; ks < 4; ++ks) Qf[nt][ks] = *(const GAS bf16x8v*)(SQ + ((size_t)b * TT + tq0 + 32 * nt + r32) * D + head * 64 + 16 * ks + 8 * hi);
        const float sink2 = sink[head] * 1.4426950408889634f;
        float m2[2] = {sink2, sink2}, ls[2] = {hi ? 0.f : 1.f, hi ? 0.f : 1.f};
        f32x16 O[2][2];
#pragma unroll
        for (int dt = 0; dt < 2; ++dt)
#pragma unroll
            for (int nt = 0; nt < 2; ++nt)
#pragma unroll
                for (int i = 0; i < 16; ++i) O[dt][nt][i] = 0.f;
        u32x4 kreg, vreg;
        { const int t0 = 0; kreg = *(const GAS u32x4*)(kbase + (size_t)t0 * 256); vreg = *(const GAS u32x4*)(vbase + t0); }
        *(LAS u32x4*)(Kb + srow * ATT_KST + 16 * sch) = kreg;
        *(LAS u32x2*)(Vb + srow * ATT_VST + 16 * sch) = (u32x2){vreg.x, vreg.y}; *(LAS u32x2*)(Vb + srow * ATT_VST + 16 * sch + 8) = (u32x2){vreg.z, vreg.w};
        __syncthreads();
#pragma unroll 1
        for (int j = 0; j < ntile; ++j) {
            const int buf = j & 1;
            if (j + 1 < ntile) { const int jn = j + 1; const int t0 = jn < 4 ? 64 * jn : LC + 64 * (w_lo + jn - 4);
                kreg = *(const GAS u32x4*)(kbase + (size_t)t0 * 256); vreg = *(const GAS u32x4*)(vbase + t0); }
            const int rel = j < 4 ? 0 : (w_lo + j - 4) - qb;
            const bool masked = (rel == 2 || rel == -2);
            const LAS unsigned char* kt = Kb + buf * ATT_KB; const LAS unsigned char* vt = Vb + buf * ATT_VB;
#pragma unroll
            for (int nt = 0; nt < 2; ++nt) {
                f32x16 s[2];
#pragma unroll
                for (int mt = 0; mt < 2; ++mt) {
#pragma unroll
                    for (int i = 0; i < 16; ++i) s[mt][i] = -m2[nt];
#pragma unroll
                    for (int ks = 0; ks < 4; ++ks) { const bf16x8v kf = *(const LAS bf16x8v*)(kt + (32 * mt + r32) * ATT_KST + (16 * ks + 8 * hi) * 2);
                        s[mt] = __builtin_amdgcn_mfma_f32_32x32x16_bf16(kf, Qf[nt][ks], s[mt], 0, 0, 0); }
                }
                __builtin_amdgcn_sched_barrier(0);
                if (masked) {
                    int mb = r32 - 4 * hi - 64 * rel; asm volatile("" : "+v"(mb));
#pragma unroll
                    for (int mt = 0; mt < 2; ++mt)
#pragma unroll
                        for (int i = 0; i < 16; ++i) { const int cc = 32 * mt + (i & 3) + 8 * (i >> 2) - 32 * nt;
                            if (mb > 128 + cc || mb < cc - 128) s[mt][i] = -1e30f; }
                }
                float mx = s[0][0];
#pragma unroll
                for (int i = 1; i < 16; ++i) mx = fmaxf(mx, s[0][i]);
#pragma unroll
                for (int i = 0; i < 16; ++i) mx = fmaxf(mx, s[1][i]);
                mx = fmaxf(mx, __shfl_xor(mx, 32));
                if (__any(mx > 8.0f)) { const float dlt = fmaxf(mx, 0.f), alpha = __builtin_amdgcn_exp2f(-dlt); m2[nt] += dlt; ls[nt] *= alpha;
#pragma unroll
                    for (int mt = 0; mt < 2; ++mt)
#pragma unroll
                        for (int i = 0; i < 16; ++i) s[mt][i] -= dlt;
#pragma unroll
                    for (int dt = 0; dt < 2; ++dt)
#pragma unroll
                        for (int i = 0; i < 16; ++i) O[dt][nt][i] *= alpha; }
                float psum = 0.f;
#pragma unroll
                for (int mt = 0; mt < 2; ++mt)
#pragma unroll
                    for (int i = 0; i < 16; ++i) { s[mt][i] = __builtin_amdgcn_exp2f(s[mt][i]); psum += s[mt][i]; }
                ls[nt] += psum;
                __builtin_amdgcn_sched_barrier(0);
                bf16x8v Pf[2][2];
#pragma unroll
                for (int mt = 0; mt < 2; ++mt)
#pragma unroll
                    for (int s2 = 0; s2 < 2; ++s2) { u32x4 w;
#pragma unroll
                        for (int q = 0; q < 4; ++q) w[q] = pg8::cvt_pk_bf16(s[mt][8 * s2 + 2 * q], s[mt][8 * s2 + 2 * q + 1]);
                        Pf[mt][s2] = __builtin_bit_cast(bf16x8v, w); }
#pragma unroll
                for (int dt = 0; dt < 2; ++dt)
#pragma unroll
                    for (int mt = 0; mt < 2; ++mt)
#pragma unroll
                        for (int s2 = 0; s2 < 2; ++s2) { const LAS unsigned char* vp = vt + (32 * dt + r32) * ATT_VST + (32 * mt + 16 * s2 + 4 * hi) * 2;
                            const u32x2 lo = *(const LAS u32x2*)vp, hh = *(const LAS u32x2*)(vp + 16);
                            const bf16x8v vf = __builtin_bit_cast(bf16x8v, (u32x4){lo.x, lo.y, hh.x, hh.y});
                            O[dt][nt] = __builtin_amdgcn_mfma_f32_32x32x16_bf16(vf, Pf[mt][s2], O[dt][nt], 0, 0, 0); }
                __builtin_amdgcn_sched_barrier(0);
            }
            if (j + 1 < ntile) { const int nb = buf ^ 1;
                *(LAS u32x4*)(Kb + nb * ATT_KB + srow * ATT_KST + 16 * sch) = kreg;
                *(LAS u32x2*)(Vb + nb * ATT_VB + srow * ATT_VST + 16 * sch) = (u32x2){vreg.x, vreg.y}; *(LAS u32x2*)(Vb + nb * ATT_VB + srow * ATT_VST + 16 * sch + 8) = (u32x2){vreg.z, vreg.w}; }
            __syncthreads();
        }
#pragma unroll
        for (int nt = 0; nt < 2; ++nt) {
            const float lt = ls[nt] + __shfl_xor(ls[nt], 32), inv = 1.0f / lt;
            bf16* op = HA + ((size_t)b * TT + tq0 + 32 * nt + r32) * D + head * 64 + 4 * hi;
#pragma unroll
            for (int dt = 0; dt < 2; ++dt)
#pragma unroll
                for (int g = 0; g < 4; ++g) { u32x2 w; w.x = pg8::cvt_pk_bf16(O[dt][nt][4 * g] * inv, O[dt][nt][4 * g + 1] * inv); w.y = pg8::cvt_pk_bf16(O[dt][nt][4 * g + 2] * inv, O[dt][nt][4 * g + 3] * inv);
                    *(GAS u32x2*)(op + 32 * dt + 8 * g) = w; }
        }
    }
}

__device__ __forceinline__ void gmlp_stats_phase(const Args& a, bool skip_ctx, int lane, int gw, int ngw) {
    const bf16* V = (const bf16*)(OPQ(a.ws) + WS_MIX + MIX_V); float* MU = (float*)(OPQ(a.ws) + WS_STAT); float* RS = MU + M;
    for (int r = gw; r < M; r += ngw) {
        if (skip_ctx && (r % TT) < LC) continue;
        float v[32];
#pragma unroll
        for (int j = 0; j < 4; ++j) { const u32x4 w = *(const GAS u32x4*)(V + (size_t)r * D + 512 * j + 8 * lane);
#pragma unroll
            for (int q = 0; q < 4; ++q) { v[8 * j + 2 * q] = bflo(w[q]); v[8 * j + 2 * q + 1] = bfhi(w[q]); } }
        float s = 0.f;
#pragma unroll
        for (int j = 0; j < 32; ++j) s += v[j];
        const float mean = wave_sum(s) * (1.0f / D); float q2 = 0.f;
#pragma unroll
        for (int j = 0; j < 32; ++j) { const float d = v[j] - mean; q2 += d * d; }
        const float var = wave_sum(q2) * (1.0f / D);
        if (lane == 0) { MU[r] = mean; RS[r] = 1.0f / sqrtf(var + EPS); }
    }
}
constexpr int GM_ST = 272;
__device__ __forceinline__ void gmlp_spatial_phase(const Args& a, bool skip_ctx, LAS unsigned char* lds, int tid, int wave, int lane, int wg, int G) {
    LAS unsigned char* VT = lds;
    LAS unsigned char* WSs = lds + 128 * GM_ST;
    const bf16* U = (const bf16*)(OPQ(a.ws) + WS_MIX + MIX_U); const bf16* V = (const bf16*)(OPQ(a.ws) + WS_MIX + MIX_V);
    const float* MU = (const float*)(OPQ(a.ws) + WS_STAT); const float* RS = MU + M;
    const float* lng = OPQF(a.in[19]); const float* lnb = OPQF(a.in[20]); const float* wsp = OPQF(a.in[21]); const float* bs = OPQF(a.in[22]); bf16* HA = (bf16*)(OPQ(a.ws) + WS_HA);
    const int l15 = lane & 15, kq = lane >> 4;
    for (int g = wg & 15; g < 16; g += (G >= 16 ? 16 : G)) {
        if (G < 16 && false) {}
        const int C0 = 128 * g;
        __syncthreads();
        for (int e = tid; e < 128 * 32; e += NTHREADS) { const int i = e >> 5, j4 = e & 31; const f32x4 w = *(const GAS f32x4*)(wsp + (size_t)g * 16384 + i * 128 + 4 * j4);
            u32x2 o; o.x = pk2(w[0], w[1]); o.y = pk2(w[2], w[3]); *(LAS u32x2*)(WSs + i * GM_ST + 8 * j4) = o; }
        for (int n = wg >> 4; n < 72; n += (G >> 4 > 0 ? G >> 4 : 1)) {
            const int R0 = 128 * n;
            if (skip_ctx && (R0 % TT) < LC) continue;
            __syncthreads();
#pragma unroll
            for (int q = 0; q < 4; ++q) { const int e = tid + NTHREADS * q, j = e >> 4, c8 = (e & 15) * 8;
                const u32x4 vv = *(const GAS u32x4*)(V + (size_t)(R0 + j) * D + C0 + c8); const float mu = MU[R0 + j], rs = RS[R0 + j];
                const f32x4 g0 = *(const GAS f32x4*)(lng + C0 + c8), g1 = *(const GAS f32x4*)(lng + C0 + c8 + 4), b0 = *(const GAS f32x4*)(lnb + C0 + c8), b1 = *(const GAS f32x4*)(lnb + C0 + c8 + 4);
#pragma unroll
                for (int k = 0; k < 4; ++k) { const float x0 = (bflo(vv[k]) - mu) * rs, x1 = (bfhi(vv[k]) - mu) * rs;
                    const float ga = k < 2 ? g0[2 * k] : g1[2 * k - 4], gb = k < 2 ? g0[2 * k + 1] : g1[2 * k - 3], ba_ = k < 2 ? b0[2 * k] : b1[2 * k - 4], bb = k < 2 ? b0[2 * k + 1] : b1[2 * k - 3];
                    const int sw = ((((j >> 3) ^ (c8 >> 3)) & 15) << 4) + (j & 7) * 2;
                    *(LAS unsigned short*)(VT + (c8 + 2 * k) * GM_ST + sw) = (unsigned short)f2bf(x0 * ga + ba_);
                    *(LAS unsigned short*)(VT + (c8 + 2 * k + 1) * GM_ST + sw) = (unsigned short)f2bf(x1 * gb + bb); } }
            __syncthreads();
            bf16x8v Bf[4];
#pragma unroll
            for (int ks = 0; ks < 4; ++ks) Bf[ks] = *(const LAS bf16x8v*)(WSs + (16 * wave + l15) * GM_ST + (32 * ks + 8 * kq) * 2);
            const int i = 16 * wave + l15; const float bsv = bs[g * 128 + i];
            const size_t orow = (size_t)(R0 + i) * D + C0 + 4 * kq;
#pragma unroll
            for (int ct = 0; ct < 8; ++ct) { f32x4 acc = (f32x4){0.f, 0.f, 0.f, 0.f};
#pragma unroll
                for (int ks = 0; ks < 4; ++ks) { const int cr = 16 * ct + l15; const bf16x8v af = *(const LAS bf16x8v*)(VT + cr * GM_ST + ((((4 * ks + kq) ^ (cr >> 3)) & 15) << 4));
                    acc = __builtin_amdgcn_mfma_f32_16x16x32_bf16(af, Bf[ks], acc, 0, 0, 0); }
                const u32x2 uu = *(const GAS u32x2*)(U + orow + 16 * ct);
                u32x2 o; o.x = pk2(bflo(uu.x) * (acc[0] + bsv), bfhi(uu.x) * (acc[1] + bsv)); o.y = pk2(bflo(uu.y) * (acc[2] + bsv), bfhi(uu.y) * (acc[3] + bsv));
                *(GAS u32x2*)(HA + orow + 16 * ct) = o; }
        }
    }
}

#ifndef SITE_MASK
#define SITE_MASK 0x1ff
#endif
#define SITE(n) (((SITE_MASK) >> (n)) & 1)
#ifndef DUP_PHASE
#define DUP_PHASE (-1)
#endif
#define REPS(p) for (int rep_ = 0; rep_ < (((p) == DUP_PHASE) ? 2 : 1); ++rep_)
constexpr int N_PHASES = 2 + 9 * DEPTH;
__host__ __device__ constexpr bool phase_exists(int p) { if (p < 2) return true; const int q = (p - 2) % 9, kind = ((p - 2) / 9) % 3; return !((q == 2 && kind == 1) || (q == 3 && kind != 0)); }

__global__ void __launch_bounds__(NTHREADS, 2) trunk_fwd(Args args) {
    extern __shared__ __attribute__((aligned(16))) unsigned char lds_raw[];
    LAS unsigned char* lds = (LAS unsigned char*)lds_raw;
    const int wave = __builtin_amdgcn_readfirstlane((int)threadIdx.x >> 6);
#define FRESH_WS() unsigned char* ws = args.ws; asm volatile("" : "+s"(ws))
#define FRESH_TID() int tid_f = threadIdx.x; asm volatile("" : "+v"(tid_f)); const int tid = tid_f, lane = tid & 63; (void)lane
    const int G = gridDim.x, wg = blockIdx.x;
    const int gw = wg * NWAVES + wave, ngw = G * NWAVES;
    unsigned char* ws = args.ws;
    gu32* ctl = (gu32*)(OPQ(args.ws) + WS_CTL);
    for (int u = threadIdx.x; u < (LDS_BYTES - LDSCTL_OFF) / 4; u += NTHREADS) ((LAS unsigned*)(lds + LDSCTL_OFF))[u] = 0u;
    __syncthreads();
    XcdBarrier bar = xcd_barrier_post((unsigned*)(ctl + CW_BAR), (volatile LAS unsigned*)(lds + MISC_OFF) + 8);
    const int lo = args.ph_lo, hi = args.ph_hi;
#define IN(k) (lo <= (k) && (k) < hi)
#define PULL(until, quota) do { int tp_ = threadIdx.x; asm volatile("" : "+v"(tp_)); tr_pull(args, lds, wave, tp_ & 63, (until), (quota)); } while (0)
#define LIGHT(nunits) (((nunits) % G) != 0 && wg >= ((nunits) % G))
#ifndef STEAL_SEAMS
#define STEAL_SEAMS 1
#endif
#define SEAM_PLAIN(k) do { if ((k) + 1 < hi) { XcdBarrier bl = bar; asm volatile("" : "+s"(bl.bar)); xcd_barrier(bl); } } while (0)
#define SEAM_STEAL(k) do { if ((k) + 1 < hi) { XcdBarrier bl = bar; asm volatile("" : "+s"(bl.bar)); int ts_ = threadIdx.x; asm volatile("" : "+v"(ts_)); xcd_barrier_steal(bl, args, lds, wave, ts_ & 63); } } while (0)
#define SEAM(k) do { if (STEAL_SEAMS) SEAM_STEAL(k); else SEAM_PLAIN(k); } while (0)

    if (IN(0) && SITE(8)) { FRESH_TID(); REPS(0) { if (wg < 64) adaln_unit(args, lds, tid, wave, lane, 0, wg); if (wg == G - 1) p0_rope(args, tid); tr_pull(args, lds, wave, lane, PROLOGUE_UNTIL, 1 << 20); __syncthreads(); } SEAM(0); }
    if (IN(1) && SITE(8)) { FRESH_TID(); norm0_phase(args, wave, lane, wg, G); SEAM(1); }

    const pg8::bf16_t* HA = (const pg8::bf16_t*)(OPQ(args.ws) + WS_HA);
#pragma unroll 1
    for (int l = 0; l < DEPTH; ++l) {
        const int base = 2 + 9 * l, kind = l % 3, slot = l / 3;
        const bool last = (l == DEPTH - 1);
        if (IN(base + 0)) { REPS(base + 0) {
            if (kind == 0) {
                pg8::Gemm g{HA, (const pg8::bf16_t*)(OPQ(args.ws) + WS_GLAW + slot * GLAW_STRIDE), M, GLA_NP, D, D}; pg8::Sched S; S.init(M / 256, GLA_NP / 256, G, wg, 0);
                pg8::EpiGlaIn E{(pg8::bf16_t*)(OPQ(args.ws) + WS_MIX + MIX_GQ), (pg8::bf16_t*)(OPQ(args.ws) + WS_MIX + MIX_GK), (pg8::bf16_t*)(OPQ(args.ws) + WS_MIX + MIX_GV), (pg8::bf16_t*)(OPQ(args.ws) + WS_MIX + MIX_GOG), (float*)(OPQ(args.ws) + WS_A32)};
                if (SITE(0)) pg8::gemm_phase<pg8::EpiGlaIn, pg8::Sched, true, true>(lds, g, S, E);
            } else if (kind == 1) {
                pg8::Gemm g{HA, (const pg8::bf16_t*)(OPQ(args.ws) + WS_SWAW), M, SWA_N, D, D}; pg8::Sched S; S.init(M / 256, SWA_N / 256, G, wg, 0);
                pg8::EpiSwaIn E{(pg8::bf16_t*)(OPQ(args.ws) + WS_MIX + MIX_SQ), (pg8::bf16_t*)(OPQ(args.ws) + WS_MIX + MIX_SK), (pg8::bf16_t*)(OPQ(args.ws) + WS_MIX + MIX_SV), (const float*)(OPQ(args.ws) + WS_ROPE), (const float*)(OPQ(args.ws) + WS_ROPE) + 1024};
                if (SITE(1)) pg8::gemm_phase<pg8::EpiSwaIn, pg8::Sched, true, true>(lds, g, S, E);
            } else {
                pg8::Gemm g{HA, (const pg8::bf16_t*)(OPQ(args.ws) + WS_GMW), M, GM_N, D, D}; pg8::Sched S; S.init(M / 256, GM_N / 256, G, wg, 0);
                pg8::EpiGmlpIn E{(pg8::bf16_t*)(OPQ(args.ws) + WS_MIX + MIX_U), (pg8::bf16_t*)(OPQ(args.ws) + WS_MIX + MIX_V)};
                if (SITE(2)) pg8::gemm_phase<pg8::EpiGmlpIn, pg8::Sched, true, true>(lds, g, S, E);
            }
            { const int nun = 36 * (kind == 0 ? GLA_NP / 256 : (kind == 1 ? SWA_N / 256 : GM_N / 256)); if (LIGHT(nun)) { const int li = wg - (nun % G); if (!last && li < 64) { FRESH_TID(); adaln_unit(args, lds, tid, wave, lane, l + 1, li); } PULL(tr_need(base + 6 + REACH), Q_IN); } }
            } SEAM(base + 0);
        }
        if (IN(base + 1)) { FRESH_TID(); REPS(base + 1) {
            if (kind == 0) gla_prep_phase(args, slot, lds, tid, wave, lane, wg, G);
            else if (kind == 1) swa_attn_phase(args, last, lds, tid, wave, lane, wg, G);
            else gmlp_stats_phase(args, last, lane, gw, ngw);
            __syncthreads(); } SEAM(base + 1);
        }
        if (IN(base + 2) && kind != 1) { FRESH_TID(); REPS(base + 2) {
            if (kind == 0) gla_scan_phase(args, lds, tid, wave, lane, wg, G);
            else gmlp_spatial_phase(args, last, lds, tid, wave, lane, wg, G);
            __syncthreads(); } SEAM(base + 2);
        }
        if (IN(base + 3) && kind == 0) { FRESH_TID(); REPS(base + 3) {
            gla_onorm_phase(args, slot, last, lane, gw, ngw);
            __syncthreads(); } SEAM(base + 3);
        }
        if (IN(base + 4)) { REPS(base + 4) {
            const size_t wo = kind == 0 ? WS_GLAW + slot * GLAW_STRIDE + GLAW_WO : (kind == 1 ? WS_SWAW + SWAW_WO : WS_GMW + GMW_WO);
#pragma unroll 1
            for (int pass = 0; pass < (last ? 1 : 2); ++pass) {
                pg8::Gemm g{HA, (const pg8::bf16_t*)(OPQ(args.ws) + wo), M, D, D, D}; pg8::Sched S; S.init(32, D / 256, G, wg, 1);
                pg8::EpiY E{(pg8::bf16_t*)(OPQ(args.ws) + WS_Y), nullptr, D};
                if (pass) { const int cp = wg >> 5, sl = wg & 3, Ks = D / 4; g.A += sl * Ks; g.Bt += sl * Ks; g.K = Ks; S.init_one(wg < 128, 9 * cp, (wg >> 2) & 7);
                    E.P = (float*)(OPQ(args.ws) + WS_YP) + (ptrdiff_t)sl * (NB * LC) * D + (ptrdiff_t)(cp - 9 * cp) * 256 * D; }
                if (SITE(3)) pg8::gemm_phase<pg8::EpiY, pg8::Sched, true, true>(lds, g, S, E);
            }
            if (!last && wg >= 128) PULL(tr_need(base + 6 + REACH), Q_WO);
            } SEAM(base + 4);
        }
        if (IN(base + 5)) { FRESH_TID(); if (SITE(7)) resid_phase<0>(args, l, lds, tid, wave, lane, wg, G); PULL(tr_need(base + 6), 1 << 20); SEAM(base + 5); }
        if (IN(base + 6)) { REPS(base + 6) {
            pg8::Gemm g{HA, (const pg8::bf16_t*)(OPQ(args.ws) + WS_FFNW + l * FFNW_STRIDE), M, 2 * FF, D, D}; pg8::Sched S; S.init(last ? 32 : 36, 2 * FF / 256, G, wg, last ? 1 : 0);
            pg8::EpiUp E{(pg8::bf16_t*)(OPQ(args.ws) + WS_HFF), FF};
            if (SITE(4)) pg8::gemm_phase<pg8::EpiUp, pg8::Sched, true, true>(lds, g, S, E);
            PULL(tr_need(base + 7), 1 << 20);
            } SEAM(base + 6);
        }
        if (IN(base + 7)) { REPS(base + 7) {
#pragma unroll 1
            for (int pass = 0; pass < (last ? 1 : 2); ++pass) {
                pg8::Gemm g{(const pg8::bf16_t*)(OPQ(args.ws) + WS_HFF), (const pg8::bf16_t*)(OPQ(args.ws) + WS_FFNW + l * FFNW_STRIDE + FFNW_W2), M, D, FF, FF}; pg8::Sched S; S.init(32, D / 256, G, wg, 1);
                pg8::EpiY E{(pg8::bf16_t*)(OPQ(args.ws) + WS_Y), nullptr, D};
                if (pass) { const int cp = wg >> 5, sl = wg & 3, Ks = FF / 4; g.A += sl * Ks; g.Bt += sl * Ks; g.K = Ks; S.init_one(wg < 128, 9 * cp, (wg >> 2) & 7);
                    E.P = (float*)(OPQ(args.ws) + WS_YP) + (ptrdiff_t)sl * (NB * LC) * D + (ptrdiff_t)(cp - 9 * cp) * 256 * D; }
                if (SITE(5)) pg8::gemm_phase<pg8::EpiY, pg8::Sched, true, true>(lds, g, S, E);
            }
            if (!last && wg >= 128) PULL(tr_need(base + 9), Q_DN);
            } SEAM(base + 7);
        }
        if (IN(base + 8)) { FRESH_TID(); if (SITE(7)) resid_phase<1>(args, l, lds, tid, wave, lane, wg, G); if (!last) PULL(tr_need(base + 9), 1 << 20); SEAM(base + 8); }
    }
#undef IN
#undef SEAM
}

#ifndef MK_ONE_LAUNCH
#define MK_ONE_LAUNCH 0
#endif
extern "C" void kernel_launch(void* const* d_in, const int* in_sizes, int n_in, void* d_out, int out_size, void* d_ws, size_t ws_size, hipStream_t stream) {
    static int grid = 0;
    if (grid == 0) {
        if (n_in != 24 || out_size != NB * SEQ * D || ws_size < WS_END) { fprintf(stderr, "kernel_launch: unexpected problem (n_in %d, out %d, ws %zu); nothing launched\n", n_in, out_size, ws_size); grid = -1; return; }
        int dev = 0, cus = 0, per_cu = 0;
        if (hipGetDevice(&dev) != hipSuccess || hipDeviceGetAttribute(&cus, hipDeviceAttributeMultiprocessorCount, dev) != hipSuccess) { grid = -1; return; }
        if (hipFuncSetAttribute((const void*)trunk_fwd, hipFuncAttributeMaxDynamicSharedMemorySize, LDS_BYTES) != hipSuccess) { fprintf(stderr, "kernel_launch: hipFuncSetAttribute failed\n"); grid = -1; return; }
        if (hipOccupancyMaxActiveBlocksPerMultiprocessor(&per_cu, (const void*)trunk_fwd, NTHREADS, LDS_BYTES) != hipSuccess || per_cu < 1) { fprintf(stderr, "kernel_launch: occupancy query says %d\n", per_cu); }
        (void)hipGetLastError();
        grid = cus;
    }
    if (grid < 0) return;
    if (hipMemsetAsync((char*)d_ws + WS_CTL, 0, CTL_ZERO_BYTES, stream) != hipSuccess) return;
    Args a{};
    for (int i = 0; i < 24; ++i) a.in[i] = (const float*)d_in[i];
    a.out = (float*)d_out; a.ws = (unsigned char*)d_ws;
#if MK_ONE_LAUNCH
    a.ph_lo = 0; a.ph_hi = N_PHASES;
    hipLaunchKernelGGL(trunk_fwd, dim3(grid), dim3(NTHREADS), LDS_BYTES, stream, a);
#else
#ifndef HOST_DUP_PHASE
#define HOST_DUP_PHASE (-1)
#endif
#ifndef HOST_DUP_REPS
#define HOST_DUP_REPS 2
#endif
    for (int p = 0; p < N_PHASES; ++p) { if (!phase_exists(p)) continue; a.ph_lo = p; a.ph_hi = p + 1;
        for (int rep = 0; rep < (p == HOST_DUP_PHASE ? HOST_DUP_REPS : 1); ++rep) hipLaunchKernelGGL(trunk_fwd, dim3(grid), dim3(NTHREADS), LDS_BYTES, stream, a); }
#endif
}
```

```cpp
#define MK_ONE_LAUNCH 1
#include <hip/hip_runtime.h>
#include <cstdio>
#include <cstdint>

#define LAS __attribute__((address_space(3)))
#define GAS __attribute__((address_space(1)))

namespace pg8 {
#define PG8_LAS __attribute__((address_space(3)))
typedef unsigned short bf16_t;
typedef short bf16x8 __attribute__((ext_vector_type(8)));
typedef float f32x4 __attribute__((ext_vector_type(4)));
typedef float f32x2 __attribute__((ext_vector_type(2)));
typedef unsigned u32x4 __attribute__((ext_vector_type(4)));
typedef unsigned u32x2 __attribute__((ext_vector_type(2)));
constexpr int BM = 256, BK = 64, HALF = 128, HTB = HALF * BK * 2  , STAGE_BYTES = 8 * HTB, NXCD = 8, WGM = 4;

__host__ __device__ __forceinline__ int lds_byte(int r, int c) { const int st = (r >> 4) * 2 + (c >> 5), rr = r & 15, cc = c & 31, ob = rr * 64 + cc * 2; return st * 1024 + (ob ^ (((ob >> 9) & 1) << 5)); }
__host__ __device__ __forceinline__ void stage_rc(int b, int& R, int& C) { const int st = b / 1024, sb = b % 1024, swz = sb ^ (((sb >> 9) & 1) << 5); R = (st >> 1) * 16 + swz / 64; C = (st & 1) * 32 + (swz % 64) / 2; }
__host__ __device__ __forceinline__ int perm32(int rho) { const int n = rho >> 4, i = rho & 15; return 8 * (i >> 2) + 4 * n + (i & 3); }

struct Unit { int pm, pn, k0, nt, part, tile; };
struct Gemm { const bf16_t* A; const bf16_t* Bt; int M, N, K, ldk; };

struct Sched {
    int nM, nN, nwg, G, c, skip;
    __device__ __forceinline__ void init(int nM_, int nN_, int G_, int c_, int skip_) { nM = nM_; nN = nN_; nwg = nM * nN; G = G_; c = c_; skip = skip_; one = 0; opm = 0; opn = 0; tail = 0; R = 0; Ssh = 0; Lt = 0; ktn = 0; }
    int one, opm, opn;
    int tail, R, Ssh, Lt, ktn;
    __device__ __forceinline__ void set_tail(int nt_total) { R = nwg / G; Lt = nwg - R * G; tail = 0; Ssh = 0; ktn = 0;
        if (Lt > 0) { const int q = G / Lt; Ssh = q >= 4 ? 2 : (q >= 2 ? 1 : 0); if (Ssh > 0 && ((nt_total >> Ssh) & 1) == 0 && ((nt_total >> Ssh) << Ssh) == nt_total) { tail = 1; ktn = nt_total >> Ssh; } } }
    __device__ __forceinline__ void init_one(bool valid, int pm_, int pn_) { nM = nN = nwg = G = c = skip = 0; tail = 0; R = 0; Ssh = 0; Lt = 0; ktn = 0; one = valid ? 1 : -1; opm = pm_; opn = pn_; }
    __device__ __forceinline__ bool next(int i, Unit& u) const {
        u.k0 = 0; u.nt = 0; u.part = -1; u.tile = 0;
        if (one) { if (one < 0 || i > 0) return false; u.pm = opm; u.pn = opn; return true; }
        long L = (long)i * G + c;
        if (tail && i >= R) { if (i > R || c >= (Lt << Ssh)) return false; u.tile = c >> Ssh; u.part = c & ((1 << Ssh) - 1); u.nt = ktn; u.k0 = u.part * ktn * BK; L = (long)R * G + u.tile; }
        if (L >= nwg) return false;
        int wgid = (int)L; { const int q = nwg / NXCD, r = nwg % NXCD, xcd = wgid % NXCD, off = wgid / NXCD; wgid = (xcd < r ? xcd * (q + 1) : r * (q + 1) + (xcd - r) * q) + off; }
        const int nig = WGM * nN, gid = wgid / nig, fm = gid * WGM, gsz = (nM - fm) < WGM ? (nM - fm) : WGM;
        int pm = fm + ((wgid % nig) % gsz); u.pn = (wgid % nig) / gsz;
        if (skip) pm = pm + (pm >> 3) + 1;
        u.pm = pm; return true;
    }
    __device__ __forceinline__ void a_ready(const Unit&) const {}
    __device__ __forceinline__ void done(const Unit&) const {}
};

typedef __bf16 bf16x2_t __attribute__((ext_vector_type(2)));
__device__ __forceinline__ unsigned cvt_pk_bf16(float lo, float hi) { const f32x2 v = {lo, hi}; const bf16x2_t b = __builtin_convertvector(v, bf16x2_t); return __builtin_bit_cast(unsigned, b); }
__device__ __forceinline__ float silu_f(float x) { return x * __builtin_amdgcn_rcpf(1.0f + __builtin_amdgcn_exp2f(-1.44269504f * x)); }
__device__ __forceinline__ float gelu_tanh_f(float x) { const float z = 0.7978845608f * (x + 0.044715f * x * x * x); return x * __builtin_amdgcn_rcpf(1.0f + __builtin_amdgcn_exp2f(-2.88539008f * z)); }
__device__ __forceinline__ u32x4 pack8(const f32x4& a, const f32x4& b) { u32x4 w; w.x = cvt_pk_bf16(a[0], a[1]); w.y = cvt_pk_bf16(a[2], a[3]); w.z = cvt_pk_bf16(b[0], b[1]); w.w = cvt_pk_bf16(b[2], b[3]); return w; }
__device__ __forceinline__ u32x2 pack4(const f32x4& a) { u32x2 w; w.x = cvt_pk_bf16(a[0], a[1]); w.y = cvt_pk_bf16(a[2], a[3]); return w; }

struct EpiF32 {
    static constexpr bool PERM = false, AFTER_DRAIN = false, SPLITK = false;
    float* C; int ldc;
    __device__ __forceinline__ void operator()(const f32x4 (&acc)[2][2][4][2], const Unit& u, int wr, int wc, int fr, int fq) const {
        const int row0 = u.pm * BM + wr * 64 + fr, col0 = u.pn * BM + wc * 32 + 4 * fq;
#pragma unroll
        for (int ai = 0; ai < 2; ++ai)
#pragma unroll
            for (int m = 0; m < 4; ++m) { float* rowp = C + (size_t)(row0 + ai * HALF + m * 16) * ldc + col0;
#pragma unroll
                for (int bj = 0; bj < 2; ++bj)
#pragma unroll
                    for (int n = 0; n < 2; ++n) *(f32x4*)(rowp + bj * HALF + n * 16) = acc[ai][bj][m][n]; }
    }
};
struct EpiY {
    static constexpr bool PERM = true, AFTER_DRAIN = false, SPLITK = false;
    bf16_t* Y; float* P; int ldc;
    __device__ __forceinline__ void operator()(const f32x4 (&acc)[2][2][4][2], const Unit& u, int wr, int wc, int fr, int fq) const {
        const int row0 = u.pm * BM + wr * 64 + fr, col0 = u.pn * BM + wc * 32 + 8 * fq;
        if (P) {
#pragma unroll
            for (int ai = 0; ai < 2; ++ai)
#pragma unroll
                for (int m = 0; m < 4; ++m) { float* rowp = P + (ptrdiff_t)(row0 + ai * HALF + m * 16) * ldc + col0;
#pragma unroll
                    for (int bj = 0; bj < 2; ++bj) { *(f32x4*)(rowp + bj * HALF) = acc[ai][bj][m][0]; *(f32x4*)(rowp + bj * HALF + 4) = acc[ai][bj][m][1]; } }
        } else {
#pragma unroll
            for (int ai = 0; ai < 2; ++ai)
#pragma unroll
                for (int m = 0; m < 4; ++m) { bf16_t* rowp = Y + (size_t)(row0 + ai * HALF + m * 16) * ldc + col0;
#pragma unroll
                    for (int bj = 0; bj < 2; ++bj) *(u32x4*)(rowp + bj * HALF) = pack8(acc[ai][bj][m][0], acc[ai][bj][m][1]); }
        }
    }
};
struct EpiUp {
    static constexpr bool PERM = true, AFTER_DRAIN = false, SPLITK = true;
    bf16_t* H; int ldc;
    unsigned* cnt; unsigned char* P; PG8_LAS unsigned* flag; int S;
    __device__ __forceinline__ bool combine(f32x4 (&acc)[2][2][4][2], const Unit& u, int tid) const {
        const __amdgpu_buffer_rsrc_t rs = __builtin_amdgcn_make_buffer_rsrc(P, 0, 32 << 20, 0x00020000);
        const unsigned tile0 = (unsigned)(u.tile * S) * (16u * 8192u), lane_off = (unsigned)tid * 16u;
        { const unsigned off = tile0 + (unsigned)u.part * (16u * 8192u) + lane_off;
#pragma unroll
          for (int ai = 0; ai < 2; ++ai)
#pragma unroll
              for (int bj = 0; bj < 2; ++bj)
#pragma unroll
                  for (int m = 0; m < 4; ++m) __builtin_amdgcn_raw_buffer_store_b128(pack8(acc[ai][bj][m][0], acc[ai][bj][m][1]), rs, (int)(off + (unsigned)((ai * 2 + bj) * 4 + m) * 8192u), 0, 16); }
        asm volatile("s_waitcnt vmcnt(0)" ::: "memory");
        __builtin_amdgcn_s_barrier();
        if (tid == 0) {
            const unsigned old = __hip_atomic_fetch_add(cnt + u.tile, 1u, __ATOMIC_RELAXED, __HIP_MEMORY_SCOPE_AGENT);
            const unsigned lastw = (old == (unsigned)(S - 1)) ? 1u : 0u;
            if (lastw) { __builtin_amdgcn_fence(__ATOMIC_ACQUIRE, "agent"); asm volatile("s_waitcnt vmcnt(0)" ::: "memory"); }
            *(volatile PG8_LAS unsigned*)flag = lastw;
            asm volatile("s_waitcnt lgkmcnt(0)" ::: "memory");
        }
        __builtin_amdgcn_s_barrier();
        asm volatile("" ::: "memory");
        const unsigned lastw = *(volatile PG8_LAS unsigned*)flag;
        if (!__builtin_amdgcn_readfirstlane(lastw)) return false;
#pragma unroll
        for (int ai = 0; ai < 2; ++ai)
#pragma unroll
            for (int bj = 0; bj < 2; ++bj)
#pragma unroll
                for (int m = 0; m < 4; ++m) { acc[ai][bj][m][0] = (f32x4){0.f, 0.f, 0.f, 0.f}; acc[ai][bj][m][1] = (f32x4){0.f, 0.f, 0.f, 0.f}; }
        const unsigned char* pb = P + tile0 + lane_off;
#pragma unroll 1
        for (int sl = 0; sl < S; ++sl) {
#pragma unroll
            for (int ai = 0; ai < 2; ++ai) {
                u32x4 w[8];
#pragma unroll
                for (int q = 0; q < 8; ++q) w[q] = *(const GAS u32x4*)(pb + (size_t)(ai * 8 + q) * 8192);
#pragma unroll
                for (int q = 0; q < 8; ++q) { const int bj = q >> 2, m = q & 3;
                    acc[ai][bj][m][0] += (f32x4){__builtin_bit_cast(float, w[q].x << 16), __builtin_bit_cast(float, w[q].x & 0xffff0000u), __builtin_bit_cast(float, w[q].y << 16), __builtin_bit_cast(float, w[q].y & 0xffff0000u)};
                    acc[ai][bj][m][1] += (f32x4){__builtin_bit_cast(float, w[q].z << 16), __builtin_bit_cast(float, w[q].z & 0xffff0000u), __builtin_bit_cast(float, w[q].w << 16), __builtin_bit_cast(float, w[q].w & 0xffff0000u)}; }
            }
            pb += 16 * 8192;
        }
        return true;
    }
    __device__ __forceinline__ void operator()(const f32x4 (&acc)[2][2][4][2], const Unit& u, int wr, int wc, int fr, int fq) const {
        const int row0 = u.pm * BM + wr * 64 + fr, col0 = u.pn * HALF + wc * 32 + 8 * fq;
#pragma unroll
        for (int ai = 0; ai < 2; ++ai)
#pragma unroll
            for (int m = 0; m < 4; ++m) { bf16_t* rowp = H + (size_t)(row0 + ai * HALF + m * 16) * ldc + col0;
                f32x4 v0, v1;
#pragma unroll
                for (int j = 0; j < 4; ++j) { v0[j] = silu_f(acc[ai][0][m][0][j]) * acc[ai][1][m][0][j]; v1[j] = silu_f(acc[ai][0][m][1][j]) * acc[ai][1][m][1][j]; }
                *(u32x4*)rowp = pack8(v0, v1); }
    }
};
struct EpiGlaIn {
    static constexpr bool PERM = true, AFTER_DRAIN = false, SPLITK = false;
    bf16_t *Q, *K, *V, *OG; float* A32;
    __device__ __forceinline__ void operator()(const f32x4 (&acc)[2][2][4][2], const Unit& u, int wr, int wc, int fr, int fq) const {
        const int row0 = u.pm * BM + wr * 64 + fr, pn = u.pn;
        if (pn == 24) {
            if (wc == 0) {
#pragma unroll
                for (int ai = 0; ai < 2; ++ai)
#pragma unroll
                    for (int m = 0; m < 4; ++m) { float* ap = A32 + (size_t)(row0 + ai * HALF + m * 16) * 32 + 8 * fq; *(f32x4*)ap = acc[ai][0][m][0]; *(f32x4*)(ap + 4) = acc[ai][0][m][1]; }
            }
            return;
        }
        bf16_t* base; int ldc, colt; float sc = 1.0f; bool act = false;
        if (pn < 4) { base = Q; ldc = 1024; colt = pn * BM; sc = 0.0625f; }
        else if (pn < 8) { base = K; ldc = 1024; colt = (pn - 4) * BM; }
        else if (pn < 16) { base = V; ldc = 2048; colt = (pn - 8) * BM; }
        else { base = OG; ldc = 2048; colt = (pn - 16) * BM; act = true; }
        const int col0 = colt + wc * 32 + 8 * fq;
#pragma unroll
        for (int ai = 0; ai < 2; ++ai)
#pragma unroll
            for (int m = 0; m < 4; ++m) { bf16_t* rowp = base + (size_t)(row0 + ai * HALF + m * 16) * ldc + col0;
#pragma unroll
                for (int bj = 0; bj < 2; ++bj) { f32x4 v0 = acc[ai][bj][m][0] * sc, v1 = acc[ai][bj][m][1] * sc;
                    if (act) {
#pragma unroll
                        for (int j = 0; j < 4; ++j) { v0[j] = silu_f(v0[j]); v1[j] = silu_f(v1[j]); } }
                    *(u32x4*)(rowp + bj * HALF) = pack8(v0, v1); } }
    }
};
struct EpiSwaIn {
    static constexpr bool PERM = false, AFTER_DRAIN = false, SPLITK = false;
    bf16_t *SQ, *SK, *SV; const float* ropeC; const float* ropeS;
    __device__ __forceinline__ void operator()(const f32x4 (&acc)[2][2][4][2], const Unit& u, int wr, int wc, int fr, int fq) const {
        const int row0 = u.pm * BM + wr * 64 + fr, pn = u.pn;
        bf16_t* base; int ldc, colt; float sc = 1.0f; const bool rope = true;
        if (pn < 8) { base = SQ; ldc = 2048; colt = pn * BM; sc = 0.125f * 1.4426950408889634f; }
        else if (pn == 8) { base = SK; ldc = 256; colt = 0; }
        else {
#pragma unroll
            for (int ai = 0; ai < 2; ++ai)
#pragma unroll
                for (int m = 0; m < 4; ++m) { const int row = row0 + ai * HALF + m * 16, b = row / 2304, t = row - b * 2304;
#pragma unroll
                    for (int bj = 0; bj < 2; ++bj)
#pragma unroll
                        for (int n = 0; n < 2; ++n) { const int c0 = bj * HALF + wc * 32 + n * 16 + 4 * fq; const u32x2 w = pack4(acc[ai][bj][m][n]);
                            bf16_t* vp = SV + ((size_t)(b * 4 + (c0 >> 6)) * 64 + (c0 & 63)) * 2304 + t;
                            vp[0] = (bf16_t)(w.x & 0xffffu); vp[2304] = (bf16_t)(w.x >> 16); vp[2 * 2304] = (bf16_t)(w.y & 0xffffu); vp[3 * 2304] = (bf16_t)(w.y >> 16); } }
            return;
        }
        const int col0 = colt + wc * 32 + 4 * fq, half = wc & 1;
#pragma unroll
        for (int ai = 0; ai < 2; ++ai)
#pragma unroll
            for (int m = 0; m < 4; ++m) { const int row = row0 + ai * HALF + m * 16, t = row % 2304; bf16_t* rowp = base + (size_t)row * ldc + col0;
                f32x4 cs = (f32x4){1.f, 1.f, 1.f, 1.f}, sn = (f32x4){0.f, 0.f, 0.f, 0.f};
                if (rope && t >= 256) { const int tl = t - 256, pos = half ? (tl & 63) : (tl >> 6); cs = *(const f32x4*)(ropeC + pos * 16 + 4 * fq); sn = *(const f32x4*)(ropeS + pos * 16 + 4 * fq); }
#pragma unroll
                for (int bj = 0; bj < 2; ++bj) { const f32x4 x0 = acc[ai][bj][m][0], x1 = acc[ai][bj][m][1];
                    const f32x4 o0 = (x0 * cs - x1 * sn) * sc, o1 = (x1 * cs + x0 * sn) * sc;
                    *(u32x2*)(rowp + bj * HALF) = pack4(o0); *(u32x2*)(rowp + bj * HALF + 16) = pack4(o1); } }
    }
};
struct EpiGmlpIn {
    static constexpr bool PERM = true, AFTER_DRAIN = false, SPLITK = false;
    bf16_t *U, *V;
    __device__ __forceinline__ void operator()(const f32x4 (&acc)[2][2][4][2], const Unit& u, int wr, int wc, int fr, int fq) const {
        const int row0 = u.pm * BM + wr * 64 + fr, pn = u.pn;
        bf16_t* base = pn < 8 ? U : V; const int col0 = (pn & 7) * BM + wc * 32 + 8 * fq;
#pragma unroll
        for (int ai = 0; ai < 2; ++ai)
#pragma unroll
            for (int m = 0; m < 4; ++m) { bf16_t* rowp = base + (size_t)(row0 + ai * HALF + m * 16) * 2048 + col0;
#pragma unroll
                for (int bj = 0; bj < 2; ++bj) { f32x4 v0, v1;
#pragma unroll
                    for (int j = 0; j < 4; ++j) { v0[j] = gelu_tanh_f(acc[ai][bj][m][0][j]); v1[j] = gelu_tanh_f(acc[ai][bj][m][1][j]); }
                    *(u32x4*)(rowp + bj * HALF) = pack8(v0, v1); } }
    }
};

template <class Epi, class Sched, bool ALIGN_EPI = false, bool SP2 = false>
__device__ __forceinline__ void gemm_phase(PG8_LAS unsigned char* lds, const Gemm g, const Sched& S, const Epi& E) {
    int tid_l = threadIdx.x; asm volatile("" : "+v"(tid_l));
    const int tid = tid_l, wid = __builtin_amdgcn_readfirstlane(tid >> 6), lane = tid & 63, wr = wid >> 2, wc = wid & 3, fr = lane & 15, fq = lane >> 4;
    const int K = g.K, nt = K / BK, LDK = g.ldk;
    unsigned voffA[2], voffB[2];
#pragma unroll
    for (int i = 0; i < 2; ++i) { int R, C; stage_rc(tid * 16 + i * 8192, R, C); const int Rb = Epi::PERM ? ((R & ~31) + perm32(R & 31)) : R;
        voffA[i] = (unsigned)(R * LDK + C) * 2u; voffB[i] = (unsigned)(Rb * LDK + C) * 2u; }
    const size_t kstep = (size_t)(BK * 2);
    const size_t hstep = (size_t)HALF * LDK * 2;
    const size_t tstep = 2 * hstep;
    const unsigned ldsw = (unsigned)wid * 1024u;
    const int aoff = lds_byte(wr * 64 + fr, fq * 8), boff = lds_byte(wc * 32 + fr, fq * 8);
#define PG8_SA(b, h) (((b) * 2 + (h)) * HTB)
#define PG8_SB(b, h) ((4 + (b) * 2 + (h)) * HTB)
#define PG8_STAGE(bufoff, gbase, voff) do { _Pragma("unroll") for (int _i = 0; _i < 2; ++_i) \
        __builtin_amdgcn_global_load_lds((const unsigned*)((const char*)(gbase) + (voff)[_i]), (PG8_LAS unsigned*)(lds + (bufoff) + ldsw + _i * 8192), 16, 0, 0); } while (0)
#define PG8_LDA(dst, b, h) do { _Pragma("unroll") for (int m = 0; m < 4; ++m) _Pragma("unroll") for (int k = 0; k < 2; ++k) dst[m][k] = *(const PG8_LAS bf16x8*)(lds + PG8_SA(b, h) + aoff + m * 2048 + k * 1024); } while (0)
#define PG8_LDB(dst, b, h) do { _Pragma("unroll") for (int n = 0; n < 2; ++n) _Pragma("unroll") for (int k = 0; k < 2; ++k) dst[n][k] = *(const PG8_LAS bf16x8*)(lds + PG8_SB(b, h) + boff + n * 2048 + k * 1024); } while (0)
#define PG8_MMA(ai, bj, At, Bt) do { __builtin_amdgcn_s_setprio(1); _Pragma("unroll") for (int m = 0; m < 4; ++m) _Pragma("unroll") for (int n = 0; n < 2; ++n) _Pragma("unroll") for (int k = 0; k < 2; ++k) \
        acc[ai][bj][m][n] = __builtin_amdgcn_mfma_f32_16x16x32_bf16(Bt[n][k], At[m][k], acc[ai][bj][m][n], 0, 0, 0); __builtin_amdgcn_s_setprio(0); } while (0)
#define PG8_WAIT_V(n) asm volatile("s_waitcnt vmcnt(" #n ")" ::: "memory")
#define PG8_WAIT_L(n) asm volatile("s_waitcnt lgkmcnt(" #n ")" ::: "memory")
#define PG8_BAR __builtin_amdgcn_s_barrier()
#define PG8_SCHED __builtin_amdgcn_sched_barrier(0)
    Unit cur, nxt; int ui = 0;
    if (!S.next(0, cur)) return;
    f32x4 acc[2][2][4][2];
#pragma unroll
    for (int a = 0; a < 2; ++a)
#pragma unroll
        for (int b = 0; b < 2; ++b)
#pragma unroll
            for (int m = 0; m < 4; ++m)
#pragma unroll
                for (int n = 0; n < 2; ++n) acc[a][b][m][n] = (f32x4){0.f, 0.f, 0.f, 0.f};
    bf16x8 At[4][2], B0[2][2], B1[2][2];
    const char* cA = (const char*)g.A + (size_t)cur.pm * tstep + (size_t)cur.k0 * 2; const char* cB = (const char*)g.Bt + (size_t)cur.pn * tstep + (size_t)cur.k0 * 2;
    S.a_ready(cur);
    if constexpr (SP2) {
        PG8_STAGE(PG8_SB(0, 0), cB, voffB); PG8_STAGE(PG8_SB(0, 1), cB + hstep, voffB); PG8_STAGE(PG8_SA(0, 0), cA, voffA); PG8_STAGE(PG8_SA(0, 1), cA + hstep, voffA);
        if (wr == 1) PG8_BAR;
        PG8_WAIT_V(2); PG8_BAR;
        PG8_STAGE(PG8_SB(1, 0), cB + kstep, voffB); PG8_STAGE(PG8_SA(1, 0), cA + kstep, voffA); PG8_STAGE(PG8_SB(1, 1), cB + hstep + kstep, voffB);
        PG8_WAIT_V(6); PG8_BAR;
    } else {
        PG8_STAGE(PG8_SB(0, 0), cB, voffB); PG8_STAGE(PG8_SA(0, 0), cA, voffA); PG8_STAGE(PG8_SB(0, 1), cB + hstep, voffB); PG8_STAGE(PG8_SA(0, 1), cA + hstep, voffA);
        if (wr == 1) PG8_BAR;
        PG8_WAIT_V(4); PG8_BAR;
        PG8_STAGE(PG8_SB(1, 0), cB + kstep, voffB); PG8_STAGE(PG8_SA(1, 0), cA + kstep, voffA); PG8_STAGE(PG8_SB(1, 1), cB + hstep + kstep, voffB);
        PG8_WAIT_V(6); PG8_BAR;
    }
    for (;;) {
        const bool has_next = S.next(ui + 1, nxt);
        const char* nA = has_next ? (const char*)g.A + (size_t)nxt.pm * tstep + (size_t)nxt.k0 * 2 : cA; const char* nB = has_next ? (const char*)g.Bt + (size_t)nxt.pn * tstep + (size_t)nxt.k0 * 2 : cB;
        const int unt = cur.nt ? cur.nt : nt;
        for (int t = 0; t < unt; t += 2) {
            const bool last = (t == unt - 2);
            const char* a1 = cA + (size_t)(t + 1) * kstep;
            const char* a2 = last ? nA : cA + (size_t)(t + 2) * kstep; const char* b2 = last ? nB : cB + (size_t)(t + 2) * kstep;
            const char* a3 = a2 + kstep; const char* b3 = b2 + kstep;
            if (last && has_next) S.a_ready(nxt);
            if constexpr (SP2) {
            PG8_LDB(B0, 0, 0); PG8_LDB(B1, 0, 1); PG8_SCHED; PG8_LDA(At, 0, 0); PG8_STAGE(PG8_SA(1, 1), a1 + hstep, voffA);
            PG8_WAIT_V(8); PG8_WAIT_L(0); PG8_BAR; PG8_MMA(0, 0, At, B0); PG8_MMA(0, 1, At, B1); PG8_BAR; PG8_SCHED;
            PG8_LDA(At, 0, 1); PG8_STAGE(PG8_SB(0, 0), b2, voffB); PG8_STAGE(PG8_SB(0, 1), b2 + hstep, voffB); PG8_STAGE(PG8_SA(0, 0), a2, voffA);
            PG8_WAIT_V(8); PG8_WAIT_L(0); PG8_BAR; PG8_MMA(1, 0, At, B0); PG8_MMA(1, 1, At, B1); PG8_BAR; PG8_SCHED;
            PG8_LDB(B0, 1, 0); PG8_LDB(B1, 1, 1); PG8_SCHED; PG8_LDA(At, 1, 0); PG8_STAGE(PG8_SA(0, 1), a2 + hstep, voffA);
            PG8_WAIT_V(8); PG8_WAIT_L(0); PG8_BAR; PG8_MMA(0, 0, At, B0); PG8_MMA(0, 1, At, B1); PG8_BAR; PG8_SCHED;
            PG8_LDA(At, 1, 1); PG8_STAGE(PG8_SB(1, 0), b3, voffB); PG8_STAGE(PG8_SB(1, 1), b3 + hstep, voffB); PG8_STAGE(PG8_SA(1, 0), a3, voffA);
            PG8_WAIT_V(8); PG8_WAIT_L(0); PG8_BAR; PG8_MMA(1, 0, At, B0); PG8_MMA(1, 1, At, B1); PG8_BAR; PG8_SCHED;
            } else {
            PG8_LDB(B0, 0, 0); PG8_SCHED; PG8_LDA(At, 0, 0); PG8_STAGE(PG8_SA(1, 1), a1 + hstep, voffA);
            PG8_WAIT_L(8); PG8_BAR; PG8_WAIT_L(0); PG8_MMA(0, 0, At, B0); PG8_BAR; PG8_SCHED;
            PG8_LDB(B1, 0, 1); PG8_STAGE(PG8_SB(0, 0), b2, voffB);
            PG8_BAR; PG8_WAIT_L(0); PG8_MMA(0, 1, At, B1); PG8_BAR;
            PG8_LDA(At, 0, 1); PG8_STAGE(PG8_SA(0, 0), a2, voffA);
            PG8_BAR; PG8_WAIT_L(0); PG8_MMA(1, 0, At, B0); PG8_BAR; PG8_SCHED;
            PG8_STAGE(PG8_SB(0, 1), b2 + hstep, voffB);
            PG8_WAIT_V(6); PG8_BAR; PG8_MMA(1, 1, At, B1); PG8_BAR;
            PG8_LDB(B0, 1, 0); PG8_SCHED; PG8_LDA(At, 1, 0); PG8_STAGE(PG8_SA(0, 1), a2 + hstep, voffA);
            PG8_WAIT_L(8); PG8_BAR; PG8_WAIT_L(0); PG8_MMA(0, 0, At, B0); PG8_BAR; PG8_SCHED;
            PG8_LDB(B1, 1, 1); PG8_STAGE(PG8_SB(1, 0), b3, voffB);
            PG8_BAR; PG8_WAIT_L(0); PG8_MMA(0, 1, At, B1); PG8_BAR;
            PG8_LDA(At, 1, 1); PG8_STAGE(PG8_SA(1, 0), a3, voffA);
            PG8_BAR; PG8_WAIT_L(0); PG8_MMA(1, 0, At, B0); PG8_BAR; PG8_SCHED;
            PG8_STAGE(PG8_SB(1, 1), b3 + hstep, voffB);
            PG8_WAIT_V(6); PG8_BAR; PG8_MMA(1, 1, At, B1); PG8_BAR;
            }
        }
        if constexpr (ALIGN_EPI) { if (wr == 0) PG8_BAR; }
        bool do_epi = true;
        if constexpr (Epi::SPLITK) { if (cur.part >= 0) do_epi = E.combine(acc, cur, tid); }
        if constexpr (!Epi::AFTER_DRAIN) { if (do_epi) E(acc, cur, wr, wc, fr, fq); S.done(cur); }
        if (!has_next) break;
#pragma unroll
        for (int a = 0; a < 2; ++a)
#pragma unroll
            for (int b = 0; b < 2; ++b)
#pragma unroll
                for (int m = 0; m < 4; ++m)
#pragma unroll
                    for (int n = 0; n < 2; ++n) acc[a][b][m][n] = (f32x4){0.f, 0.f, 0.f, 0.f};
        cur = nxt; cA = nA; cB = nB; ++ui;
        if constexpr (ALIGN_EPI) { if (wr == 1) PG8_BAR; }
    }
    PG8_WAIT_V(0);
    if constexpr (!ALIGN_EPI) { if (wr == 0) PG8_BAR; }
    PG8_BAR;
    if constexpr (Epi::AFTER_DRAIN) { E.fused(acc, cur, wr, wc, fr, fq, lds, wid, lane); S.done(cur); }
#undef PG8_SA
#undef PG8_SB
#undef PG8_STAGE
#undef PG8_LDA
#undef PG8_LDB
#undef PG8_MMA
#undef PG8_WAIT_V
#undef PG8_WAIT_L
#undef PG8_BAR
#undef PG8_SCHED
}
}

typedef unsigned short bf16;
typedef float f32x4 __attribute__((ext_vector_type(4)));
typedef float f32x2 __attribute__((ext_vector_type(2)));
typedef unsigned u32x4 __attribute__((ext_vector_type(4)));
typedef unsigned u32x2 __attribute__((ext_vector_type(2)));
typedef GAS unsigned gu32;
#define RLX_AGENT __ATOMIC_RELAXED, __HIP_MEMORY_SCOPE_AGENT

constexpr int D = 2048, NB = 4, SEQ = 2048, LC = 256, TT = SEQ + LC, M = NB * TT, FF = 5632, DEPTH = 4;
constexpr int NWAVES = 8, NTHREADS = 512;
constexpr float EPS = 1e-6f;
constexpr int GLA_N = 6176, GLA_NP = 6400, SWA_N = 2560, GM_N = 4096;
static_assert(M == 9216 && M % 256 == 0, "row panels");

constexpr size_t MiB = 1u << 20;
constexpr size_t WS_CTL = 0, CTL_ZERO_BYTES = 1 * MiB;
constexpr size_t WS_MOD = 1 * MiB;
constexpr size_t WS_ROPE = 2 * MiB;
constexpr size_t WS_STAT = 3 * MiB;
constexpr size_t WS_A32 = 4 * MiB;
constexpr size_t WS_W = 8 * MiB;
constexpr size_t WS_FFNW = WS_W, FFNW_STRIDE = 66 * MiB, FFNW_W2 = 44 * MiB;
constexpr size_t WS_GLAW = WS_W + 264 * MiB, GLAW_STRIDE = 33 * MiB, GLAW_WO = 25 * MiB;
constexpr size_t WS_SWAW = WS_GLAW + 66 * MiB, SWAW_WO = 10 * MiB;
constexpr size_t WS_GMW = WS_SWAW + 18 * MiB, GMW_WO = 16 * MiB;
constexpr size_t WS_X = 384 * MiB;
constexpr size_t WS_Y = 456 * MiB;
constexpr size_t WS_HA = 528 * MiB;
constexpr size_t WS_HFF = 564 * MiB;
constexpr size_t WS_MIX = 664 * MiB;
constexpr size_t MIX_GQ = 0, MIX_GK = 18 * MiB, MIX_GV = 36 * MiB, MIX_GOG = 72 * MiB, MIX_GOF = 108 * MiB, MIX_GOB = 144 * MiB;
constexpr size_t MIX_GQT = 180 * MiB, MIX_GKT = 216 * MiB, MIX_GVT = 252 * MiB, MIX_GATT = 288 * MiB, MIX_GDEC = 298 * MiB;
constexpr size_t MIX_SQ = 0, MIX_SK = 36 * MiB, MIX_SV = 41 * MiB;
constexpr size_t MIX_U = 0, MIX_V = 36 * MiB;
constexpr size_t WS_YP = 968 * MiB;
constexpr size_t WS_END = 1000 * MiB;
static_assert(WS_GMW + 24 * MiB <= WS_X && WS_HFF + (size_t)M * FF * 2 <= WS_MIX, "d_ws map");
constexpr int CW_SPLIT = 16384;
constexpr int CW_BAR = 4096;

constexpr int RING_BYTES = 131072, LDS_BYTES = 163840, LDSCTL_OFF = LDS_BYTES - 1024, MISC_OFF = LDSCTL_OFF + 320;

#define LDS_WAIT() asm volatile("s_waitcnt lgkmcnt(0)" ::: "memory")
#define VM_WAIT() asm volatile("s_waitcnt vmcnt(0)" ::: "memory")
__device__ __forceinline__ unsigned pk2(float lo, float hi) { return pg8::cvt_pk_bf16(lo, hi); }
__device__ __forceinline__ unsigned f2bf(float f) { return pg8::cvt_pk_bf16(f, 0.f) & 0xffffu; }
__device__ __forceinline__ float bf2f(unsigned short b) { return __builtin_bit_cast(float, (unsigned)b << 16); }
__device__ __forceinline__ float bflo(unsigned u) { return __builtin_bit_cast(float, u << 16); }
__device__ __forceinline__ float bfhi(unsigned u) { return __builtin_bit_cast(float, u & 0xffff0000u); }
__device__ __forceinline__ float wave_sum(float v) {
#pragma unroll
    for (int o = 1; o < 64; o <<= 1) v += __shfl_xor(v, o);
    return v;
}
__device__ __forceinline__ float wave_max(float v) {
#pragma unroll
    for (int o = 1; o < 64; o <<= 1) v = fmaxf(v, __shfl_xor(v, o));
    return v;
}

#define XB_TMO      128
#define XB_XCNT(j)  (256  + 64 * (j))
#define XB_XSUB(j)  (1280 + 64 * (j))
#define XB_XGEN(j)  (2304 + 64 * (j))
#define XB_TOP      3328
#define XB_TOPGEN   3392
#define XCD_BAR_WORDS 3456
#define XB_SPIN_CAP (1u << 18)

__device__ __forceinline__ unsigned xb_ld(unsigned* p)              { return __hip_atomic_load(p, __ATOMIC_RELAXED, __HIP_MEMORY_SCOPE_AGENT); }
__device__ __forceinline__ unsigned xb_add(unsigned* p, unsigned v) { return __hip_atomic_fetch_add(p, v, __ATOMIC_RELAXED, __HIP_MEMORY_SCOPE_AGENT); }
__device__ __forceinline__ unsigned xb_xcc_id() { return (unsigned)__builtin_amdgcn_s_getreg((3 << 11) | 20) & 0xFu; }
#define XB_SPIN(cond, bar) do { unsigned _sp = 0; while (cond) { __builtin_amdgcn_s_sleep(1); \
    if ((++_sp & 255u) == 0u) { if (xb_ld(&(bar)[XB_TMO])) break; if (_sp > XB_SPIN_CAP) { atomicAdd(&(bar)[XB_TMO], 1u); break; } } } } while (0)

struct XcdBarrier {
    unsigned* bar; unsigned x;
    volatile LAS unsigned* st;
};

__device__ __forceinline__ XcdBarrier xcd_barrier_post(unsigned* bar, volatile LAS unsigned* st) {
    XcdBarrier b; b.bar = bar; b.x = xb_xcc_id(); b.st = st;
    if (threadIdx.x == 0) (void)xb_add(&bar[XB_XCNT(b.x)], 1u);
    return b;
}
__device__ __forceinline__ void xcd_barrier_complete(unsigned* bar, unsigned x, unsigned& nloc, unsigned& nx) {
    const unsigned G = gridDim.x * gridDim.y * gridDim.z;
    unsigned sum, cnt, mine, sp = 0u;
    for (;;) {
        sum = 0u; cnt = 0u; mine = 0u;
#pragma unroll
        for (unsigned j = 0; j < 16; ++j) { const unsigned c = xb_ld(&bar[XB_XCNT(j)]); sum += c; cnt += (c > 0u) ? 1u : 0u; mine = (j == x) ? c : mine; }
        if (sum == G) break;
        __builtin_amdgcn_s_sleep(1);
        if ((++sp & 255u) == 0u) { if (xb_ld(&bar[XB_TMO])) break; if (sp > XB_SPIN_CAP) { atomicAdd(&bar[XB_TMO], 1u); break; } }
    }
    nloc = mine > 0u ? mine : 1u; nx = cnt > 0u ? cnt : 1u;
}

__device__ __forceinline__ void xcd_barrier(const XcdBarrier& b) {
    asm volatile("s_waitcnt vmcnt(0)" ::: "memory");
    __syncthreads();
    if (threadIdx.x == 0) {
        unsigned* bar = b.bar;
        __builtin_amdgcn_s_waitcnt(0);
        unsigned nloc = b.st[0], nx = b.st[1];
        if (nloc == 0u) { xcd_barrier_complete(bar, b.x, nloc, nx); b.st[0] = nloc; b.st[1] = nx; }
        const unsigned old = xb_add(&bar[XB_XSUB(b.x)], 1u);
        const unsigned gen = old / nloc;
        if (old + 1u == (gen + 1u) * nloc) {
            __builtin_amdgcn_fence(__ATOMIC_RELEASE, "agent");
            asm volatile("s_waitcnt vmcnt(0)" ::: "memory");
            const unsigned og = xb_add(&bar[XB_TOP], 1u);
            const unsigned tg = og / nx;
            if (og + 1u == (tg + 1u) * nx) xb_add(&bar[XB_TOPGEN], 1u);
            else XB_SPIN(xb_ld(&bar[XB_TOPGEN]) == tg, bar);
            __builtin_amdgcn_fence(__ATOMIC_ACQUIRE, "agent");
            xb_add(&bar[XB_XGEN(b.x)], 1u);
            asm volatile("s_waitcnt vmcnt(0)" ::: "memory");
        } else {
            XB_SPIN(xb_ld(&bar[XB_XGEN(b.x)]) == gen, bar);
            __builtin_amdgcn_fence(__ATOMIC_ACQUIRE, "agent");
            asm volatile("s_waitcnt vmcnt(0)" ::: "memory");
        }
    }
    __syncthreads();
}

struct Args { const float* in[24]; float* out; unsigned char* ws; int ph_lo, ph_hi; };

__device__ __forceinline__ unsigned char* OPQ(unsigned char* p) { asm volatile("" : "+s"(p)); return p; }
__device__ __forceinline__ const float* OPQF(const float* p) { asm volatile("" : "+s"(p)); return p; }
__device__ __forceinline__ const float* input_row(const float* x, const float* ctx, int r) {
    const int b = r / TT, t = r - b * TT;
    return t < LC ? ctx + ((size_t)b * LC + t) * D : x + ((size_t)b * SEQ + (t - LC)) * D;
}

__device__ __forceinline__ void p0_transpose_item(const float* W, int K, int N, bf16* WT, int drow0, int k0, int n0, LAS float* scr, int lane) {
    const int n4 = lane & 15, kr = lane >> 4; const bool ok = (n0 + 4 * n4) < N;
    const float* wp = W + (size_t)(k0 + kr) * N + n0 + 4 * n4;
    f32x4 v[16];
#pragma unroll
    for (int i = 0; i < 16; ++i) v[i] = ok ? __builtin_nontemporal_load((const GAS f32x4*)(wp + (size_t)(4 * i) * N)) : (f32x4){0.f, 0.f, 0.f, 0.f};
#pragma unroll
    for (int i = 0; i < 16; ++i)
#pragma unroll
        for (int q = 0; q < 4; ++q) scr[(4 * i + kr) * 65 + 4 * n4 + q] = v[i][q];
    LDS_WAIT(); asm volatile("" ::: "memory");
    const int c = lane & 7;
#pragma unroll
    for (int jj = 0; jj < 8; ++jj) { const int n = (lane >> 3) + 8 * jj; const LAS float* s = scr + (8 * c) * 65 + n;
        u32x4 o; o.x = pk2(s[0 * 65], s[1 * 65]); o.y = pk2(s[2 * 65], s[3 * 65]); o.z = pk2(s[4 * 65], s[5 * 65]); o.w = pk2(s[6 * 65], s[7 * 65]);
        if (n0 + n < N) *(GAS u32x4*)(WT + (size_t)(drow0 + n) * K + k0 + 8 * c) = o; }
    LDS_WAIT(); asm volatile("" ::: "memory");
}
constexpr int I_FF = 2816, I_FFL = 3 * I_FF, I_GIN = 32 * 97, I_SQ = 32 * 32, I_GLA = I_GIN + I_SQ, I_SWA = 32 * 40 + I_SQ, I_GM = 32 * 64 + I_SQ;
constexpr int IT_G0 = 0, IT_F0 = IT_G0 + I_GLA, IT_SW = IT_F0 + I_FFL, IT_F1 = IT_SW + I_SWA, IT_GM = IT_F1 + I_FFL, IT_F2 = IT_GM + I_GM, IT_G1 = IT_F2 + I_FFL, IT_F3 = IT_G1 + I_GLA, N_TR_ITEMS = IT_F3 + I_FFL;
static_assert(I_FF == (D / 64) * (FF / 64) && I_FF == (FF / 64) * (D / 64) && GLA_N == 96 * 64 + 32 && N_TR_ITEMS == 47424, "transpose items");
#ifndef REACH
#define REACH 0
#endif
#ifndef Q_IN
#define Q_IN 12
#endif
#ifndef Q_WO
#define Q_WO 3
#endif
#ifndef Q_DN
#define Q_DN 5
#endif
#ifndef PROLOGUE_UNTIL
#define PROLOGUE_UNTIL IT_F0
#endif
constexpr int CW_STEAL = 64;
__device__ __forceinline__ int tr_need(int p) {
    if (p < 8) return IT_F0;
    if (p < 9) return IT_F0 + 2 * I_FF;   if (p < 11) return IT_SW;
    if (p < 17) return IT_F1;             if (p < 18) return IT_F1 + 2 * I_FF;   if (p < 20) return IT_GM;
    if (p < 26) return IT_F2;             if (p < 27) return IT_F2 + 2 * I_FF;   if (p < 29) return IT_G1;
    if (p < 35) return IT_F3;             if (p < 36) return IT_F3 + 2 * I_FF;   return N_TR_ITEMS;
}
__device__ __forceinline__ void tr_do_item(const Args& a, int it, LAS float* scr, int lane) {
    unsigned char* ws = OPQ(a.ws);
    int r = it; const float* src; bf16* dst; int K = D, N, nblk, dmode = 0, l = 0; int grp;
    if (r < IT_F0) { grp = 0; l = 0; } else if (r < IT_SW) { grp = 1; l = 0; r -= IT_F0; } else if (r < IT_F1) { grp = 2; r -= IT_SW; } else if (r < IT_GM) { grp = 1; l = 1; r -= IT_F1; }
    else if (r < IT_F2) { grp = 3; r -= IT_GM; } else if (r < IT_G1) { grp = 1; l = 2; r -= IT_F2; } else if (r < IT_F3) { grp = 0; l = 1; r -= IT_G1; } else { grp = 1; l = 3; r -= IT_F3; }
    if (grp == 1) { const int which = r / I_FF; r -= which * I_FF;
        if (which < 2) { src = OPQF(a.in[which ? 8 : 7]) + (size_t)l * D * FF; N = FF; nblk = FF / 64; dst = (bf16*)(ws + WS_FFNW + l * FFNW_STRIDE); dmode = 1 + which; }
        else { src = OPQF(a.in[9]) + (size_t)l * FF * D; K = FF; N = D; nblk = D / 64; dst = (bf16*)(ws + WS_FFNW + l * FFNW_STRIDE + FFNW_W2); } }
    else if (grp == 0) {
        if (r < I_GIN) { src = OPQF(a.in[10]) + (size_t)l * D * GLA_N; N = GLA_N; nblk = 97; dst = (bf16*)(ws + WS_GLAW + l * GLAW_STRIDE); }
        else { r -= I_GIN; src = OPQF(a.in[14]) + (size_t)l * D * D; N = D; nblk = 32; dst = (bf16*)(ws + WS_GLAW + l * GLAW_STRIDE + GLAW_WO); } }
    else if (grp == 2) {
        if (r < 32 * 40) { src = OPQF(a.in[15]); N = SWA_N; nblk = 40; dst = (bf16*)(ws + WS_SWAW); }
        else { r -= 32 * 40; src = OPQF(a.in[17]); N = D; nblk = 32; dst = (bf16*)(ws + WS_SWAW + SWAW_WO); } }
    else {
        if (r < 32 * 64) { src = OPQF(a.in[18]); N = GM_N; nblk = 64; dst = (bf16*)(ws + WS_GMW); }
        else { r -= 32 * 64; src = OPQF(a.in[23]); N = D; nblk = 32; dst = (bf16*)(ws + WS_GMW + GMW_WO); } }
    const int kb = r / nblk, nb = r - kb * nblk, k0 = 64 * kb, n0 = 64 * nb;
    const int drow0 = dmode == 0 ? n0 : ((n0 >> 7) * 256 + (dmode - 1) * 128 + (n0 & 127));
    p0_transpose_item(src, K, N, dst, drow0, k0, n0, scr, lane);
}
__device__ __forceinline__ void tr_pull(const Args& a, LAS unsigned char* lds, int wave, int lane, int until, int max_batches) {
    gu32* ctr = (gu32*)(OPQ(a.ws) + WS_CTL) + CW_STEAL;
    LAS float* scr = (LAS float*)(lds + wave * 16640);
    volatile LAS unsigned* bc = (volatile LAS unsigned*)(lds + MISC_OFF);
    if (until > N_TR_ITEMS) until = N_TR_ITEMS;
    for (int k = 0; k < max_batches; ++k) {
        __syncthreads();
        if (threadIdx.x == 0) { unsigned v = 0xffffffffu; if ((int)__hip_atomic_load(ctr, RLX_AGENT) < until) v = __hip_atomic_fetch_add(ctr, 16u, RLX_AGENT); bc[0] = v; }
        __syncthreads();
        const unsigned base = bc[0];
        if (base == 0xffffffffu || (int)base >= N_TR_ITEMS) break;
#pragma unroll 1
        for (int q = 0; q < 2; ++q) { const int it = (int)base + 8 * q + wave; if (it < N_TR_ITEMS) tr_do_item(a, it, scr, lane); }
    }
}
__device__ __forceinline__ void adaln_unit(const Args& a, LAS unsigned char* lds, int tid, int wave, int lane, int l, int cb) {
    LAS float* SL = (LAS float*)lds;
    LAS float* PART = (LAS float*)(lds + 40960);
    const float* cvec = OPQF(a.in[1]); const float* cctx = OPQF(a.in[3]); const float* ada_w = OPQF(a.in[4]); const float* ada_b = OPQF(a.in[5]);
    float* MOD = (float*)(OPQ(a.ws) + WS_MOD);
    __syncthreads();
    for (int e = tid; e < 5 * D; e += NTHREADS) { const int mi = e / D, k = e - mi * D; const float cv = mi < 4 ? cvec[mi * D + k] : cctx[k]; SL[e] = cv / (1.0f + expf(-cv)); }
    __syncthreads();
    {
        const bool on = lane < 48;
        f32x4 acc[5];
#pragma unroll
        for (int mi = 0; mi < 5; ++mi) acc[mi] = (f32x4){0.f, 0.f, 0.f, 0.f};
        const float* wp = ada_w + ((size_t)l * D + 256 * wave) * (6 * D) + 192 * cb + 4 * (on ? lane : 0);
        const LAS float* sl = SL + 256 * wave;
#pragma unroll 2
        for (int k4 = 0; k4 < 256; k4 += 8) {
            f32x4 wv[8];
#pragma unroll
            for (int q = 0; q < 8; ++q) wv[q] = *(const GAS f32x4*)(wp + (size_t)(k4 + q) * (6 * D));
#pragma unroll
            for (int mi = 0; mi < 5; ++mi) { const f32x4 s4 = *(const LAS f32x4*)(sl + mi * D + k4), s5 = *(const LAS f32x4*)(sl + mi * D + k4 + 4);
#pragma unroll
                for (int q = 0; q < 4; ++q) { acc[mi] += wv[q] * s4[q]; acc[mi] += wv[4 + q] * s5[q]; } }
        }
        if (on) {
#pragma unroll
            for (int mi = 0; mi < 5; ++mi) *(LAS f32x4*)(PART + (wave * 5 + mi) * 192 + 4 * lane) = acc[mi]; }
        __syncthreads();
        for (int e = tid; e < 5 * 192; e += NTHREADS) { const int mi = e / 192, cc = e - mi * 192; float s = ada_b[l * 6 * D + 192 * cb + cc];
#pragma unroll
            for (int w = 0; w < 8; ++w) s += PART[(w * 5 + mi) * 192 + cc];
            MOD[(size_t)(l * 5 + mi) * (6 * D) + 192 * cb + cc] = s; }
        __syncthreads();
    }
}
__device__ __forceinline__ void p0_rope(const Args& a, int tid) {
    float* RC = (float*)(OPQ(a.ws) + WS_ROPE); float* RS = RC + 1024;
    for (int e = tid; e < 1024; e += NTHREADS) {
        const int pos = e >> 4, f = e & 15;
        double inv = 1.0; for (int i = 0; i < f; ++i) inv *= 0.56234132519034908;
        const double x = (double)pos * (double)(float)inv;
        const double twopi = 6.283185307179586476925;
        const double n = __builtin_rint(x * (1.0 / twopi)); const double r = x - n * twopi;
        double s = r, c = 1.0, ts = r, tc = 1.0; const double r2 = r * r;
#pragma unroll
        for (int i = 1; i <= 16; ++i) { tc = -tc * r2 * (1.0 / (double)((2 * i - 1) * (2 * i))); c += tc; ts = -ts * r2 * (1.0 / (double)((2 * i) * (2 * i + 1))); s += ts; }
        RC[e] = (float)c; RS[e] = (float)s;
    }
}

__device__ __forceinline__ void load_row8(const float* p, int lane, f32x4 (&v)[8]) {
#pragma unroll
    for (int j = 0; j < 8; ++j) v[j] = *(const GAS f32x4*)(p + (64 * j + lane) * 4);
}
__device__ __forceinline__ float sumsq8(const f32x4 (&v)[8]) { float s = 0.f;
#pragma unroll
    for (int j = 0; j < 8; ++j) s += (v[j].x * v[j].x + v[j].y * v[j].y) + (v[j].z * v[j].z + v[j].w * v[j].w);
    return s; }
__device__ __forceinline__ void store_h8(bf16* hrow, int lane, const f32x4 (&v)[8]) {
#pragma unroll
    for (int j = 0; j < 8; ++j) { u32x2 w; w.x = pk2(v[j].x, v[j].y); w.y = pk2(v[j].z, v[j].w); *(GAS u32x2*)(hrow + (64 * j + lane) * 4) = w; }
}
__device__ __forceinline__ void wave_rows(int rb, int wave, int& r0, int& nr) { nr = wave < 4 ? 5 : 4; r0 = rb * 36 + (wave < 4 ? 5 * wave : 20 + 4 * (wave - 4)); }

__device__ __forceinline__ void norm0_phase(const Args& a, int wave, int lane, int wg, int G) {
    const float* MOD = (const float*)(OPQ(a.ws) + WS_MOD); const float* ng = OPQF(a.in[6]); bf16* HA = (bf16*)(OPQ(a.ws) + WS_HA);
    for (int rb = wg; rb < 256; rb += G) {
        int r0, nr; wave_rows(rb, wave, r0, nr);
        int cur = -1; f32x4 cB[8], cC[8];
        for (int r = r0; r < r0 + nr; ++r) {
            const int b = r / TT, t = r - b * TT, mi = t < LC ? 4 : b;
            if (mi != cur) { cur = mi; const float* mod = MOD + (size_t)mi * (6 * D); f32x4 g[8], sc[8];
                load_row8(ng, lane, g); load_row8(mod + D, lane, sc); load_row8(mod, lane, cC);
#pragma unroll
                for (int j = 0; j < 8; ++j) cB[j] = g[j] * (1.0f + sc[j]); }
            f32x4 x[8]; load_row8(input_row(OPQF(a.in[0]), OPQF(a.in[2]), r), lane, x);
            const float rs = 1.0f / sqrtf(wave_sum(sumsq8(x)) * (1.0f / D) + EPS);
#pragma unroll
            for (int j = 0; j < 8; ++j) x[j] = x[j] * rs * cB[j] + cC[j];
            store_h8(HA + (size_t)r * D, lane, x);
        }
    }
}
__device__ __forceinline__ void load_xrow(const float* fin, const bf16* Xb, bool from_input, int lane, f32x4 (&x)[8]) {
    if (from_input) load_row8(fin, lane, x);
    else {
#pragma unroll
        for (int j = 0; j < 8; ++j) { const u32x2 w = *(const GAS u32x2*)(Xb + (64 * j + lane) * 4); x[j] = (f32x4){bflo(w.x), bfhi(w.x), bflo(w.y), bfhi(w.y)}; } }
}
template <int WHICH> __device__ __forceinline__ void resid_phase(const Args& a, int l, LAS unsigned char* lds, int tid, int wave, int lane, int wg, int G) {
    const float* MOD = (const float*)(OPQ(a.ws) + WS_MOD); const float* ng = OPQF(a.in[6]);
    bf16* X = (bf16*)(OPQ(a.ws) + WS_X); const bf16* Y = (const bf16*)(OPQ(a.ws) + WS_Y); bf16* HA = (bf16*)(OPQ(a.ws) + WS_HA);
    const float* YP = (const float*)(OPQ(a.ws) + WS_YP); const float* xin = OPQF(a.in[0]); const float* cin = OPQF(a.in[2]);
    const bool last = (l == DEPTH - 1), final_out = last && WHICH == 1, from_input = (l == 0 && WHICH == 0);
    LAS float* PAR = (LAS float*)lds;
    for (int rb = wg; rb < 256; rb += G) {
        const int bb = (rb * 36) / TT;
        __syncthreads();
#pragma unroll
        for (int slot = 0; slot < 2; ++slot) { const int mi = slot ? bb : 4; const float* mod = MOD + (size_t)(l * 5 + mi) * (6 * D);
            const f32x4 gt = *(const GAS f32x4*)(mod + (WHICH ? 5 : 2) * D + 4 * tid), gy = *(const GAS f32x4*)(ng + (size_t)(l * 4 + (WHICH ? 3 : 1)) * D + 4 * tid);
            *(LAS f32x4*)(PAR + (slot * 3 + 0) * D + 4 * tid) = gt * gy;
            if (!final_out) { const float* gn = WHICH ? ng + (size_t)((l + 1) * 4) * D : ng + (size_t)(l * 4 + 2) * D;
                const float* modn = WHICH ? MOD + (size_t)((l + 1) * 5 + mi) * (6 * D) : mod;
                const f32x4 g = *(const GAS f32x4*)(gn + 4 * tid), sc = *(const GAS f32x4*)(modn + (WHICH ? 1 : 4) * D + 4 * tid), sh = *(const GAS f32x4*)(modn + (WHICH ? 0 : 3) * D + 4 * tid);
                *(LAS f32x4*)(PAR + (slot * 3 + 1) * D + 4 * tid) = g * (1.0f + sc); *(LAS f32x4*)(PAR + (slot * 3 + 2) * D + 4 * tid) = sh; } }
        __syncthreads();
        int r0, nr; wave_rows(rb, wave, r0, nr);
        f32x4 x[8], xn[8]; u32x2 yb[8], ybn[8];
        { const int r = r0; const int b = r / TT, t = r - b * TT;
          load_xrow(from_input ? input_row(xin, cin, r) : nullptr, X + (size_t)r * D, from_input, lane, x);
          if (t >= LC) {
#pragma unroll
              for (int j = 0; j < 8; ++j) yb[j] = *(const GAS u32x2*)(Y + (size_t)r * D + (64 * j + lane) * 4); } }
#pragma unroll 1
        for (int r = r0; r < r0 + nr; ++r) {
            const int b = r / TT, t = r - b * TT;
            if (r + 1 < r0 + nr) { const int rn = r + 1, bn = rn / TT, tn = rn - bn * TT;
                load_xrow(from_input ? input_row(xin, cin, rn) : nullptr, X + (size_t)rn * D, from_input, lane, xn);
                if (tn >= LC) {
#pragma unroll
                    for (int j = 0; j < 8; ++j) ybn[j] = *(const GAS u32x2*)(Y + (size_t)rn * D + (64 * j + lane) * 4); } }
            if (!(last && t < LC)) {
            const LAS float* par = PAR + (t < LC ? 0 : 3 * D);
            f32x4 y[8];
            if (t < LC) { const float* yp = YP + (size_t)(b * LC + t) * D; load_row8(yp, lane, y);
#pragma unroll
                for (int sl = 1; sl < 4; ++sl) { f32x4 pp[8]; load_row8(yp + (size_t)sl * (NB * LC) * D, lane, pp);
#pragma unroll
                    for (int j = 0; j < 8; ++j) y[j] += pp[j]; } }
            else {
#pragma unroll
                for (int j = 0; j < 8; ++j) y[j] = (f32x4){bflo(yb[j].x), bfhi(yb[j].x), bflo(yb[j].y), bfhi(yb[j].y)}; }
            const float rs = 1.0f / sqrtf(wave_sum(sumsq8(y)) * (1.0f / D) + EPS);
#pragma unroll
            for (int j = 0; j < 8; ++j) x[j] = x[j] + *(const LAS f32x4*)(par + (64 * j + lane) * 4) * (y[j] * rs);
            if (final_out) { float* xd = a.out + ((size_t)b * SEQ + (t - LC)) * D;
#pragma unroll
                for (int j = 0; j < 8; ++j) *(GAS f32x4*)(xd + (64 * j + lane) * 4) = x[j]; }
            else {
                store_h8(X + (size_t)r * D, lane, x);
                const float rs2 = 1.0f / sqrtf(wave_sum(sumsq8(x)) * (1.0f / D) + EPS);
#pragma unroll
                for (int j = 0; j < 8; ++j) x[j] = x[j] * rs2 * *(const LAS f32x4*)(par + D + (64 * j + lane) * 4) + *(const LAS f32x4*)(par + 2 * D + (64 * j + lane) * 4);
                store_h8(HA + (size_t)r * D, lane, x);
            }
            }
#pragma unroll
            for (int j = 0; j < 8; ++j) { x[j] = xn[j]; yb[j] = ybn[j]; }
        }
    }
}

typedef float f32x16 __attribute__((ext_vector_type(16)));
typedef short bf16x8v __attribute__((ext_vector_type(8)));
constexpr int GL_ST = 528;
__device__ __forceinline__ float log_sigmoid_f(float z) { return fminf(z, 0.f) - __logf(1.0f + __expf(-fabsf(z))); }
template <int DIR> __device__ __forceinline__ void gla_prep_unit(const Args& a, int slot, int u, LAS unsigned char* lds, int tid, int wave, int lane) {
    LAS float* As = (LAS float*)lds;
    LAS float* TOT = (LAS float*)(lds + 4096);
    LAS unsigned char* Qs = lds + 8192;
    LAS unsigned char* Ks = lds + 8192 + 64 * GL_ST;
    LAS unsigned char* Vs = lds + 8192 + 128 * GL_ST;
    const bf16* Q = (const bf16*)(OPQ(a.ws) + WS_MIX + MIX_GQ); const bf16* Kb = (const bf16*)(OPQ(a.ws) + WS_MIX + MIX_GK); const bf16* V = (const bf16*)(OPQ(a.ws) + WS_MIX + MIX_GV);
    bf16* QT = (bf16*)(OPQ(a.ws) + WS_MIX + MIX_GQT); bf16* KT = (bf16*)(OPQ(a.ws) + WS_MIX + MIX_GKT); bf16* VT = (bf16*)(OPQ(a.ws) + WS_MIX + MIX_GVT); bf16* ATT = (bf16*)(OPQ(a.ws) + WS_MIX + MIX_GATT); float* DEC = (float*)(OPQ(a.ws) + WS_MIX + MIX_GDEC);
    const float* A32 = (const float*)(OPQ(a.ws) + WS_A32);
    const int c = (u >> 1) % 36, bh = (u >> 1) / 36, h = bh & 3, b = bh >> 2;
    const size_t row0 = (size_t)b * TT + 64 * c;
    const int kk = tid & 255, hf = tid >> 8;
    __syncthreads();
    for (int e = tid; e < 1024; e += NTHREADS) As[e] = A32[(row0 + (e >> 4)) * 32 + 16 * DIR + (e & 15)];
#pragma unroll
    for (int q = 0; q < 4; ++q) { const int e = tid + NTHREADS * q, i = e >> 5, ch = e & 31; *(LAS u32x4*)(Vs + i * GL_ST + 16 * ch) = *(const GAS u32x4*)(V + (row0 + i) * 2048 + h * 512 + 256 * DIR + 8 * ch); }
    unsigned short qraw[32], kraw[32];
    { const bf16* qp = Q + (row0 + 32 * hf) * 1024 + h * 256 + kk; const bf16* kp = Kb + (row0 + 32 * hf) * 1024 + h * 256 + kk;
#pragma unroll
      for (int p = 0; p < 32; ++p) { qraw[p] = qp[(size_t)p * 1024]; kraw[p] = kp[(size_t)p * 1024]; } }
    const float bias = OPQF(a.in[12])[(size_t)(slot * 2 + DIR) * 1024 + h * 256 + kk];
    LAS float* Zs = (LAS float*)(lds + 8192);
    float bq[2][4];
    { const float* wp = OPQF(a.in[11]) + (size_t)(slot * 2 + DIR) * 16 * 1024 + h * 256 + (lane & 15);
#pragma unroll
      for (int t2 = 0; t2 < 2; ++t2)
#pragma unroll
          for (int ks = 0; ks < 4; ++ks) bq[t2][ks] = wp[(size_t)(4 * ks + (lane >> 4)) * 1024 + 16 * (2 * wave + t2)]; }
    __syncthreads();
#pragma unroll
    for (int tm = 0; tm < 4; ++tm) { float aq[4];
#pragma unroll
        for (int ks = 0; ks < 4; ++ks) aq[ks] = As[(16 * tm + (lane & 15)) * 16 + 4 * ks + (lane >> 4)];
#pragma unroll
        for (int t2 = 0; t2 < 2; ++t2) { f32x4 zc = (f32x4){0.f, 0.f, 0.f, 0.f};
#pragma unroll
            for (int ks = 0; ks < 4; ++ks) zc = __builtin_amdgcn_mfma_f32_16x16x4f32(aq[ks], bq[t2][ks], zc, 0, 0, 0);
#pragma unroll
            for (int r = 0; r < 4; ++r) Zs[(16 * tm + 4 * (lane >> 4) + r) * 256 + 16 * (2 * wave + t2) + (lane & 15)] = zc[r]; } }
    __syncthreads();
    float lc[32]; float run = 0.f;
#pragma unroll
    for (int s = 0; s < 32; ++s) { const int p = DIR ? 31 - s : s, i = 32 * hf + p; const float z = bias + Zs[i * 256 + kk];
        run += log_sigmoid_f(z) * 0.0625f; lc[p] = run; }
    TOT[hf * 256 + kk] = run;
    __syncthreads();
    const float tot0 = TOT[kk], tot1 = TOT[256 + kk];
    const float off = DIR ? (hf == 0 ? tot1 : 0.f) : (hf == 1 ? tot0 : 0.f);
    const float dec = expf(tot0 + tot1);
    {
#pragma unroll
      for (int p = 0; p < 32; ++p) { const int i = 32 * hf + p; const float bb = lc[p] + off, eb = __expf(bb), ebi = __expf(-bb);
        const float qv = bf2f(qraw[p]), kv = bf2f(kraw[p]);
        const unsigned short qt = (unsigned short)f2bf(qv * eb); *(LAS unsigned short*)(Qs + i * GL_ST + 2 * kk) = qt;
        const float kh = kv * ebi; *(LAS unsigned short*)(Ks + i * GL_ST + 2 * kk) = (unsigned short)f2bf(kh); lc[p] = kh * dec; } }
#pragma unroll
    for (int g = 0; g < 4; ++g) { u32x4 o;
#pragma unroll
        for (int q = 0; q < 4; ++q) o[q] = pk2(lc[8 * g + 2 * q], lc[8 * g + 2 * q + 1]);
        *(GAS u32x4*)(KT + ((size_t)u * 256 + kk) * 64 + 32 * hf + 8 * g) = o; }
    if (hf == 0) DEC[(size_t)u * 256 + kk] = dec;
    __syncthreads();
#pragma unroll
    for (int q = 0; q < 4; ++q) { const int e = tid + NTHREADS * q, i = e >> 5, ch = e & 31; *(GAS u32x4*)(QT + ((size_t)u * 64 + i) * 256 + 8 * ch) = *(const LAS u32x4*)(Qs + i * GL_ST + 16 * ch); }
    { const int tr = wave >> 1, tc0 = (wave & 1) * 2, l15 = lane & 15, kq = lane >> 4;
      f32x4 acc[2] = {(f32x4){0.f, 0.f, 0.f, 0.f}, (f32x4){0.f, 0.f, 0.f, 0.f}};
#pragma unroll
      for (int s = 0; s < 8; ++s) { const bf16x8v af = *(const LAS bf16x8v*)(Qs + (16 * tr + l15) * GL_ST + (32 * s + 8 * kq) * 2);
#pragma unroll
          for (int t2 = 0; t2 < 2; ++t2) { const bf16x8v bfr = *(const LAS bf16x8v*)(Ks + (16 * (tc0 + t2) + l15) * GL_ST + (32 * s + 8 * kq) * 2);
              acc[t2] = __builtin_amdgcn_mfma_f32_16x16x32_bf16(af, bfr, acc[t2], 0, 0, 0); } }
#pragma unroll
      for (int t2 = 0; t2 < 2; ++t2)
#pragma unroll
          for (int r = 0; r < 4; ++r) { const int i = 16 * tr + 4 * kq + r, j = 16 * (tc0 + t2) + l15; const bool keep = DIR ? (j >= i) : (j <= i);
              ATT[((size_t)u * 64 + i) * 64 + j] = (bf16)f2bf(keep ? acc[t2][r] : 0.f); } }
    { bf16* vt = VT + ((size_t)(u >> 1) * 512 + 256 * DIR + kk) * 64 + 32 * hf;
#pragma unroll
      for (int g = 0; g < 4; ++g) { u32x4 o;
#pragma unroll
          for (int q = 0; q < 4; ++q) { const int i = 32 * hf + 8 * g + 2 * q;
              o[q] = (unsigned)*(const LAS unsigned short*)(Vs + i * GL_ST + 2 * kk) | ((unsigned)*(const LAS unsigned short*)(Vs + (i + 1) * GL_ST + 2 * kk) << 16); }
          *(GAS u32x4*)(vt + 8 * g) = o; } }
}
__device__ __forceinline__ void gla_prep_phase(const Args& a, int slot, LAS unsigned char* lds, int tid, int wave, int lane, int wg, int G) {
    for (int u = wg; u < 1152; u += G) { if (u & 1) gla_prep_unit<1>(a, slot, u, lds, tid, wave, lane); else gla_prep_unit<0>(a, slot, u, lds, tid, wave, lane); }
}
constexpr int GS_VST = 144, GS_STB = 64 * GL_ST, GS_VSB = 64 * GS_VST;
struct ScanB { bf16x8v Qf[8], Af[2]; };
struct ScanC { bf16x8v Kf[2][4]; };
__device__ __forceinline__ int scan_chunk(int dir, int n) { return dir ? (n < 4 ? 3 - n : 39 - n) : n; }
__device__ __forceinline__ void scan_load_b(ScanB& o, const bf16* QT, const bf16* ATT, size_t u, int wave, int l15, int kq) {
#pragma unroll
    for (int s = 0; s < 8; ++s) o.Qf[s] = *(const GAS bf16x8v*)(QT + (u * 64 + 16 * wave + l15) * 256 + 32 * s + 8 * kq);
#pragma unroll
    for (int s = 0; s < 2; ++s) o.Af[s] = *(const GAS bf16x8v*)(ATT + (u * 64 + 16 * wave + l15) * 64 + 32 * s + 8 * kq);
}
__device__ __forceinline__ void scan_load_c(ScanC& o, const bf16* KT, size_t u, int cw, int r32, int hi) {
#pragma unroll
    for (int mt = 0; mt < 2; ++mt)
#pragma unroll
        for (int s = 0; s < 4; ++s) o.Kf[mt][s] = *(const GAS bf16x8v*)(KT + (u * 256 + 64 * cw + 32 * mt + r32) * 64 + 16 * s + 8 * hi);
}
__device__ __forceinline__ void scan_part_o(const ScanB& o, LAS unsigned char* os, const LAS unsigned char* stp, const LAS unsigned char* vs, int wave, int l15, int kq) {
    f32x4 oacc[4];
#pragma unroll
    for (int t4 = 0; t4 < 4; ++t4) oacc[t4] = (f32x4){0.f, 0.f, 0.f, 0.f};
    bf16x8v bfr[2][4];
#pragma unroll
    for (int t4 = 0; t4 < 4; ++t4) bfr[0][t4] = *(const LAS bf16x8v*)(stp + (16 * t4 + l15) * GL_ST + (8 * kq) * 2);
#pragma unroll
    for (int g = 0; g < 10; ++g) {
        if (g + 1 < 10) { const int s = g + 1;
#pragma unroll
            for (int t4 = 0; t4 < 4; ++t4) bfr[(g + 1) & 1][t4] = s < 8 ? *(const LAS bf16x8v*)(stp + (16 * t4 + l15) * GL_ST + (32 * s + 8 * kq) * 2)
                                                                         : *(const LAS bf16x8v*)(vs + (16 * t4 + l15) * GS_VST + (32 * (s - 8) + 8 * kq) * 2); }
#pragma unroll
        for (int t4 = 0; t4 < 4; ++t4) oacc[t4] = __builtin_amdgcn_mfma_f32_16x16x32_bf16(g < 8 ? o.Qf[g] : o.Af[g - 8], bfr[g & 1][t4], oacc[t4], 0, 0, 0);
    }
#pragma unroll
    for (int t4 = 0; t4 < 4; ++t4)
#pragma unroll
        for (int r = 0; r < 4; ++r) *(LAS unsigned short*)(os + (16 * wave + 4 * kq + r) * GS_VST + (16 * t4 + l15) * 2) = (unsigned short)f2bf(oacc[t4][r]);
}
__device__ __forceinline__ void scan_part_s(const ScanC& oc, f32x16 (&S)[2][2], LAS unsigned char* stn, const LAS unsigned char* vs, const LAS float* decs, int cw, int r32, int hi) {
    bf16x8v vfr[4][2];
#pragma unroll
    for (int s = 0; s < 4; ++s)
#pragma unroll
        for (int nt = 0; nt < 2; ++nt) vfr[s][nt] = *(const LAS bf16x8v*)(vs + (32 * nt + r32) * GS_VST + (16 * s + 8 * hi) * 2);
#pragma unroll
    for (int mt = 0; mt < 2; ++mt)
#pragma unroll
        for (int g = 0; g < 4; ++g) { const f32x4 dc = *(const LAS f32x4*)(decs + 64 * cw + 32 * mt + 8 * g + 4 * hi);
#pragma unroll
            for (int nt = 0; nt < 2; ++nt)
#pragma unroll
                for (int q = 0; q < 4; ++q) S[mt][nt][4 * g + q] *= dc[q]; }
#pragma unroll
    for (int s = 0; s < 4; ++s)
#pragma unroll
        for (int mt = 0; mt < 2; ++mt)
#pragma unroll
            for (int nt = 0; nt < 2; ++nt) S[mt][nt] = __builtin_amdgcn_mfma_f32_32x32x16_bf16(oc.Kf[mt][s], vfr[s][nt], S[mt][nt], 0, 0, 0);
#pragma unroll
    for (int mt = 0; mt < 2; ++mt)
#pragma unroll
        for (int nt = 0; nt < 2; ++nt)
#pragma unroll
            for (int g = 0; g < 4; ++g) { u32x2 w2; w2.x = pg8::cvt_pk_bf16(S[mt][nt][4 * g], S[mt][nt][4 * g + 1]); w2.y = pg8::cvt_pk_bf16(S[mt][nt][4 * g + 2], S[mt][nt][4 * g + 3]);
                *(LAS u32x2*)(stn + (32 * nt + r32) * GL_ST + (64 * cw + 32 * mt + 8 * g + 4 * hi) * 2) = w2; }
}
__device__ __forceinline__ void scan_flush_o(const LAS unsigned char* os, bf16* O, int b, int h, int c, int dvs, int tid) {
    const u32x4 v = *(const LAS u32x4*)(os + (tid >> 3) * GS_VST + 16 * (tid & 7));
    bf16* op = O + ((size_t)b * TT + 64 * c + (tid >> 3)) * 2048 + h * 512 + 64 * dvs + 8 * (tid & 7);
    asm volatile("s_waitcnt lgkmcnt(0)\n\tglobal_store_dwordx4 %0, %1, off\n\ts_nop 2" :: "v"(op), "v"(v) : "memory");
}
template <bool OW> __device__ __forceinline__ void gla_scan_body(const Args& a, LAS unsigned char* lds, int tid, int wave, int lane, int wg, int G) {
    const bf16* QT = (const bf16*)(OPQ(a.ws) + WS_MIX + MIX_GQT); const bf16* KT = (const bf16*)(OPQ(a.ws) + WS_MIX + MIX_GKT); const bf16* VT = (const bf16*)(OPQ(a.ws) + WS_MIX + MIX_GVT);
    const bf16* ATT = (const bf16*)(OPQ(a.ws) + WS_MIX + MIX_GATT); const float* DEC = (const float*)(OPQ(a.ws) + WS_MIX + MIX_GDEC);
    LAS unsigned char* ST = lds; LAS unsigned char* Vs = lds + 2 * GS_STB; LAS unsigned char* Os = lds + 2 * GS_STB + 2 * GS_VSB; LAS float* DECs = (LAS float*)(lds + 2 * GS_STB + 4 * GS_VSB);
    const int l15 = lane & 15, kq = lane >> 4, r32 = lane & 31, hi = lane >> 5, cw = wave & 3;
    const int vso = (tid >> 3) * GS_VST + 16 * (tid & 7);
    for (int item = wg; item < 256; item += G) {
        const int dvs = (item >> 3) & 7, combo = (item & 7) * 4 + (item >> 6), dir = combo & 1, h = (combo >> 1) & 3, b = combo >> 3, bh = b * 4 + h;
        bf16* O = (bf16*)(OPQ(a.ws) + WS_MIX + (dir ? MIX_GOB : MIX_GOF));
        __syncthreads();
        for (int e = tid; e < GS_STB / 16; e += NTHREADS) *(LAS u32x4*)(ST + GS_STB + 16 * e) = (u32x4){0u, 0u, 0u, 0u};
        f32x16 S[2][2];
#pragma unroll
        for (int mt = 0; mt < 2; ++mt)
#pragma unroll
            for (int nt = 0; nt < 2; ++nt)
#pragma unroll
                for (int i = 0; i < 16; ++i) S[mt][nt][i] = 0.f;
        ScanB BA, BB; ScanC CA, CB; u32x4 vA, vB; f32x4 dA = (f32x4){0.f, 0.f, 0.f, 0.f}, dB = dA;
#define SCAN_BAR() do { asm volatile("s_waitcnt lgkmcnt(0)" ::: "memory"); __builtin_amdgcn_s_barrier(); asm volatile("" ::: "memory"); } while (0)
#define SCAN_LOAD(BS, CS, vr, dr, n_) do { const int c_ = scan_chunk(dir, (n_)); const size_t uv_ = (size_t)bh * 36 + c_, u_ = uv_ * 2 + dir; \
            vr = *(const GAS u32x4*)(VT + (uv_ * 512 + 64 * dvs + (tid >> 3)) * 64 + 8 * (tid & 7)); if (tid < 64) dr = *(const GAS f32x4*)(DEC + u_ * 256 + 4 * tid); \
            if constexpr (OW) scan_load_b(BS, QT, ATT, u_, wave, l15, kq); else scan_load_c(CS, KT, u_, cw, r32, hi); } while (0)
#define SCAN_STAGE(vr, dr, buf) do { *(LAS u32x4*)(Vs + (buf) * GS_VSB + vso) = vr; if (tid < 64) *(LAS f32x4*)(DECs + (buf) * 256 + 4 * tid) = dr; } while (0)
#define SCAN_STEP(BS, CS, n_) do { const int n__ = (n_); if constexpr (OW) scan_part_o(BS, Os + (n__ & 1) * GS_VSB, ST + ((n__ + 1) & 1) * GS_STB, Vs + (n__ & 1) * GS_VSB, wave, l15, kq); \
            else scan_part_s(CS, S, ST + (n__ & 1) * GS_STB, Vs + (n__ & 1) * GS_VSB, DECs + (n__ & 1) * 256, cw, r32, hi); } while (0)
        SCAN_LOAD(BA, CA, vA, dA, 0);
        SCAN_STAGE(vA, dA, 0);
        SCAN_LOAD(BB, CB, vB, dB, 1);
        SCAN_BAR();
#pragma unroll 1
        for (int n = 0; n < 36; n += 2) {
            SCAN_STEP(BA, CA, n);
            SCAN_STAGE(vB, dB, 1);
            if (n > 0) scan_flush_o(Os + GS_VSB, O, b, h, scan_chunk(dir, n - 1), dvs, tid);
            SCAN_LOAD(BA, CA, vA, dA, n + 2 < 36 ? n + 2 : 35);
            SCAN_BAR();
            SCAN_STEP(BB, CB, n + 1);
            SCAN_STAGE(vA, dA, 0);
            scan_flush_o(Os, O, b, h, scan_chunk(dir, n), dvs, tid);
            SCAN_LOAD(BB, CB, vB, dB, n + 3 < 36 ? n + 3 : 35);
            SCAN_BAR();
        }
        scan_flush_o(Os + GS_VSB, O, b, h, scan_chunk(dir, 35), dvs, tid);
#undef SCAN_BAR
#undef SCAN_LOAD
#undef SCAN_STAGE
#undef SCAN_STEP
    }
}
__device__ __forceinline__ void gla_scan_phase(const Args& a, LAS unsigned char* lds, int tid, int wave, int lane, int wg, int G) {
    if (wave < 4) gla_scan_body<true>(a, lds, tid, wave, lane, wg, G); else gla_scan_body<false>(a, lds, tid, wave, lane, wg, G);
}
__device__ __forceinline__ void gla_onorm_phase(const Args& a, int slot, bool skip_ctx, int lane, int gw, int ngw) {
    const bf16* OF = (const bf16*)(OPQ(a.ws) + WS_MIX + MIX_GOF); const bf16* OB = (const bf16*)(OPQ(a.ws) + WS_MIX + MIX_GOB); const bf16* OG = (const bf16*)(OPQ(a.ws) + WS_MIX + MIX_GOG);
    const float* og_g = OPQF(a.in[13]) + (size_t)slot * D; bf16* HA = (bf16*)(OPQ(a.ws) + WS_HA);
    for (int r = gw; r < M; r += ngw) {
        if (skip_ctx && (r % TT) < LC) continue;
#pragma unroll
        for (int hh = 0; hh < 4; ++hh) {
            const size_t off = (size_t)r * D + hh * 512 + 8 * lane;
            const u32x4 f = *(const GAS u32x4*)(OF + off), bk = *(const GAS u32x4*)(OB + off), g = *(const GAS u32x4*)(OG + off);
            float o[8];
#pragma unroll
            for (int q = 0; q < 4; ++q) { o[2 * q] = bflo(f[q]) + bflo(bk[q]); o[2 * q + 1] = bfhi(f[q]) + bfhi(bk[q]); }
            float ss = 0.f;
#pragma unroll
            for (int q = 0; q < 8; ++q) ss += o[q] * o[q];
            const float rs = 1.0f / sqrtf(wave_sum(ss) * (1.0f / 512.0f) + EPS);
            const f32x4 w0 = *(const GAS f32x4*)(og_g + hh * 512 + 8 * lane), w1 = *(const GAS f32x4*)(og_g + hh * 512 + 8 * lane + 4);
            u32x4 w;
#pragma unroll
            for (int q = 0; q < 4; ++q) { const float wa = q < 2 ? w0[2 * q] : w1[2 * q - 4], wb = q < 2 ? w0[2 * q + 1] : w1[2 * q - 3];
                w[q] = pk2(o[2 * q] * rs * wa * bflo(g[q]), o[2 * q + 1] * rs * wb * bfhi(g[q])); }
            *(GAS u32x4*)(HA + off) = w;
        }
    }
}

constexpr int ATT_KST = 144, ATT_VST = 136, ATT_KB = 64 * ATT_KST, ATT_VB = 64 * ATT_VST;
__device__ __forceinline__ void swa_attn_phase(const Args& a, bool skip_ctx, LAS unsigned char* lds, int tid, int wave, int lane, int wg, int G) {
    const bf16* SQ = (const bf16*)(OPQ(a.ws) + WS_MIX + MIX_SQ); const bf16* SK = (const bf16*)(OPQ(a.ws) + WS_MIX + MIX_SK); const bf16* SVT = (const bf16*)(OPQ(a.ws) + WS_MIX + MIX_SV);
    const float* sink = OPQF(a.in[16]); bf16* HA = (bf16*)(OPQ(a.ws) + WS_HA);
    LAS unsigned char* Kb = lds; LAS unsigned char* Vb = lds + 2 * ATT_KB;
    const int r32 = lane & 31, hi = lane >> 5, srow = tid >> 3, sch = tid & 7;
    const int nunits = skip_ctx ? 512 : 576;
    for (int ui = wg; ui < nunits; ui += G) {
        const bool lat = ui < 512;
        int b, kvh, qb; { const int w = ui & 255, x = w & 7, s = w >> 3;
            if (lat) { const int combo = 2 * x + (ui >> 8); b = combo >> 2; kvh = combo & 3; qb = s; }
            else { const int combo = 2 * x + (s & 1); b = combo >> 2; kvh = combo & 3; qb = (s >> 1) & 3; } }
        const int head = kvh * 8 + wave;
        const int tq0 = lat ? LC + 64 * qb : 64 * qb;
        const int w_lo = qb - 2 < 0 ? 0 : qb - 2, w_hi = qb + 2 > 31 ? 31 : qb + 2;
        const int ntile = lat ? 4 + (w_hi - w_lo + 1) : 4;
        const bf16* kbase = SK + (size_t)b * TT * 256 + kvh * 64 + (size_t)srow * 256 + 8 * sch;
        const bf16* vbase = SVT + ((size_t)(b * 4 + kvh) * 64 + srow) * TT + 8 * sch;
        bf16x8v Qf[2][4];
#pragma unroll
        for (int nt = 0; nt < 2; ++nt)
#pragma unroll
            for (int ks = 0; ks < 4; ++ks) Qf[nt][ks] = *(const GAS bf16x8v*)(SQ + ((size_t)b * TT + tq0 + 32 * nt + r32) * D + head * 64 + 16 * ks + 8 * hi);
        const float sink2 = sink[head] * 1.4426950408889634f;
        float m2[2] = {sink2, sink2}, ls[2] = {hi ? 0.f : 1.f, hi ? 0.f : 1.f};
        f32x16 O[2][2];
#pragma unroll
        for (int dt = 0; dt < 2; ++dt)
#pragma unroll
            for (int nt = 0; nt < 2; ++nt)
#pragma unroll
                for (int i = 0; i < 16; ++i) O[dt][nt][i] = 0.f;
        u32x4 kreg, vreg;
        { const int t0 = 0; kreg = *(const GAS u32x4*)(kbase + (size_t)t0 * 256); vreg = *(const GAS u32x4*)(vbase + t0); }
        *(LAS u32x4*)(Kb + srow * ATT_KST + 16 * sch) = kreg;
        *(LAS u32x2*)(Vb + srow * ATT_VST + 16 * sch) = (u32x2){vreg.x, vreg.y}; *(LAS u32x2*)(Vb + srow * ATT_VST + 16 * sch + 8) = (u32x2){vreg.z, vreg.w};
        __syncthreads();
#pragma unroll 1
        for (int j = 0; j < ntile; ++j) {
            const int buf = j & 1;
            if (j + 1 < ntile) { const int jn = j + 1; const int t0 = jn < 4 ? 64 * jn : LC + 64 * (w_lo + jn - 4);
                kreg = *(const GAS u32x4*)(kbase + (size_t)t0 * 256); vreg = *(const GAS u32x4*)(vbase + t0); }
            const int rel = j < 4 ? 0 : (w_lo + j - 4) - qb;
            const bool masked = (rel == 2 || rel == -2);
            const LAS unsigned char* kt = Kb + buf * ATT_KB; const LAS unsigned char* vt = Vb + buf * ATT_VB;
#pragma unroll
            for (int nt = 0; nt < 2; ++nt) {
                f32x16 s[2];
#pragma unroll
                for (int mt = 0; mt < 2; ++mt) {
#pragma unroll
                    for (int i = 0; i < 16; ++i) s[mt][i] = -m2[nt];
#pragma unroll
                    for (int ks = 0; ks < 4; ++ks) { const bf16x8v kf = *(const LAS bf16x8v*)(kt + (32 * mt + r32) * ATT_KST + (16 * ks + 8 * hi) * 2);
                        s[mt] = __builtin_amdgcn_mfma_f32_32x32x16_bf16(kf, Qf[nt][ks], s[mt], 0, 0, 0); }
                }
                __builtin_amdgcn_sched_barrier(0);
                if (masked) {
                    int mb = r32 - 4 * hi - 64 * rel; asm volatile("" : "+v"(mb));
#pragma unroll
                    for (int mt = 0; mt < 2; ++mt)
#pragma unroll
                        for (int i = 0; i < 16; ++i) { const int cc = 32 * mt + (i & 3) + 8 * (i >> 2) - 32 * nt;
                            if (mb > 128 + cc || mb < cc - 128) s[mt][i] = -1e30f; }
                }
                float mx = s[0][0];
#pragma unroll
                for (int i = 1; i < 16; ++i) mx = fmaxf(mx, s[0][i]);
#pragma unroll
                for (int i = 0; i < 16; ++i) mx = fmaxf(mx, s[1][i]);
                mx = fmaxf(mx, __shfl_xor(mx, 32));
                if (__any(mx > 8.0f)) { const float dlt = fmaxf(mx, 0.f), alpha = __builtin_amdgcn_exp2f(-dlt); m2[nt] += dlt; ls[nt] *= alpha;
#pragma unroll
                    for (int mt = 0; mt < 2; ++mt)
#pragma unroll
                        for (int i = 0; i < 16; ++i) s[mt][i] -= dlt;
#pragma unroll
                    for (int dt = 0; dt < 2; ++dt)
#pragma unroll
                        for (int i = 0; i < 16; ++i) O[dt][nt][i] *= alpha; }
                float psum = 0.f;
#pragma unroll
                for (int mt = 0; mt < 2; ++mt)
#pragma unroll
                    for (int i = 0; i < 16; ++i) { s[mt][i] = __builtin_amdgcn_exp2f(s[mt][i]); psum += s[mt][i]; }
                ls[nt] += psum;
                __builtin_amdgcn_sched_barrier(0);
                bf16x8v Pf[2][2];
#pragma unroll
                for (int mt = 0; mt < 2; ++mt)
#pragma unroll
                    for (int s2 = 0; s2 < 2; ++s2) { u32x4 w;
#pragma unroll
                        for (int q = 0; q < 4; ++q) w[q] = pg8::cvt_pk_bf16(s[mt][8 * s2 + 2 * q], s[mt][8 * s2 + 2 * q + 1]);
                        Pf[mt][s2] = __builtin_bit_cast(bf16x8v, w); }
#pragma unroll
                for (int dt = 0; dt < 2; ++dt)
#pragma unroll
                    for (int mt = 0; mt < 2; ++mt)
#pragma unroll
                        for (int s2 = 0; s2 < 2; ++s2) { const LAS unsigned char* vp = vt + (32 * dt + r32) * ATT_VST + (32 * mt + 16 * s2 + 4 * hi) * 2;
                            const u32x2 lo = *(const LAS u32x2*)vp, hh = *(const LAS u32x2*)(vp + 16);
                            const bf16x8v vf = __builtin_bit_cast(bf16x8v, (u32x4){lo.x, lo.y, hh.x, hh.y});
                            O[dt][nt] = __builtin_amdgcn_mfma_f32_32x32x16_bf16(vf, Pf[mt][s2], O[dt][nt], 0, 0, 0); }
                __builtin_amdgcn_sched_barrier(0);
            }
            if (j + 1 < ntile) { const int nb = buf ^ 1;
                *(LAS u32x4*)(Kb + nb * ATT_KB + srow * ATT_KST + 16 * sch) = kreg;
                *(LAS u32x2*)(Vb + nb * ATT_VB + srow * ATT_VST + 16 * sch) = (u32x2){vreg.x, vreg.y}; *(LAS u32x2*)(Vb + nb * ATT_VB + srow * ATT_VST + 16 * sch + 8) = (u32x2){vreg.z, vreg.w}; }
            __syncthreads();
        }
#pragma unroll
        for (int nt = 0; nt < 2; ++nt) {
            const float lt = ls[nt] + __shfl_xor(ls[nt], 32), inv = 1.0f / lt;
            bf16* op = HA + ((size_t)b * TT + tq0 + 32 * nt + r32) * D + head * 64 + 4 * hi;
#pragma unroll
            for (int dt = 0; dt < 2; ++dt)
#pragma unroll
                for (int g = 0; g < 4; ++g) { u32x2 w; w.x = pg8::cvt_pk_bf16(O[dt][nt][4 * g] * inv, O[dt][nt][4 * g + 1] * inv); w.y = pg8::cvt_pk_bf16(O[dt][nt][4 * g + 2] * inv, O[dt][nt][4 * g + 3] * inv);
                    *(GAS u32x2*)(op + 32 * dt + 8 * g) = w; }
        }
    }
}

__device__ __forceinline__ void gmlp_stats_phase(const Args& a, bool skip_ctx, int lane, int gw, int ngw) {
    const bf16* V = (const bf16*)(OPQ(a.ws) + WS_MIX + MIX_V); float* MU = (float*)(OPQ(a.ws) + WS_STAT); float* RS = MU + M;
    for (int r = gw; r < M; r += ngw) {
        if (skip_ctx && (r % TT) < LC) continue;
        float v[32];
#pragma unroll
        for (int j = 0; j < 4; ++j) { const u32x4 w = *(const GAS u32x4*)(V + (size_t)r * D + 512 * j + 8 * lane);
#pragma unroll
            for (int q = 0; q < 4; ++q) { v[8 * j + 2 * q] = bflo(w[q]); v[8 * j + 2 * q + 1] = bfhi(w[q]); } }
        float s = 0.f;
#pragma unroll
        for (int j = 0; j < 32; ++j) s += v[j];
        const float mean = wave_sum(s) * (1.0f / D); float q2 = 0.f;
#pragma unroll
        for (int j = 0; j < 32; ++j) { const float d = v[j] - mean; q2 += d * d; }
        const float var = wave_sum(q2) * (1.0f / D);
        if (lane == 0) { MU[r] = mean; RS[r] = 1.0f / sqrtf(var + EPS); }
    }
}
constexpr int GM_ST = 272;
__device__ __forceinline__ void gmlp_spatial_phase(const Args& a, bool skip_ctx, LAS unsigned char* lds, int tid, int wave, int lane, int wg, int G) {
    LAS unsigned char* VT = lds;
    LAS unsigned char* WSs = lds + 128 * GM_ST;
    const bf16* U = (const bf16*)(OPQ(a.ws) + WS_MIX + MIX_U); const bf16* V = (const bf16*)(OPQ(a.ws) + WS_MIX + MIX_V);
    const float* MU = (const float*)(OPQ(a.ws) + WS_STAT); const float* RS = MU + M;
    const float* lng = OPQF(a.in[19]); const float* lnb = OPQF(a.in[20]); const float* wsp = OPQF(a.in[21]); const float* bs = OPQF(a.in[22]); bf16* HA = (bf16*)(OPQ(a.ws) + WS_HA);
    const int l15 = lane & 15, kq = lane >> 4;
    for (int g = wg & 15; g < 16; g += (G >= 16 ? 16 : G)) {
        if (G < 16 && false) {}
        const int C0 = 128 * g;
        __syncthreads();
        for (int e = tid; e < 128 * 32; e += NTHREADS) { const int i = e >> 5, j4 = e & 31; const f32x4 w = *(const GAS f32x4*)(wsp + (size_t)g * 16384 + i * 128 + 4 * j4);
            u32x2 o; o.x = pk2(w[0], w[1]); o.y = pk2(w[2], w[3]); *(LAS u32x2*)(WSs + i * GM_ST + 8 * j4) = o; }
        for (int n = wg >> 4; n < 72; n += (G >> 4 > 0 ? G >> 4 : 1)) {
            const int R0 = 128 * n;
            if (skip_ctx && (R0 % TT) < LC) continue;
            __syncthreads();
#pragma unroll
            for (int q = 0; q < 4; ++q) { const int e = tid + NTHREADS * q, j = e >> 4, c8 = (e & 15) * 8;
                const u32x4 vv = *(const GAS u32x4*)(V + (size_t)(R0 + j) * D + C0 + c8); const float mu = MU[R0 + j], rs = RS[R0 + j];
                const f32x4 g0 = *(const GAS f32x4*)(lng + C0 + c8), g1 = *(const GAS f32x4*)(lng + C0 + c8 + 4), b0 = *(const GAS f32x4*)(lnb + C0 + c8), b1 = *(const GAS f32x4*)(lnb + C0 + c8 + 4);
#pragma unroll
                for (int k = 0; k < 4; ++k) { const float x0 = (bflo(vv[k]) - mu) * rs, x1 = (bfhi(vv[k]) - mu) * rs;
                    const float ga = k < 2 ? g0[2 * k] : g1[2 * k - 4], gb = k < 2 ? g0[2 * k + 1] : g1[2 * k - 3], ba_ = k < 2 ? b0[2 * k] : b1[2 * k - 4], bb = k < 2 ? b0[2 * k + 1] : b1[2 * k - 3];
                    const int sw = ((((j >> 3) ^ (c8 >> 3)) & 15) << 4) + (j & 7) * 2;
                    *(LAS unsigned short*)(VT + (c8 + 2 * k) * GM_ST + sw) = (unsigned short)f2bf(x0 * ga + ba_);
                    *(LAS unsigned short*)(VT + (c8 + 2 * k + 1) * GM_ST + sw) = (unsigned short)f2bf(x1 * gb + bb); } }
            __syncthreads();
            bf16x8v Bf[4];
#pragma unroll
            for (int ks = 0; ks < 4; ++ks) Bf[ks] = *(const LAS bf16x8v*)(WSs + (16 * wave + l15) * GM_ST + (32 * ks + 8 * kq) * 2);
            const int i = 16 * wave + l15; const float bsv = bs[g * 128 + i];
            const size_t orow = (size_t)(R0 + i) * D + C0 + 4 * kq;
#pragma unroll
            for (int ct = 0; ct < 8; ++ct) { f32x4 acc = (f32x4){0.f, 0.f, 0.f, 0.f};
#pragma unroll
                for (int ks = 0; ks < 4; ++ks) { const int cr = 16 * ct + l15; const bf16x8v af = *(const LAS bf16x8v*)(VT + cr * GM_ST + ((((4 * ks + kq) ^ (cr >> 3)) & 15) << 4));
                    acc = __builtin_amdgcn_mfma_f32_16x16x32_bf16(af, Bf[ks], acc, 0, 0, 0); }
                const u32x2 uu = *(const GAS u32x2*)(U + orow + 16 * ct);
                u32x2 o; o.x = pk2(bflo(uu.x) * (acc[0] + bsv), bfhi(uu.x) * (acc[1] + bsv)); o.y = pk2(bflo(uu.y) * (acc[2] + bsv), bfhi(uu.y) * (acc[3] + bsv));
                *(GAS u32x2*)(HA + orow + 16 * ct) = o; }
        }
    }
}

#ifndef SITE_MASK
#define SITE_MASK 0x1ff
#endif
#define SITE(n) (((SITE_MASK) >> (n)) & 1)
#ifndef DUP_PHASE
#define DUP_PHASE (-1)
#endif
#define REPS(p) for (int rep_ = 0; rep_ < (((p) == DUP_PHASE) ? 2 : 1); ++rep_)
constexpr int N_PHASES = 2 + 9 * DEPTH;
__host__ __device__ constexpr bool phase_exists(int p) { if (p < 2) return true; const int q = (p - 2) % 9, kind = ((p - 2) / 9) % 3; return !((q == 2 && kind == 1) || (q == 3 && kind != 0)); }

__global__ void __launch_bounds__(NTHREADS, 2) trunk_fwd(Args args) {
    extern __shared__ __attribute__((aligned(16))) unsigned char lds_raw[];
    LAS unsigned char* lds = (LAS unsigned char*)lds_raw;
    const int wave = __builtin_amdgcn_readfirstlane((int)threadIdx.x >> 6);
#define FRESH_WS() unsigned char* ws = args.ws; asm volatile("" : "+s"(ws))
#define FRESH_TID() int tid_f = threadIdx.x; asm volatile("" : "+v"(tid_f)); const int tid = tid_f, lane = tid & 63; (void)lane
    const int G = gridDim.x, wg = blockIdx.x;
    const int gw = wg * NWAVES + wave, ngw = G * NWAVES;
    unsigned char* ws = args.ws;
    gu32* ctl = (gu32*)(OPQ(args.ws) + WS_CTL);
    for (int u = threadIdx.x; u < (LDS_BYTES - LDSCTL_OFF) / 4; u += NTHREADS) ((LAS unsigned*)(lds + LDSCTL_OFF))[u] = 0u;
    __syncthreads();
    XcdBarrier bar = xcd_barrier_post((unsigned*)(ctl + CW_BAR), (volatile LAS unsigned*)(lds + MISC_OFF) + 8);
    const int lo = args.ph_lo, hi = args.ph_hi;
#define IN(k) (lo <= (k) && (k) < hi)
#define PULL(until, quota) do { int tp_ = threadIdx.x; asm volatile("" : "+v"(tp_)); tr_pull(args, lds, wave, tp_ & 63, (until), (quota)); } while (0)
#define LIGHT(nunits) (((nunits) % G) != 0 && wg >= ((nunits) % G))
#define SEAM(k) do { if ((k) + 1 < hi) { XcdBarrier bl = bar; asm volatile("" : "+s"(bl.bar)); xcd_barrier(bl); } } while (0)

    if (IN(0) && SITE(8)) { FRESH_TID(); REPS(0) { if (wg < 64) adaln_unit(args, lds, tid, wave, lane, 0, wg); if (wg == G - 1) p0_rope(args, tid); tr_pull(args, lds, wave, lane, PROLOGUE_UNTIL, 1 << 20); __syncthreads(); } SEAM(0); }
    if (IN(1) && SITE(8)) { FRESH_TID(); norm0_phase(args, wave, lane, wg, G); SEAM(1); }

    const pg8::bf16_t* HA = (const pg8::bf16_t*)(OPQ(args.ws) + WS_HA);
#pragma unroll 1
    for (int l = 0; l < DEPTH; ++l) {
        const int base = 2 + 9 * l, kind = l % 3, slot = l / 3;
        const bool last = (l == DEPTH - 1);
        if (IN(base + 0)) { REPS(base + 0) {
            if (kind == 0) {
                pg8::Gemm g{HA, (const pg8::bf16_t*)(OPQ(args.ws) + WS_GLAW + slot * GLAW_STRIDE), M, GLA_NP, D, D}; pg8::Sched S; S.init(M / 256, GLA_NP / 256, G, wg, 0);
                pg8::EpiGlaIn E{(pg8::bf16_t*)(OPQ(args.ws) + WS_MIX + MIX_GQ), (pg8::bf16_t*)(OPQ(args.ws) + WS_MIX + MIX_GK), (pg8::bf16_t*)(OPQ(args.ws) + WS_MIX + MIX_GV), (pg8::bf16_t*)(OPQ(args.ws) + WS_MIX + MIX_GOG), (float*)(OPQ(args.ws) + WS_A32)};
                if (SITE(0)) pg8::gemm_phase<pg8::EpiGlaIn, pg8::Sched, true, true>(lds, g, S, E);
            } else if (kind == 1) {
                pg8::Gemm g{HA, (const pg8::bf16_t*)(OPQ(args.ws) + WS_SWAW), M, SWA_N, D, D}; pg8::Sched S; S.init(M / 256, SWA_N / 256, G, wg, 0);
                pg8::EpiSwaIn E{(pg8::bf16_t*)(OPQ(args.ws) + WS_MIX + MIX_SQ), (pg8::bf16_t*)(OPQ(args.ws) + WS_MIX + MIX_SK), (pg8::bf16_t*)(OPQ(args.ws) + WS_MIX + MIX_SV), (const float*)(OPQ(args.ws) + WS_ROPE), (const float*)(OPQ(args.ws) + WS_ROPE) + 1024};
                if (SITE(1)) pg8::gemm_phase<pg8::EpiSwaIn, pg8::Sched, true, true>(lds, g, S, E);
            } else {
                pg8::Gemm g{HA, (const pg8::bf16_t*)(OPQ(args.ws) + WS_GMW), M, GM_N, D, D}; pg8::Sched S; S.init(M / 256, GM_N / 256, G, wg, 0);
                pg8::EpiGmlpIn E{(pg8::bf16_t*)(OPQ(args.ws) + WS_MIX + MIX_U), (pg8::bf16_t*)(OPQ(args.ws) + WS_MIX + MIX_V)};
                if (SITE(2)) pg8::gemm_phase<pg8::EpiGmlpIn, pg8::Sched, true, true>(lds, g, S, E);
            }
            { const int nun = 36 * (kind == 0 ? GLA_NP / 256 : (kind == 1 ? SWA_N / 256 : GM_N / 256)); if (LIGHT(nun)) { const int li = wg - (nun % G); if (!last && li < 64) { FRESH_TID(); adaln_unit(args, lds, tid, wave, lane, l + 1, li); } PULL(tr_need(base + 6 + REACH), Q_IN); } }
            } SEAM(base + 0);
        }
        if (IN(base + 1)) { FRESH_TID(); REPS(base + 1) {
            if (kind == 0) gla_prep_phase(args, slot, lds, tid, wave, lane, wg, G);
            else if (kind == 1) swa_attn_phase(args, last, lds, tid, wave, lane, wg, G);
            else gmlp_stats_phase(args, last, lane, gw, ngw);
            __syncthreads(); } SEAM(base + 1);
        }
        if (IN(base + 2) && kind != 1) { FRESH_TID(); REPS(base + 2) {
            if (kind == 0) gla_scan_phase(args, lds, tid, wave, lane, wg, G);
            else gmlp_spatial_phase(args, last, lds, tid, wave, lane, wg, G);
            __syncthreads(); } SEAM(base + 2);
        }
        if (IN(base + 3) && kind == 0) { FRESH_TID(); REPS(base + 3) {
            gla_onorm_phase(args, slot, last, lane, gw, ngw);
            __syncthreads(); } SEAM(base + 3);
        }
        if (IN(base + 4)) { REPS(base + 4) {
            const size_t wo = kind == 0 ? WS_GLAW + slot * GLAW_STRIDE + GLAW_WO : (kind == 1 ? WS_SWAW + SWAW_WO : WS_GMW + GMW_WO);
#pragma unroll 1
            for (int pass = 0; pass < (last ? 1 : 2); ++pass) {
                pg8::Gemm g{HA, (const pg8::bf16_t*)(OPQ(args.ws) + wo), M, D, D, D}; pg8::Sched S; S.init(32, D / 256, G, wg, 1);
                pg8::EpiY E{(pg8::bf16_t*)(OPQ(args.ws) + WS_Y), nullptr, D};
                if (pass) { const int cp = wg >> 5, sl = wg & 3, Ks = D / 4; g.A += sl * Ks; g.Bt += sl * Ks; g.K = Ks; S.init_one(wg < 128, 9 * cp, (wg >> 2) & 7);
                    E.P = (float*)(OPQ(args.ws) + WS_YP) + (ptrdiff_t)sl * (NB * LC) * D + (ptrdiff_t)(cp - 9 * cp) * 256 * D; }
                if (SITE(3)) pg8::gemm_phase<pg8::EpiY, pg8::Sched, true, true>(lds, g, S, E);
            }
            if (!last && wg >= 128) PULL(tr_need(base + 6 + REACH), Q_WO);
            } SEAM(base + 4);
        }
        if (IN(base + 5)) { FRESH_TID(); if (SITE(7)) resid_phase<0>(args, l, lds, tid, wave, lane, wg, G); PULL(tr_need(base + 6), 1 << 20); SEAM(base + 5); }
        if (IN(base + 6)) { REPS(base + 6) {
            pg8::Gemm g{HA, (const pg8::bf16_t*)(OPQ(args.ws) + WS_FFNW + l * FFNW_STRIDE), M, 2 * FF, D, D}; pg8::Sched S; S.init(last ? 32 : 36, 2 * FF / 256, G, wg, last ? 1 : 0); S.set_tail(D / 64);
            pg8::EpiUp E{(pg8::bf16_t*)(OPQ(args.ws) + WS_HFF), FF, (unsigned*)(OPQ(args.ws) + WS_CTL) + CW_SPLIT + l * 128, OPQ(args.ws) + WS_YP, (LAS unsigned*)(lds + MISC_OFF + 4), 1 << S.Ssh};
            if (SITE(4)) pg8::gemm_phase<pg8::EpiUp, pg8::Sched, true, true>(lds, g, S, E);
            PULL(tr_need(base + 7), 1 << 20);
            } SEAM(base + 6);
        }
        if (IN(base + 7)) { REPS(base + 7) {
#pragma unroll 1
            for (int pass = 0; pass < (last ? 1 : 2); ++pass) {
                pg8::Gemm g{(const pg8::bf16_t*)(OPQ(args.ws) + WS_HFF), (const pg8::bf16_t*)(OPQ(args.ws) + WS_FFNW + l * FFNW_STRIDE + FFNW_W2), M, D, FF, FF}; pg8::Sched S; S.init(32, D / 256, G, wg, 1);
                pg8::EpiY E{(pg8::bf16_t*)(OPQ(args.ws) + WS_Y), nullptr, D};
                if (pass) { const int cp = wg >> 5, sl = wg & 3, Ks = FF / 4; g.A += sl * Ks; g.Bt += sl * Ks; g.K = Ks; S.init_one(wg < 128, 9 * cp, (wg >> 2) & 7);
                    E.P = (float*)(OPQ(args.ws) + WS_YP) + (ptrdiff_t)sl * (NB * LC) * D + (ptrdiff_t)(cp - 9 * cp) * 256 * D; }
                if (SITE(5)) pg8::gemm_phase<pg8::EpiY, pg8::Sched, true, true>(lds, g, S, E);
            }
            if (!last && wg >= 128) PULL(tr_need(base + 9), Q_DN);
            } SEAM(base + 7);
        }
        if (IN(base + 8)) { FRESH_TID(); if (SITE(7)) resid_phase<1>(args, l, lds, tid, wave, lane, wg, G); if (!last) PULL(tr_need(base + 9), 1 << 20); SEAM(base + 8); }
    }
#undef IN
#undef SEAM
}

#ifndef MK_ONE_LAUNCH
#define MK_ONE_LAUNCH 0
#endif
extern "C" void kernel_launch(void* const* d_in, const int* in_sizes, int n_in, void* d_out, int out_size, void* d_ws, size_t ws_size, hipStream_t stream) {
    static int grid = 0;
    if (grid == 0) {
        if (n_in != 24 || out_size != NB * SEQ * D || ws_size < WS_END) { fprintf(stderr, "kernel_launch: unexpected problem (n_in %d, out %d, ws %zu); nothing launched\n", n_in, out_size, ws_size); grid = -1; return; }
        int dev = 0, cus = 0, per_cu = 0;
        if (hipGetDevice(&dev) != hipSuccess || hipDeviceGetAttribute(&cus, hipDeviceAttributeMultiprocessorCount, dev) != hipSuccess) { grid = -1; return; }
        if (hipFuncSetAttribute((const void*)trunk_fwd, hipFuncAttributeMaxDynamicSharedMemorySize, LDS_BYTES) != hipSuccess) { fprintf(stderr, "kernel_launch: hipFuncSetAttribute failed\n"); grid = -1; return; }
        if (hipOccupancyMaxActiveBlocksPerMultiprocessor(&per_cu, (const void*)trunk_fwd, NTHREADS, LDS_BYTES) != hipSuccess || per_cu < 1) { fprintf(stderr, "kernel_launch: occupancy query says %d\n", per_cu); }
        (void)hipGetLastError();
        grid = cus;
    }
    if (grid < 0) return;
    if (hipMemsetAsync((char*)d_ws + WS_CTL, 0, CTL_ZERO_BYTES, stream) != hipSuccess) return;
    Args a{};
    for (int i = 0; i < 24; ++i) a.in[i] = (const float*)d_in[i];
    a.out = (float*)d_out; a.ws = (unsigned char*)d_ws;
#if MK_ONE_LAUNCH
    a.ph_lo = 0; a.ph_hi = N_PHASES;
    hipLaunchKernelGGL(trunk_fwd, dim3(grid), dim3(NTHREADS), LDS_BYTES, stream, a);
#else
#ifndef HOST_DUP_PHASE
#define HOST_DUP_PHASE (-1)
#endif
#ifndef HOST_DUP_REPS
#define HOST_DUP_REPS 2
#endif
    for (int p = 0; p < N_PHASES; ++p) { if (!phase_exists(p)) continue; a.ph_lo = p; a.ph_hi = p + 1;
        for (int rep = 0; rep < (p == HOST_DUP_PHASE ? HOST_DUP_REPS : 1); ++rep) hipLaunchKernelGGL(trunk_fwd, dim3(grid), dim3(NTHREADS), LDS_BYTES, stream, a); }
#endif
}
```

```cpp
#define MK_ONE_LAUNCH 1
#include <hip/hip_runtime.h>
#include <cstdio>
#include <cstdint>

#define LAS __attribute__((address_space(3)))
#define GAS __attribute__((address_space(1)))

namespace pg8 {
#define PG8_LAS __attribute__((address_space(3)))
typedef unsigned short bf16_t;
typedef short bf16x8 __attribute__((ext_vector_type(8)));
typedef float f32x4 __attribute__((ext_vector_type(4)));
typedef float f32x2 __attribute__((ext_vector_type(2)));
typedef unsigned u32x4 __attribute__((ext_vector_type(4)));
typedef unsigned u32x2 __attribute__((ext_vector_type(2)));
constexpr int BM = 256, BK = 64, HALF = 128, HTB = HALF * BK * 2  , STAGE_BYTES = 8 * HTB, NXCD = 8, WGM = 4;

__host__ __device__ __forceinline__ int lds_byte(int r, int c) { const int st = (r >> 4) * 2 + (c >> 5), rr = r & 15, cc = c & 31, ob = rr * 64 + cc * 2; return st * 1024 + (ob ^ (((ob >> 9) & 1) << 5)); }
__host__ __device__ __forceinline__ void stage_rc(int b, int& R, int& C) { const int st = b / 1024, sb = b % 1024, swz = sb ^ (((sb >> 9) & 1) << 5); R = (st >> 1) * 16 + swz / 64; C = (st & 1) * 32 + (swz % 64) / 2; }
__host__ __device__ __forceinline__ int perm32(int rho) { const int n = rho >> 4, i = rho & 15; return 8 * (i >> 2) + 4 * n + (i & 3); }

struct Unit { int pm, pn, k0, nt, part, tile; };
struct Gemm { const bf16_t* A; const bf16_t* Bt; int M, N, K, ldk; };

struct Sched {
    int nM, nN, nwg, G, c, skip;
    __device__ __forceinline__ void init(int nM_, int nN_, int G_, int c_, int skip_) { nM = nM_; nN = nN_; nwg = nM * nN; G = G_; c = c_; skip = skip_; one = 0; opm = 0; opn = 0; tail = 0; R = 0; Ssh = 0; Lt = 0; ktn = 0; }
    int one, opm, opn;
    int tail, R, Ssh, Lt, ktn;
    __device__ __forceinline__ void set_tail(int nt_total) { R = nwg / G; Lt = nwg - R * G; tail = 0; Ssh = 0; ktn = 0;
        if (Lt > 0) { const int q = G / Lt; Ssh = q >= 4 ? 2 : (q >= 2 ? 1 : 0); if (Ssh > 0 && ((nt_total >> Ssh) & 1) == 0 && ((nt_total >> Ssh) << Ssh) == nt_total) { tail = 1; ktn = nt_total >> Ssh; } } }
    __device__ __forceinline__ void init_one(bool valid, int pm_, int pn_) { nM = nN = nwg = G = c = skip = 0; tail = 0; R = 0; Ssh = 0; Lt = 0; ktn = 0; one = valid ? 1 : -1; opm = pm_; opn = pn_; }
    __device__ __forceinline__ bool next(int i, Unit& u) const {
        u.k0 = 0; u.nt = 0; u.part = -1; u.tile = 0;
        if (one) { if (one < 0 || i > 0) return false; u.pm = opm; u.pn = opn; return true; }
        long L = (long)i * G + c;
        if (tail && i >= R) { if (i > R || c >= (Lt << Ssh)) return false; u.tile = c >> Ssh; u.part = c & ((1 << Ssh) - 1); u.nt = ktn; u.k0 = u.part * ktn * BK; L = (long)R * G + u.tile; }
        if (L >= nwg) return false;
        int wgid = (int)L; { const int q = nwg / NXCD, r = nwg % NXCD, xcd = wgid % NXCD, off = wgid / NXCD; wgid = (xcd < r ? xcd * (q + 1) : r * (q + 1) + (xcd - r) * q) + off; }
        const int nig = WGM * nN, gid = wgid / nig, fm = gid * WGM, gsz = (nM - fm) < WGM ? (nM - fm) : WGM;
        int pm = fm + ((wgid % nig) % gsz); u.pn = (wgid % nig) / gsz;
        if (skip) pm = pm + (pm >> 3) + 1;
        u.pm = pm; return true;
    }
    __device__ __forceinline__ void a_ready(const Unit&) const {}
    __device__ __forceinline__ void done(const Unit&) const {}
};

typedef __bf16 bf16x2_t __attribute__((ext_vector_type(2)));
__device__ __forceinline__ unsigned cvt_pk_bf16(float lo, float hi) { const f32x2 v = {lo, hi}; const bf16x2_t b = __builtin_convertvector(v, bf16x2_t); return __builtin_bit_cast(unsigned, b); }
__device__ __forceinline__ float silu_f(float x) { return x * __builtin_amdgcn_rcpf(1.0f + __builtin_amdgcn_exp2f(-1.44269504f * x)); }
__device__ __forceinline__ float gelu_tanh_f(float x) { const float z = 0.7978845608f * (x + 0.044715f * x * x * x); return x * __builtin_amdgcn_rcpf(1.0f + __builtin_amdgcn_exp2f(-2.88539008f * z)); }
__device__ __forceinline__ u32x4 pack8(const f32x4& a, const f32x4& b) { u32x4 w; w.x = cvt_pk_bf16(a[0], a[1]); w.y = cvt_pk_bf16(a[2], a[3]); w.z = cvt_pk_bf16(b[0], b[1]); w.w = cvt_pk_bf16(b[2], b[3]); return w; }
__device__ __forceinline__ u32x2 pack4(const f32x4& a) { u32x2 w; w.x = cvt_pk_bf16(a[0], a[1]); w.y = cvt_pk_bf16(a[2], a[3]); return w; }

struct EpiF32 {
    static constexpr bool PERM = false, AFTER_DRAIN = false, SPLITK = false;
    float* C; int ldc;
    __device__ __forceinline__ void operator()(const f32x4 (&acc)[2][2][4][2], const Unit& u, int wr, int wc, int fr, int fq) const {
        const int row0 = u.pm * BM + wr * 64 + fr, col0 = u.pn * BM + wc * 32 + 4 * fq;
#pragma unroll
        for (int ai = 0; ai < 2; ++ai)
#pragma unroll
            for (int m = 0; m < 4; ++m) { float* rowp = C + (size_t)(row0 + ai * HALF + m * 16) * ldc + col0;
#pragma unroll
                for (int bj = 0; bj < 2; ++bj)
#pragma unroll
                    for (int n = 0; n < 2; ++n) *(f32x4*)(rowp + bj * HALF + n * 16) = acc[ai][bj][m][n]; }
    }
};
struct EpiY {
    static constexpr bool PERM = true, AFTER_DRAIN = false, SPLITK = false;
    bf16_t* Y; bf16_t* P; int ldc;
    __device__ __forceinline__ void operator()(const f32x4 (&acc)[2][2][4][2], const Unit& u, int wr, int wc, int fr, int fq) const {
        const int row0 = u.pm * BM + wr * 64 + fr, col0 = u.pn * BM + wc * 32 + 8 * fq;
        if (P) {
#pragma unroll
            for (int ai = 0; ai < 2; ++ai)
#pragma unroll
                for (int m = 0; m < 4; ++m) { bf16_t* rowp = P + (ptrdiff_t)(row0 + ai * HALF + m * 16) * ldc + col0;
#pragma unroll
                    for (int bj = 0; bj < 2; ++bj) *(u32x4*)(rowp + bj * HALF) = pack8(acc[ai][bj][m][0], acc[ai][bj][m][1]); }
        } else {
#pragma unroll
            for (int ai = 0; ai < 2; ++ai)
#pragma unroll
                for (int m = 0; m < 4; ++m) { bf16_t* rowp = Y + (size_t)(row0 + ai * HALF + m * 16) * ldc + col0;
#pragma unroll
                    for (int bj = 0; bj < 2; ++bj) *(u32x4*)(rowp + bj * HALF) = pack8(acc[ai][bj][m][0], acc[ai][bj][m][1]); }
        }
    }
};
struct EpiUp {
    static constexpr bool PERM = true, AFTER_DRAIN = false, SPLITK = true;
    bf16_t* H; int ldc;
    unsigned* cnt; unsigned char* P; PG8_LAS unsigned* flag; int S;
    __device__ __forceinline__ bool combine(f32x4 (&acc)[2][2][4][2], const Unit& u, int tid) const {
        const __amdgpu_buffer_rsrc_t rs = __builtin_amdgcn_make_buffer_rsrc(P, 0, 32 << 20, 0x00020000);
        const unsigned tile0 = (unsigned)(u.tile * S) * (16u * 8192u), lane_off = (unsigned)tid * 16u;
        { const unsigned off = tile0 + (unsigned)u.part * (16u * 8192u) + lane_off;
#pragma unroll
          for (int ai = 0; ai < 2; ++ai)
#pragma unroll
              for (int bj = 0; bj < 2; ++bj)
#pragma unroll
                  for (int m = 0; m < 4; ++m) __builtin_amdgcn_raw_buffer_store_b128(pack8(acc[ai][bj][m][0], acc[ai][bj][m][1]), rs, (int)(off + (unsigned)((ai * 2 + bj) * 4 + m) * 8192u), 0, 16); }
        asm volatile("s_waitcnt vmcnt(0)" ::: "memory");
        __builtin_amdgcn_s_barrier();
        if (tid == 0) {
            asm volatile("buffer_inv sc1" ::: "memory");
            const unsigned old = __hip_atomic_fetch_add(cnt + u.tile, 1u, __ATOMIC_RELAXED, __HIP_MEMORY_SCOPE_AGENT);
            const unsigned lastw = (old == (unsigned)(S - 1)) ? 1u : 0u;
            if (lastw) { asm volatile("s_waitcnt vmcnt(0)" ::: "memory"); }
            *(volatile PG8_LAS unsigned*)flag = lastw;
            asm volatile("s_waitcnt lgkmcnt(0)" ::: "memory");
        }
        __builtin_amdgcn_s_barrier();
        asm volatile("" ::: "memory");
        const unsigned lastw = *(volatile PG8_LAS unsigned*)flag;
        if (!__builtin_amdgcn_readfirstlane(lastw)) return false;
#pragma unroll
        for (int ai = 0; ai < 2; ++ai)
#pragma unroll
            for (int bj = 0; bj < 2; ++bj)
#pragma unroll
                for (int m = 0; m < 4; ++m) { acc[ai][bj][m][0] = (f32x4){0.f, 0.f, 0.f, 0.f}; acc[ai][bj][m][1] = (f32x4){0.f, 0.f, 0.f, 0.f}; }
        const unsigned char* pb = P + tile0 + lane_off;
#pragma unroll 1
        for (int sl = 0; sl < S; ++sl) {
#pragma unroll
            for (int ai = 0; ai < 2; ++ai) {
                u32x4 w[8];
#pragma unroll
                for (int q = 0; q < 8; ++q) w[q] = *(const GAS u32x4*)(pb + (size_t)(ai * 8 + q) * 8192);
#pragma unroll
                for (int q = 0; q < 8; ++q) { const int bj = q >> 2, m = q & 3;
                    acc[ai][bj][m][0] += (f32x4){__builtin_bit_cast(float, w[q].x << 16), __builtin_bit_cast(float, w[q].x & 0xffff0000u), __builtin_bit_cast(float, w[q].y << 16), __builtin_bit_cast(float, w[q].y & 0xffff0000u)};
                    acc[ai][bj][m][1] += (f32x4){__builtin_bit_cast(float, w[q].z << 16), __builtin_bit_cast(float, w[q].z & 0xffff0000u), __builtin_bit_cast(float, w[q].w << 16), __builtin_bit_cast(float, w[q].w & 0xffff0000u)}; }
            }
            pb += 16 * 8192;
        }
        return true;
    }
    __device__ __forceinline__ void operator()(const f32x4 (&acc)[2][2][4][2], const Unit& u, int wr, int wc, int fr, int fq) const {
        const int row0 = u.pm * BM + wr * 64 + fr, col0 = u.pn * HALF + wc * 32 + 8 * fq;
#pragma unroll
        for (int ai = 0; ai < 2; ++ai)
#pragma unroll
            for (int m = 0; m < 4; ++m) { bf16_t* rowp = H + (size_t)(row0 + ai * HALF + m * 16) * ldc + col0;
                f32x4 v0, v1;
#pragma unroll
                for (int j = 0; j < 4; ++j) { v0[j] = silu_f(acc[ai][0][m][0][j]) * acc[ai][1][m][0][j]; v1[j] = silu_f(acc[ai][0][m][1][j]) * acc[ai][1][m][1][j]; }
                *(u32x4*)rowp = pack8(v0, v1); }
    }
};
struct EpiGlaIn {
    static constexpr bool PERM = true, AFTER_DRAIN = false, SPLITK = false;
    bf16_t *Q, *K, *V, *OG; float* A32;
    __device__ __forceinline__ void operator()(const f32x4 (&acc)[2][2][4][2], const Unit& u, int wr, int wc, int fr, int fq) const {
        const int row0 = u.pm * BM + wr * 64 + fr, pn = u.pn;
        if (pn == 24) {
            if (wc == 0) {
#pragma unroll
                for (int ai = 0; ai < 2; ++ai)
#pragma unroll
                    for (int m = 0; m < 4; ++m) { float* ap = A32 + (size_t)(row0 + ai * HALF + m * 16) * 32 + 8 * fq; *(f32x4*)ap = acc[ai][0][m][0]; *(f32x4*)(ap + 4) = acc[ai][0][m][1]; }
            }
            return;
        }
        bf16_t* base; int ldc, colt; float sc = 1.0f; bool act = false;
        if (pn < 4) { base = Q; ldc = 1024; colt = pn * BM; sc = 0.0625f; }
        else if (pn < 8) { base = K; ldc = 1024; colt = (pn - 4) * BM; }
        else if (pn < 16) { base = V; ldc = 2048; colt = (pn - 8) * BM; }
        else { base = OG; ldc = 2048; colt = (pn - 16) * BM; act = true; }
        const int col0 = colt + wc * 32 + 8 * fq;
#pragma unroll
        for (int ai = 0; ai < 2; ++ai)
#pragma unroll
            for (int m = 0; m < 4; ++m) { bf16_t* rowp = base + (size_t)(row0 + ai * HALF + m * 16) * ldc + col0;
#pragma unroll
                for (int bj = 0; bj < 2; ++bj) { f32x4 v0 = acc[ai][bj][m][0] * sc, v1 = acc[ai][bj][m][1] * sc;
                    if (act) {
#pragma unroll
                        for (int j = 0; j < 4; ++j) { v0[j] = silu_f(v0[j]); v1[j] = silu_f(v1[j]); } }
                    *(u32x4*)(rowp + bj * HALF) = pack8(v0, v1); } }
    }
};
struct EpiSwaIn {
    static constexpr bool PERM = false, AFTER_DRAIN = false, SPLITK = false;
    bf16_t *SQ, *SK, *SV; const float* ropeC; const float* ropeS;
    __device__ __forceinline__ void operator()(const f32x4 (&acc)[2][2][4][2], const Unit& u, int wr, int wc, int fr, int fq) const {
        const int row0 = u.pm * BM + wr * 64 + fr, pn = u.pn;
        bf16_t* base; int ldc, colt; float sc = 1.0f; const bool rope = true;
        if (pn < 8) { base = SQ; ldc = 2048; colt = pn * BM; sc = 0.125f * 1.4426950408889634f; }
        else if (pn == 8) { base = SK; ldc = 256; colt = 0; }
        else {
#pragma unroll
            for (int ai = 0; ai < 2; ++ai)
#pragma unroll
                for (int m = 0; m < 4; ++m) { const int row = row0 + ai * HALF + m * 16, b = row / 2304, t = row - b * 2304;
#pragma unroll
                    for (int bj = 0; bj < 2; ++bj)
#pragma unroll
                        for (int n = 0; n < 2; ++n) { const int c0 = bj * HALF + wc * 32 + n * 16 + 4 * fq; const u32x2 w = pack4(acc[ai][bj][m][n]);
                            bf16_t* vp = SV + ((size_t)(b * 4 + (c0 >> 6)) * 64 + (c0 & 63)) * 2304 + t;
                            vp[0] = (bf16_t)(w.x & 0xffffu); vp[2304] = (bf16_t)(w.x >> 16); vp[2 * 2304] = (bf16_t)(w.y & 0xffffu); vp[3 * 2304] = (bf16_t)(w.y >> 16); } }
            return;
        }
        const int col0 = colt + wc * 32 + 4 * fq, half = wc & 1;
#pragma unroll
        for (int ai = 0; ai < 2; ++ai)
#pragma unroll
            for (int m = 0; m < 4; ++m) { const int row = row0 + ai * HALF + m * 16, t = row % 2304; bf16_t* rowp = base + (size_t)row * ldc + col0;
                f32x4 cs = (f32x4){1.f, 1.f, 1.f, 1.f}, sn = (f32x4){0.f, 0.f, 0.f, 0.f};
                if (rope && t >= 256) { const int tl = t - 256, pos = half ? (tl & 63) : (tl >> 6); cs = *(const f32x4*)(ropeC + pos * 16 + 4 * fq); sn = *(const f32x4*)(ropeS + pos * 16 + 4 * fq); }
#pragma unroll
                for (int bj = 0; bj < 2; ++bj) { const f32x4 x0 = acc[ai][bj][m][0], x1 = acc[ai][bj][m][1];
                    const f32x4 o0 = (x0 * cs - x1 * sn) * sc, o1 = (x1 * cs + x0 * sn) * sc;
                    *(u32x2*)(rowp + bj * HALF) = pack4(o0); *(u32x2*)(rowp + bj * HALF + 16) = pack4(o1); } }
    }
};
struct EpiGmlpIn {
    static constexpr bool PERM = true, AFTER_DRAIN = false, SPLITK = false;
    bf16_t *U, *V; float* SP;
    __device__ __forceinline__ void operator()(const f32x4 (&acc)[2][2][4][2], const Unit& u, int wr, int wc, int fr, int fq) const {
        const int row0 = u.pm * BM + wr * 64 + fr, pn = u.pn;
        const bool vhalf = pn >= 8;
        bf16_t* base = vhalf ? V : U; const int col0 = (pn & 7) * BM + wc * 32 + 8 * fq;
#pragma unroll
        for (int ai = 0; ai < 2; ++ai)
#pragma unroll
            for (int m = 0; m < 4; ++m) { bf16_t* rowp = base + (size_t)(row0 + ai * HALF + m * 16) * 2048 + col0;
                float s1 = 0.f, s2 = 0.f;
#pragma unroll
                for (int bj = 0; bj < 2; ++bj) { f32x4 v0, v1;
#pragma unroll
                    for (int j = 0; j < 4; ++j) { v0[j] = gelu_tanh_f(acc[ai][bj][m][0][j]); v1[j] = gelu_tanh_f(acc[ai][bj][m][1][j]); s1 += v0[j] + v1[j]; s2 += v0[j] * v0[j] + v1[j] * v1[j]; }
                    *(u32x4*)(rowp + bj * HALF) = pack8(v0, v1); }
                if (vhalf) {
                    s1 += __shfl_xor(s1, 16); s2 += __shfl_xor(s2, 16); s1 += __shfl_xor(s1, 32); s2 += __shfl_xor(s2, 32);
                    if (fq == 0) { f32x2 st; st.x = s1; st.y = s2; *(GAS f32x2*)(SP + ((size_t)(row0 + ai * HALF + m * 16) * 32 + (pn - 8) * 4 + wc) * 2) = st; } }
            }
    }
};

template <class Epi, class Sched, bool ALIGN_EPI = false, bool SP2 = false>
__device__ __forceinline__ void gemm_phase(PG8_LAS unsigned char* lds, const Gemm g, const Sched& S, const Epi& E) {
    int tid_l = threadIdx.x; asm volatile("" : "+v"(tid_l));
    const int tid = tid_l, wid = __builtin_amdgcn_readfirstlane(tid >> 6), lane = tid & 63, wr = wid >> 2, wc = wid & 3, fr = lane & 15, fq = lane >> 4;
    const int K = g.K, nt = K / BK, LDK = g.ldk;
    unsigned voffA[2], voffB[2];
#pragma unroll
    for (int i = 0; i < 2; ++i) { int R, C; stage_rc(tid * 16 + i * 8192, R, C); const int Rb = Epi::PERM ? ((R & ~31) + perm32(R & 31)) : R;
        voffA[i] = (unsigned)(R * LDK + C) * 2u; voffB[i] = (unsigned)(Rb * LDK + C) * 2u; }
    const size_t kstep = (size_t)(BK * 2);
    const size_t hstep = (size_t)HALF * LDK * 2;
    const size_t tstep = 2 * hstep;
    const unsigned ldsw = (unsigned)wid * 1024u;
    const int aoff = lds_byte(wr * 64 + fr, fq * 8), boff = lds_byte(wc * 32 + fr, fq * 8);
#define PG8_SA(b, h) (((b) * 2 + (h)) * HTB)
#define PG8_SB(b, h) ((4 + (b) * 2 + (h)) * HTB)
#define PG8_STAGE(bufoff, gbase, voff) do { _Pragma("unroll") for (int _i = 0; _i < 2; ++_i) \
        __builtin_amdgcn_global_load_lds((const unsigned*)((const char*)(gbase) + (voff)[_i]), (PG8_LAS unsigned*)(lds + (bufoff) + ldsw + _i * 8192), 16, 0, 0); } while (0)
#define PG8_LDA(dst, b, h) do { _Pragma("unroll") for (int m = 0; m < 4; ++m) _Pragma("unroll") for (int k = 0; k < 2; ++k) dst[m][k] = *(const PG8_LAS bf16x8*)(lds + PG8_SA(b, h) + aoff + m * 2048 + k * 1024); } while (0)
#define PG8_LDB(dst, b, h) do { _Pragma("unroll") for (int n = 0; n < 2; ++n) _Pragma("unroll") for (int k = 0; k < 2; ++k) dst[n][k] = *(const PG8_LAS bf16x8*)(lds + PG8_SB(b, h) + boff + n * 2048 + k * 1024); } while (0)
#define PG8_MMA(ai, bj, At, Bt) do { __builtin_amdgcn_s_setprio(1); _Pragma("unroll") for (int m = 0; m < 4; ++m) _Pragma("unroll") for (int n = 0; n < 2; ++n) _Pragma("unroll") for (int k = 0; k < 2; ++k) \
        acc[ai][bj][m][n] = __builtin_amdgcn_mfma_f32_16x16x32_bf16(Bt[n][k], At[m][k], acc[ai][bj][m][n], 0, 0, 0); __builtin_amdgcn_s_setprio(0); } while (0)
#define PG8_WAIT_V(n) asm volatile("s_waitcnt vmcnt(" #n ")" ::: "memory")
#define PG8_WAIT_L(n) asm volatile("s_waitcnt lgkmcnt(" #n ")" ::: "memory")
#define PG8_BAR __builtin_amdgcn_s_barrier()
#define PG8_SCHED __builtin_amdgcn_sched_barrier(0)
    Unit cur, nxt; int ui = 0;
    if (!S.next(0, cur)) return;
    f32x4 acc[2][2][4][2];
#pragma unroll
    for (int a = 0; a < 2; ++a)
#pragma unroll
        for (int b = 0; b < 2; ++b)
#pragma unroll
            for (int m = 0; m < 4; ++m)
#pragma unroll
                for (int n = 0; n < 2; ++n) acc[a][b][m][n] = (f32x4){0.f, 0.f, 0.f, 0.f};
    bf16x8 At[4][2], B0[2][2], B1[2][2];
    const char* cA = (const char*)g.A + (size_t)cur.pm * tstep + (size_t)cur.k0 * 2; const char* cB = (const char*)g.Bt + (size_t)cur.pn * tstep + (size_t)cur.k0 * 2;
    S.a_ready(cur);
    if constexpr (SP2) {
        PG8_STAGE(PG8_SB(0, 0), cB, voffB); PG8_STAGE(PG8_SB(0, 1), cB + hstep, voffB); PG8_STAGE(PG8_SA(0, 0), cA, voffA); PG8_STAGE(PG8_SA(0, 1), cA + hstep, voffA);
        if (wr == 1) PG8_BAR;
        PG8_WAIT_V(2); PG8_BAR;
        PG8_STAGE(PG8_SB(1, 0), cB + kstep, voffB); PG8_STAGE(PG8_SA(1, 0), cA + kstep, voffA); PG8_STAGE(PG8_SB(1, 1), cB + hstep + kstep, voffB);
        PG8_WAIT_V(6); PG8_BAR;
    } else {
        PG8_STAGE(PG8_SB(0, 0), cB, voffB); PG8_STAGE(PG8_SA(0, 0), cA, voffA); PG8_STAGE(PG8_SB(0, 1), cB + hstep, voffB); PG8_STAGE(PG8_SA(0, 1), cA + hstep, voffA);
        if (wr == 1) PG8_BAR;
        PG8_WAIT_V(4); PG8_BAR;
        PG8_STAGE(PG8_SB(1, 0), cB + kstep, voffB); PG8_STAGE(PG8_SA(1, 0), cA + kstep, voffA); PG8_STAGE(PG8_SB(1, 1), cB + hstep + kstep, voffB);
        PG8_WAIT_V(6); PG8_BAR;
    }
    for (;;) {
        const bool has_next = S.next(ui + 1, nxt);
        const char* nA = has_next ? (const char*)g.A + (size_t)nxt.pm * tstep + (size_t)nxt.k0 * 2 : cA; const char* nB = has_next ? (const char*)g.Bt + (size_t)nxt.pn * tstep + (size_t)nxt.k0 * 2 : cB;
        const int unt = cur.nt ? cur.nt : nt;
        for (int t = 0; t < unt; t += 2) {
            const bool last = (t == unt - 2);
            const char* a1 = cA + (size_t)(t + 1) * kstep;
            const char* a2 = last ? nA : cA + (size_t)(t + 2) * kstep; const char* b2 = last ? nB : cB + (size_t)(t + 2) * kstep;
            const char* a3 = a2 + kstep; const char* b3 = b2 + kstep;
            if (last && has_next) S.a_ready(nxt);
            if constexpr (SP2) {
            PG8_LDB(B0, 0, 0); PG8_LDB(B1, 0, 1); PG8_SCHED; PG8_LDA(At, 0, 0); PG8_STAGE(PG8_SA(1, 1), a1 + hstep, voffA);
            PG8_WAIT_V(8); PG8_WAIT_L(0); PG8_BAR; PG8_MMA(0, 0, At, B0); PG8_MMA(0, 1, At, B1); PG8_BAR; PG8_SCHED;
            PG8_LDA(At, 0, 1); PG8_STAGE(PG8_SB(0, 0), b2, voffB); PG8_STAGE(PG8_SB(0, 1), b2 + hstep, voffB); PG8_STAGE(PG8_SA(0, 0), a2, voffA);
            PG8_WAIT_V(8); PG8_WAIT_L(0); PG8_BAR; PG8_MMA(1, 0, At, B0); PG8_MMA(1, 1, At, B1); PG8_BAR; PG8_SCHED;
            PG8_LDB(B0, 1, 0); PG8_LDB(B1, 1, 1); PG8_SCHED; PG8_LDA(At, 1, 0); PG8_STAGE(PG8_SA(0, 1), a2 + hstep, voffA);
            PG8_WAIT_V(8); PG8_WAIT_L(0); PG8_BAR; PG8_MMA(0, 0, At, B0); PG8_MMA(0, 1, At, B1); PG8_BAR; PG8_SCHED;
            PG8_LDA(At, 1, 1); PG8_STAGE(PG8_SB(1, 0), b3, voffB); PG8_STAGE(PG8_SB(1, 1), b3 + hstep, voffB); PG8_STAGE(PG8_SA(1, 0), a3, voffA);
            PG8_WAIT_V(8); PG8_WAIT_L(0); PG8_BAR; PG8_MMA(1, 0, At, B0); PG8_MMA(1, 1, At, B1); PG8_BAR; PG8_SCHED;
            } else {
            PG8_LDB(B0, 0, 0); PG8_SCHED; PG8_LDA(At, 0, 0); PG8_STAGE(PG8_SA(1, 1), a1 + hstep, voffA);
            PG8_WAIT_L(8); PG8_BAR; PG8_WAIT_L(0); PG8_MMA(0, 0, At, B0); PG8_BAR; PG8_SCHED;
            PG8_LDB(B1, 0, 1); PG8_STAGE(PG8_SB(0, 0), b2, voffB);
            PG8_BAR; PG8_WAIT_L(0); PG8_MMA(0, 1, At, B1); PG8_BAR;
            PG8_LDA(At, 0, 1); PG8_STAGE(PG8_SA(0, 0), a2, voffA);
            PG8_BAR; PG8_WAIT_L(0); PG8_MMA(1, 0, At, B0); PG8_BAR; PG8_SCHED;
            PG8_STAGE(PG8_SB(0, 1), b2 + hstep, voffB);
            PG8_WAIT_V(6); PG8_BAR; PG8_MMA(1, 1, At, B1); PG8_BAR;
            PG8_LDB(B0, 1, 0); PG8_SCHED; PG8_LDA(At, 1, 0); PG8_STAGE(PG8_SA(0, 1), a2 + hstep, voffA);
            PG8_WAIT_L(8); PG8_BAR; PG8_WAIT_L(0); PG8_MMA(0, 0, At, B0); PG8_BAR; PG8_SCHED;
            PG8_LDB(B1, 1, 1); PG8_STAGE(PG8_SB(1, 0), b3, voffB);
            PG8_BAR; PG8_WAIT_L(0); PG8_MMA(0, 1, At, B1); PG8_BAR;
            PG8_LDA(At, 1, 1); PG8_STAGE(PG8_SA(1, 0), a3, voffA);
            PG8_BAR; PG8_WAIT_L(0); PG8_MMA(1, 0, At, B0); PG8_BAR; PG8_SCHED;
            PG8_STAGE(PG8_SB(1, 1), b3 + hstep, voffB);
            PG8_WAIT_V(6); PG8_BAR; PG8_MMA(1, 1, At, B1); PG8_BAR;
            }
        }
        if constexpr (ALIGN_EPI) { if (wr == 0) PG8_BAR; }
        bool do_epi = true;
        if constexpr (Epi::SPLITK) { if (cur.part >= 0) do_epi = E.combine(acc, cur, tid); }
        if constexpr (!Epi::AFTER_DRAIN) { if (do_epi) E(acc, cur, wr, wc, fr, fq); S.done(cur); }
        if (!has_next) break;
#pragma unroll
        for (int a = 0; a < 2; ++a)
#pragma unroll
            for (int b = 0; b < 2; ++b)
#pragma unroll
                for (int m = 0; m < 4; ++m)
#pragma unroll
                    for (int n = 0; n < 2; ++n) acc[a][b][m][n] = (f32x4){0.f, 0.f, 0.f, 0.f};
        cur = nxt; cA = nA; cB = nB; ++ui;
        if constexpr (ALIGN_EPI) { if (wr == 1) PG8_BAR; }
    }
    PG8_WAIT_V(0);
    if constexpr (!ALIGN_EPI) { if (wr == 0) PG8_BAR; }
    PG8_BAR;
    if constexpr (Epi::AFTER_DRAIN) { E.fused(acc, cur, wr, wc, fr, fq, lds, wid, lane); S.done(cur); }
#undef PG8_SA
#undef PG8_SB
#undef PG8_STAGE
#undef PG8_LDA
#undef PG8_LDB
#undef PG8_MMA
#undef PG8_WAIT_V
#undef PG8_WAIT_L
#undef PG8_BAR
#undef PG8_SCHED
}
}

typedef unsigned short bf16;
typedef float f32x4 __attribute__((ext_vector_type(4)));
typedef float f32x2 __attribute__((ext_vector_type(2)));
typedef unsigned u32x4 __attribute__((ext_vector_type(4)));
typedef unsigned u32x2 __attribute__((ext_vector_type(2)));
typedef GAS unsigned gu32;
#define RLX_AGENT __ATOMIC_RELAXED, __HIP_MEMORY_SCOPE_AGENT

constexpr int D = 2048, NB = 4, SEQ = 2048, LC = 256, TT = SEQ + LC, M = NB * TT, FF = 5632, DEPTH = 4;
constexpr int NWAVES = 8, NTHREADS = 512;
constexpr float EPS = 1e-6f;
constexpr int GLA_N = 6176, GLA_NP = 6400, SWA_N = 2560, GM_N = 4096;
static_assert(M == 9216 && M % 256 == 0, "row panels");

constexpr size_t MiB = 1u << 20;
constexpr size_t WS_CTL = 0, CTL_ZERO_BYTES = 1 * MiB;
constexpr size_t WS_MOD = 1 * MiB;
constexpr size_t WS_ROPE = 2 * MiB;
constexpr size_t WS_STAT = 3 * MiB;
constexpr size_t WS_A32 = 4 * MiB;
constexpr size_t WS_W = 8 * MiB;
constexpr size_t WS_FFNW = WS_W, FFNW_STRIDE = 66 * MiB, FFNW_W2 = 44 * MiB;
constexpr size_t WS_GLAW = WS_W + 264 * MiB, GLAW_STRIDE = 33 * MiB, GLAW_WO = 25 * MiB;
constexpr size_t WS_SWAW = WS_GLAW + 66 * MiB, SWAW_WO = 10 * MiB;
constexpr size_t WS_GMW = WS_SWAW + 18 * MiB, GMW_WO = 16 * MiB;
constexpr size_t WS_X = 384 * MiB;
constexpr size_t WS_Y = 456 * MiB;
constexpr size_t WS_HA = 528 * MiB;
constexpr size_t WS_HFF = 564 * MiB;
constexpr size_t WS_MIX = 664 * MiB;
constexpr size_t MIX_GQ = 0, MIX_GK = 18 * MiB, MIX_GV = 36 * MiB, MIX_GOG = 72 * MiB, MIX_GOF = 108 * MiB, MIX_GOB = 144 * MiB;
constexpr size_t MIX_GQT = 180 * MiB, MIX_GKT = 216 * MiB, MIX_GVT = 252 * MiB, MIX_GATT = 288 * MiB, MIX_GDEC = 298 * MiB;
constexpr size_t MIX_SQ = 0, MIX_SK = 36 * MiB, MIX_SV = 41 * MiB;
constexpr size_t MIX_U = 0, MIX_V = 36 * MiB;
constexpr size_t WS_YP = 968 * MiB;
constexpr size_t WS_END = 1000 * MiB;
static_assert(WS_GMW + 24 * MiB <= WS_X && WS_HFF + (size_t)M * FF * 2 <= WS_MIX, "d_ws map");
constexpr int CW_SPLIT = 16384;
constexpr int CW_BAR = 4096;

constexpr int RING_BYTES = 131072, LDS_BYTES = 163840, LDSCTL_OFF = LDS_BYTES - 1024, MISC_OFF = LDSCTL_OFF + 320;

#define LDS_WAIT() asm volatile("s_waitcnt lgkmcnt(0)" ::: "memory")
#define VM_WAIT() asm volatile("s_waitcnt vmcnt(0)" ::: "memory")
__device__ __forceinline__ unsigned pk2(float lo, float hi) { return pg8::cvt_pk_bf16(lo, hi); }
__device__ __forceinline__ unsigned f2bf(float f) { return pg8::cvt_pk_bf16(f, 0.f) & 0xffffu; }
__device__ __forceinline__ float bf2f(unsigned short b) { return __builtin_bit_cast(float, (unsigned)b << 16); }
__device__ __forceinline__ float bflo(unsigned u) { return __builtin_bit_cast(float, u << 16); }
__device__ __forceinline__ float bfhi(unsigned u) { return __builtin_bit_cast(float, u & 0xffff0000u); }
__device__ __forceinline__ float wave_sum(float v) {
#pragma unroll
    for (int o = 1; o < 64; o <<= 1) v += __shfl_xor(v, o);
    return v;
}
__device__ __forceinline__ float wave_max(float v) {
#pragma unroll
    for (int o = 1; o < 64; o <<= 1) v = fmaxf(v, __shfl_xor(v, o));
    return v;
}

#define XB_TMO      128
#define XB_XCNT(j)  (256  + 64 * (j))
#define XB_XSUB(j)  (1280 + 64 * (j))
#define XB_XGEN(j)  (2304 + 64 * (j))
#define XB_TOP      3328
#define XB_TOPGEN   3392
#define XCD_BAR_WORDS 3456
#define XB_SPIN_CAP (1u << 18)

__device__ __forceinline__ unsigned xb_ld(unsigned* p)              { return __hip_atomic_load(p, __ATOMIC_RELAXED, __HIP_MEMORY_SCOPE_AGENT); }
__device__ __forceinline__ unsigned xb_add(unsigned* p, unsigned v) { return __hip_atomic_fetch_add(p, v, __ATOMIC_RELAXED, __HIP_MEMORY_SCOPE_AGENT); }
__device__ __forceinline__ unsigned xb_xcc_id() { return (unsigned)__builtin_amdgcn_s_getreg((3 << 11) | 20) & 0xFu; }
#define XB_SPIN(cond, bar) do { unsigned _sp = 0; while (cond) { __builtin_amdgcn_s_sleep(1); \
    if ((++_sp & 255u) == 0u) { if (xb_ld(&(bar)[XB_TMO])) break; if (_sp > XB_SPIN_CAP) { atomicAdd(&(bar)[XB_TMO], 1u); break; } } } } while (0)

struct XcdBarrier {
    unsigned* bar; unsigned x;
    volatile LAS unsigned* st;
};

__device__ __forceinline__ XcdBarrier xcd_barrier_post(unsigned* bar, volatile LAS unsigned* st) {
    XcdBarrier b; b.bar = bar; b.x = xb_xcc_id(); b.st = st;
    if (threadIdx.x == 0) (void)xb_add(&bar[XB_XCNT(b.x)], 1u);
    return b;
}
__device__ __forceinline__ void xcd_barrier_complete(unsigned* bar, unsigned x, unsigned& nloc, unsigned& nx) {
    const unsigned G = gridDim.x * gridDim.y * gridDim.z;
    unsigned sum, cnt, mine, sp = 0u;
    for (;;) {
        sum = 0u; cnt = 0u; mine = 0u;
#pragma unroll
        for (unsigned j = 0; j < 16; ++j) { const unsigned c = xb_ld(&bar[XB_XCNT(j)]); sum += c; cnt += (c > 0u) ? 1u : 0u; mine = (j == x) ? c : mine; }
        if (sum == G) break;
        __builtin_amdgcn_s_sleep(1);
        if ((++sp & 255u) == 0u) { if (xb_ld(&bar[XB_TMO])) break; if (sp > XB_SPIN_CAP) { atomicAdd(&bar[XB_TMO], 1u); break; } }
    }
    nloc = mine > 0u ? mine : 1u; nx = cnt > 0u ? cnt : 1u;
}

__device__ __forceinline__ void xcd_barrier(const XcdBarrier& b) {
    asm volatile("s_waitcnt vmcnt(0)" ::: "memory");
    __syncthreads();
    if (threadIdx.x == 0) {
        unsigned* bar = b.bar;
        __builtin_amdgcn_s_waitcnt(0);
        unsigned nloc = b.st[0], nx = b.st[1];
        if (nloc == 0u) { xcd_barrier_complete(bar, b.x, nloc, nx); b.st[0] = nloc; b.st[1] = nx; }
        const unsigned old = xb_add(&bar[XB_XSUB(b.x)], 1u);
        const unsigned gen = old / nloc;
        asm volatile("buffer_inv sc1" ::: "memory");
        if (old + 1u == (gen + 1u) * nloc) {
            __builtin_amdgcn_fence(__ATOMIC_RELEASE, "agent");
            asm volatile("s_waitcnt vmcnt(0)" ::: "memory");
            const unsigned og = xb_add(&bar[XB_TOP], 1u);
            const unsigned tg = og / nx;
            if (og + 1u == (tg + 1u) * nx) xb_add(&bar[XB_TOPGEN], 1u);
            else XB_SPIN(xb_ld(&bar[XB_TOPGEN]) == tg, bar);
            asm volatile("" ::: "memory");
            xb_add(&bar[XB_XGEN(b.x)], 1u);
            asm volatile("s_waitcnt vmcnt(0)" ::: "memory");
        } else {
            XB_SPIN(xb_ld(&bar[XB_XGEN(b.x)]) == gen, bar);
            asm volatile("" ::: "memory");
            asm volatile("s_waitcnt vmcnt(0)" ::: "memory");
        }
    }
    __syncthreads();
}

struct Args { const float* in[24]; float* out; unsigned char* ws; int ph_lo, ph_hi; };

__device__ __forceinline__ unsigned char* OPQ(unsigned char* p) { asm volatile("" : "+s"(p)); return p; }
__device__ __forceinline__ const float* OPQF(const float* p) { asm volatile("" : "+s"(p)); return p; }
__device__ __forceinline__ const float* input_row(const float* x, const float* ctx, int r) {
    const int b = r / TT, t = r - b * TT;
    return t < LC ? ctx + ((size_t)b * LC + t) * D : x + ((size_t)b * SEQ + (t - LC)) * D;
}

__device__ __forceinline__ void p0_transpose_item(const float* W, int K, int N, bf16* WT, int drow0, int k0, int n0, LAS float* scr, int lane) {
    const int n4 = lane & 15, kr = lane >> 4; const bool ok = (n0 + 4 * n4) < N;
    const float* wp = W + (size_t)(k0 + kr) * N + n0 + 4 * n4;
    f32x4 v[16];
#pragma unroll
    for (int i = 0; i < 16; ++i) v[i] = ok ? __builtin_nontemporal_load((const GAS f32x4*)(wp + (size_t)(4 * i) * N)) : (f32x4){0.f, 0.f, 0.f, 0.f};
#pragma unroll
    for (int i = 0; i < 16; ++i)
#pragma unroll
        for (int q = 0; q < 4; ++q) scr[(4 * i + kr) * 65 + 4 * n4 + q] = v[i][q];
    LDS_WAIT(); asm volatile("" ::: "memory");
    const int c = lane & 7;
#pragma unroll
    for (int jj = 0; jj < 8; ++jj) { const int n = (lane >> 3) + 8 * jj; const LAS float* s = scr + (8 * c) * 65 + n;
        u32x4 o; o.x = pk2(s[0 * 65], s[1 * 65]); o.y = pk2(s[2 * 65], s[3 * 65]); o.z = pk2(s[4 * 65], s[5 * 65]); o.w = pk2(s[6 * 65], s[7 * 65]);
        if (n0 + n < N) *(GAS u32x4*)(WT + (size_t)(drow0 + n) * K + k0 + 8 * c) = o; }
    LDS_WAIT(); asm volatile("" ::: "memory");
}
constexpr int I_FF = 2816, I_FFL = 3 * I_FF, I_GIN = 32 * 97, I_SQ = 32 * 32, I_GLA = I_GIN + I_SQ, I_SWA = 32 * 40 + I_SQ, I_GM = 32 * 64 + I_SQ;
constexpr int IT_G0 = 0, IT_F0 = IT_G0 + I_GLA, IT_SW = IT_F0 + I_FFL, IT_F1 = IT_SW + I_SWA, IT_GM = IT_F1 + I_FFL, IT_F2 = IT_GM + I_GM, IT_G1 = IT_F2 + I_FFL, IT_F3 = IT_G1 + I_GLA, N_TR_ITEMS = IT_F3 + I_FFL;
static_assert(I_FF == (D / 64) * (FF / 64) && I_FF == (FF / 64) * (D / 64) && GLA_N == 96 * 64 + 32 && N_TR_ITEMS == 47424, "transpose items");
#ifndef REACH
#define REACH 0
#endif
#ifndef Q_IN
#define Q_IN 12
#endif
#ifndef Q_WO
#define Q_WO 3
#endif
#ifndef Q_DN
#define Q_DN 5
#endif
#ifndef PROLOGUE_UNTIL
#define PROLOGUE_UNTIL IT_F0
#endif
constexpr int CW_STEAL = 64;
__device__ __forceinline__ int tr_need(int p) {
    if (p < 8) return IT_F0;
    if (p < 9) return IT_F0 + 2 * I_FF;   if (p < 11) return IT_SW;
    if (p < 17) return IT_F1;             if (p < 18) return IT_F1 + 2 * I_FF;   if (p < 20) return IT_GM;
    if (p < 26) return IT_F2;             if (p < 27) return IT_F2 + 2 * I_FF;   if (p < 29) return IT_G1;
    if (p < 35) return IT_F3;             if (p < 36) return IT_F3 + 2 * I_FF;   return N_TR_ITEMS;
}
__device__ __forceinline__ void tr_do_item(const Args& a, int it, LAS float* scr, int lane) {
    unsigned char* ws = OPQ(a.ws);
    int r = it; const float* src; bf16* dst; int K = D, N, nblk, dmode = 0, l = 0; int grp;
    if (r < IT_F0) { grp = 0; l = 0; } else if (r < IT_SW) { grp = 1; l = 0; r -= IT_F0; } else if (r < IT_F1) { grp = 2; r -= IT_SW; } else if (r < IT_GM) { grp = 1; l = 1; r -= IT_F1; }
    else if (r < IT_F2) { grp = 3; r -= IT_GM; } else if (r < IT_G1) { grp = 1; l = 2; r -= IT_F2; } else if (r < IT_F3) { grp = 0; l = 1; r -= IT_G1; } else { grp = 1; l = 3; r -= IT_F3; }
    if (grp == 1) { const int which = r / I_FF; r -= which * I_FF;
        if (which < 2) { src = OPQF(a.in[which ? 8 : 7]) + (size_t)l * D * FF; N = FF; nblk = FF / 64; dst = (bf16*)(ws + WS_FFNW + l * FFNW_STRIDE); dmode = 1 + which; }
        else { src = OPQF(a.in[9]) + (size_t)l * FF * D; K = FF; N = D; nblk = D / 64; dst = (bf16*)(ws + WS_FFNW + l * FFNW_STRIDE + FFNW_W2); } }
    else if (grp == 0) {
        if (r < I_GIN) { src = OPQF(a.in[10]) + (size_t)l * D * GLA_N; N = GLA_N; nblk = 97; dst = (bf16*)(ws + WS_GLAW + l * GLAW_STRIDE); }
        else { r -= I_GIN; src = OPQF(a.in[14]) + (size_t)l * D * D; N = D; nblk = 32; dst = (bf16*)(ws + WS_GLAW + l * GLAW_STRIDE + GLAW_WO); } }
    else if (grp == 2) {
        if (r < 32 * 40) { src = OPQF(a.in[15]); N = SWA_N; nblk = 40; dst = (bf16*)(ws + WS_SWAW); }
        else { r -= 32 * 40; src = OPQF(a.in[17]); N = D; nblk = 32; dst = (bf16*)(ws + WS_SWAW + SWAW_WO); } }
    else {
        if (r < 32 * 64) { src = OPQF(a.in[18]); N = GM_N; nblk = 64; dst = (bf16*)(ws + WS_GMW); }
        else { r -= 32 * 64; src = OPQF(a.in[23]); N = D; nblk = 32; dst = (bf16*)(ws + WS_GMW + GMW_WO); } }
    const int kb = r / nblk, nb = r - kb * nblk, k0 = 64 * kb, n0 = 64 * nb;
    const int drow0 = dmode == 0 ? n0 : ((n0 >> 7) * 256 + (dmode - 1) * 128 + (n0 & 127));
    p0_transpose_item(src, K, N, dst, drow0, k0, n0, scr, lane);
}
__device__ __forceinline__ void tr_pull(const Args& a, LAS unsigned char* lds, int wave, int lane, int until, int max_batches) {
    gu32* ctr = (gu32*)(OPQ(a.ws) + WS_CTL) + CW_STEAL;
    LAS float* scr = (LAS float*)(lds + wave * 16640);
    volatile LAS unsigned* bc = (volatile LAS unsigned*)(lds + MISC_OFF);
    if (until > N_TR_ITEMS) until = N_TR_ITEMS;
    for (int k = 0; k < max_batches; ++k) {
        __syncthreads();
        if (threadIdx.x == 0) { unsigned v = 0xffffffffu; if ((int)__hip_atomic_load(ctr, RLX_AGENT) < until) v = __hip_atomic_fetch_add(ctr, 16u, RLX_AGENT); bc[0] = v; }
        __syncthreads();
        const unsigned base = bc[0];
        if (base == 0xffffffffu || (int)base >= N_TR_ITEMS) break;
#pragma unroll 1
        for (int q = 0; q < 2; ++q) { const int it = (int)base + 8 * q + wave; if (it < N_TR_ITEMS) tr_do_item(a, it, scr, lane); }
    }
}
__device__ __forceinline__ void adaln_unit(const Args& a, LAS unsigned char* lds, int tid, int wave, int lane, int l, int cb) {
    LAS float* SL = (LAS float*)lds;
    LAS float* PART = (LAS float*)(lds + 40960);
    const float* cvec = OPQF(a.in[1]); const float* cctx = OPQF(a.in[3]); const float* ada_w = OPQF(a.in[4]); const float* ada_b = OPQF(a.in[5]);
    float* MOD = (float*)(OPQ(a.ws) + WS_MOD);
    __syncthreads();
    for (int e = tid; e < 5 * D; e += NTHREADS) { const int mi = e / D, k = e - mi * D; const float cv = mi < 4 ? cvec[mi * D + k] : cctx[k]; SL[e] = cv / (1.0f + expf(-cv)); }
    __syncthreads();
    {
        const bool on = lane < 48;
        f32x4 acc[5];
#pragma unroll
        for (int mi = 0; mi < 5; ++mi) acc[mi] = (f32x4){0.f, 0.f, 0.f, 0.f};
        const float* wp = ada_w + ((size_t)l * D + 256 * wave) * (6 * D) + 192 * cb + 4 * (on ? lane : 0);
        const LAS float* sl = SL + 256 * wave;
#pragma unroll 2
        for (int k4 = 0; k4 < 256; k4 += 8) {
            f32x4 wv[8];
#pragma unroll
            for (int q = 0; q < 8; ++q) wv[q] = *(const GAS f32x4*)(wp + (size_t)(k4 + q) * (6 * D));
#pragma unroll
            for (int mi = 0; mi < 5; ++mi) { const f32x4 s4 = *(const LAS f32x4*)(sl + mi * D + k4), s5 = *(const LAS f32x4*)(sl + mi * D + k4 + 4);
#pragma unroll
                for (int q = 0; q < 4; ++q) { acc[mi] += wv[q] * s4[q]; acc[mi] += wv[4 + q] * s5[q]; } }
        }
        if (on) {
#pragma unroll
            for (int mi = 0; mi < 5; ++mi) *(LAS f32x4*)(PART + (wave * 5 + mi) * 192 + 4 * lane) = acc[mi]; }
        __syncthreads();
        for (int e = tid; e < 5 * 192; e += NTHREADS) { const int mi = e / 192, cc = e - mi * 192; float s = ada_b[l * 6 * D + 192 * cb + cc];
#pragma unroll
            for (int w = 0; w < 8; ++w) s += PART[(w * 5 + mi) * 192 + cc];
            MOD[(size_t)(l * 5 + mi) * (6 * D) + 192 * cb + cc] = s; }
        __syncthreads();
    }
}
__device__ __forceinline__ void p0_rope(const Args& a, int tid) {
    float* RC = (float*)(OPQ(a.ws) + WS_ROPE); float* RS = RC + 1024;
    for (int e = tid; e < 1024; e += NTHREADS) {
        const int pos = e >> 4, f = e & 15;
        double inv = 1.0; for (int i = 0; i < f; ++i) inv *= 0.56234132519034908;
        const double x = (double)pos * (double)(float)inv;
        const double twopi = 6.283185307179586476925;
        const double n = __builtin_rint(x * (1.0 / twopi)); const double r = x - n * twopi;
        double s = r, c = 1.0, ts = r, tc = 1.0; const double r2 = r * r;
#pragma unroll
        for (int i = 1; i <= 16; ++i) { tc = -tc * r2 * (1.0 / (double)((2 * i - 1) * (2 * i))); c += tc; ts = -ts * r2 * (1.0 / (double)((2 * i) * (2 * i + 1))); s += ts; }
        RC[e] = (float)c; RS[e] = (float)s;
    }
}

__device__ __forceinline__ void load_row8(const float* p, int lane, f32x4 (&v)[8]) {
#pragma unroll
    for (int j = 0; j < 8; ++j) v[j] = *(const GAS f32x4*)(p + (64 * j + lane) * 4);
}
__device__ __forceinline__ float sumsq8(const f32x4 (&v)[8]) { float s = 0.f;
#pragma unroll
    for (int j = 0; j < 8; ++j) s += (v[j].x * v[j].x + v[j].y * v[j].y) + (v[j].z * v[j].z + v[j].w * v[j].w);
    return s; }
__device__ __forceinline__ void store_h8(bf16* hrow, int lane, const f32x4 (&v)[8]) {
#pragma unroll
    for (int j = 0; j < 8; ++j) { u32x2 w; w.x = pk2(v[j].x, v[j].y); w.y = pk2(v[j].z, v[j].w); *(GAS u32x2*)(hrow + (64 * j + lane) * 4) = w; }
}
__device__ __forceinline__ void wave_rows(int rb, int wave, int& r0, int& nr) { nr = wave < 4 ? 5 : 4; r0 = rb * 36 + (wave < 4 ? 5 * wave : 20 + 4 * (wave - 4)); }

__device__ __forceinline__ void norm0_phase(const Args& a, int wave, int lane, int wg, int G) {
    const float* MOD = (const float*)(OPQ(a.ws) + WS_MOD); const float* ng = OPQF(a.in[6]); bf16* HA = (bf16*)(OPQ(a.ws) + WS_HA);
    for (int rb = wg; rb < 256; rb += G) {
        int r0, nr; wave_rows(rb, wave, r0, nr);
        int cur = -1; f32x4 cB[8], cC[8];
        for (int r = r0; r < r0 + nr; ++r) {
            const int b = r / TT, t = r - b * TT, mi = t < LC ? 4 : b;
            if (mi != cur) { cur = mi; const float* mod = MOD + (size_t)mi * (6 * D); f32x4 g[8], sc[8];
                load_row8(ng, lane, g); load_row8(mod + D, lane, sc); load_row8(mod, lane, cC);
#pragma unroll
                for (int j = 0; j < 8; ++j) cB[j] = g[j] * (1.0f + sc[j]); }
            f32x4 x[8]; load_row8(input_row(OPQF(a.in[0]), OPQF(a.in[2]), r), lane, x);
            const float rs = 1.0f / sqrtf(wave_sum(sumsq8(x)) * (1.0f / D) + EPS);
#pragma unroll
            for (int j = 0; j < 8; ++j) x[j] = x[j] * rs * cB[j] + cC[j];
            store_h8(HA + (size_t)r * D, lane, x);
        }
    }
}
__device__ __forceinline__ void load_xrow(const float* fin, const bf16* Xb, bool from_input, int lane, f32x4 (&x)[8]) {
    if (from_input) load_row8(fin, lane, x);
    else {
#pragma unroll
        for (int j = 0; j < 8; ++j) { const u32x2 w = *(const GAS u32x2*)(Xb + (64 * j + lane) * 4); x[j] = (f32x4){bflo(w.x), bfhi(w.x), bflo(w.y), bfhi(w.y)}; } }
}
template <int WHICH> __device__ __forceinline__ void resid_phase(const Args& a, int l, LAS unsigned char* lds, int tid, int wave, int lane, int wg, int G) {
    const float* MOD = (const float*)(OPQ(a.ws) + WS_MOD); const float* ng = OPQF(a.in[6]);
    bf16* X = (bf16*)(OPQ(a.ws) + WS_X); const bf16* Y = (const bf16*)(OPQ(a.ws) + WS_Y); bf16* HA = (bf16*)(OPQ(a.ws) + WS_HA);
    const bf16* YP = (const bf16*)(OPQ(a.ws) + WS_YP); const float* xin = OPQF(a.in[0]); const float* cin = OPQF(a.in[2]);
    const bool last = (l == DEPTH - 1), final_out = last && WHICH == 1, from_input = (l == 0 && WHICH == 0);
    LAS float* PAR = (LAS float*)lds;
    for (int rb = wg; rb < 256; rb += G) {
        const int bb = rb >> 6, qb = rb & 63;
        const bool ctxw = !last && wave < 4;
        const int lat0 = bb * TT + LC + 32 * qb + (last ? 4 * wave : (wave < 4 ? 3 * wave : 12 + 5 * (wave - 4)));
        const int nr = last ? 4 : (wave < 4 ? 4 : 5);
        const int rfirst = ctxw ? bb * TT + 4 * qb + wave : lat0, rbase = ctxw ? lat0 - 1 : lat0;
#define ROW(i) ((i) == 0 ? rfirst : rbase + (i))
        const int r0 = rfirst;
        f32x4 x[8], xn[8]; u32x2 yb[8], ybn[8];
        { const int r = r0; const int b = r / TT, t = r - b * TT;
          load_xrow(from_input ? input_row(xin, cin, r) : nullptr, X + (size_t)r * D, from_input, lane, x);
          if (t >= LC) {
#pragma unroll
              for (int j = 0; j < 8; ++j) yb[j] = *(const GAS u32x2*)(Y + (size_t)r * D + (64 * j + lane) * 4); }
          else if (!last) { const bf16* yp = YP + (size_t)(b * LC + t) * D;
#pragma unroll
              for (int j = 0; j < 8; ++j) yb[j] = *(const GAS u32x2*)(yp + (64 * j + lane) * 4); } }
        __syncthreads();
#pragma unroll
        for (int slot = 0; slot < 2; ++slot) { const int mi = slot ? bb : 4; const float* mod = MOD + (size_t)(l * 5 + mi) * (6 * D);
            const f32x4 gt = *(const GAS f32x4*)(mod + (WHICH ? 5 : 2) * D + 4 * tid), gy = *(const GAS f32x4*)(ng + (size_t)(l * 4 + (WHICH ? 3 : 1)) * D + 4 * tid);
            *(LAS f32x4*)(PAR + (slot * 3 + 0) * D + 4 * tid) = gt * gy;
            if (!final_out) { const float* gn = WHICH ? ng + (size_t)((l + 1) * 4) * D : ng + (size_t)(l * 4 + 2) * D;
                const float* modn = WHICH ? MOD + (size_t)((l + 1) * 5 + mi) * (6 * D) : mod;
                const f32x4 g = *(const GAS f32x4*)(gn + 4 * tid), sc = *(const GAS f32x4*)(modn + (WHICH ? 1 : 4) * D + 4 * tid), sh = *(const GAS f32x4*)(modn + (WHICH ? 0 : 3) * D + 4 * tid);
                *(LAS f32x4*)(PAR + (slot * 3 + 1) * D + 4 * tid) = g * (1.0f + sc); *(LAS f32x4*)(PAR + (slot * 3 + 2) * D + 4 * tid) = sh; } }
        __syncthreads();
#pragma unroll 1
        for (int ri = 0; ri < nr; ++ri) {
            const int r = ROW(ri);
            const int b = r / TT, t = r - b * TT;
            if (ri + 1 < nr) { const int rn = ROW(ri + 1), bn = rn / TT, tn = rn - bn * TT;
                load_xrow(from_input ? input_row(xin, cin, rn) : nullptr, X + (size_t)rn * D, from_input, lane, xn);
                if (tn >= LC) {
#pragma unroll
                    for (int j = 0; j < 8; ++j) ybn[j] = *(const GAS u32x2*)(Y + (size_t)rn * D + (64 * j + lane) * 4); } }
            if (!(last && t < LC)) {
            const LAS float* par = PAR + (t < LC ? 0 : 3 * D);
            f32x4 y[8];
            if (t < LC) { const bf16* yp = YP + (size_t)(b * LC + t) * D;
                u32x2 ysl[3][8];
#pragma unroll
                for (int sl = 1; sl < 4; ++sl)
#pragma unroll
                    for (int j = 0; j < 8; ++j) ysl[sl - 1][j] = *(const GAS u32x2*)(yp + (size_t)sl * (NB * LC) * D + (64 * j + lane) * 4);
#pragma unroll
                for (int j = 0; j < 8; ++j) { y[j] = (f32x4){bflo(yb[j].x), bfhi(yb[j].x), bflo(yb[j].y), bfhi(yb[j].y)};
#pragma unroll
                    for (int sl = 0; sl < 3; ++sl) y[j] += (f32x4){bflo(ysl[sl][j].x), bfhi(ysl[sl][j].x), bflo(ysl[sl][j].y), bfhi(ysl[sl][j].y)}; } }
            else {
#pragma unroll
                for (int j = 0; j < 8; ++j) y[j] = (f32x4){bflo(yb[j].x), bfhi(yb[j].x), bflo(yb[j].y), bfhi(yb[j].y)}; }
            const float rs = 1.0f / sqrtf(wave_sum(sumsq8(y)) * (1.0f / D) + EPS);
#pragma unroll
            for (int j = 0; j < 8; ++j) x[j] = x[j] + *(const LAS f32x4*)(par + (64 * j + lane) * 4) * (y[j] * rs);
            if (final_out) { float* xd = a.out + ((size_t)b * SEQ + (t - LC)) * D;
#pragma unroll
                for (int j = 0; j < 8; ++j) *(GAS f32x4*)(xd + (64 * j + lane) * 4) = x[j]; }
            else {
                store_h8(X + (size_t)r * D, lane, x);
                const float rs2 = 1.0f / sqrtf(wave_sum(sumsq8(x)) * (1.0f / D) + EPS);
#pragma unroll
                for (int j = 0; j < 8; ++j) x[j] = x[j] * rs2 * *(const LAS f32x4*)(par + D + (64 * j + lane) * 4) + *(const LAS f32x4*)(par + 2 * D + (64 * j + lane) * 4);
                store_h8(HA + (size_t)r * D, lane, x);
            }
            }
#pragma unroll
            for (int j = 0; j < 8; ++j) { x[j] = xn[j]; yb[j] = ybn[j]; }
        }
#undef ROW
    }
}

typedef float f32x16 __attribute__((ext_vector_type(16)));
typedef short bf16x8v __attribute__((ext_vector_type(8)));
constexpr int GL_ST = 528;
__device__ __forceinline__ float log_sigmoid_f(float z) { return fminf(z, 0.f) - __logf(1.0f + __expf(-fabsf(z))); }
template <int DIR> __device__ __forceinline__ void gla_prep_unit(const Args& a, int slot, int u, LAS unsigned char* lds, int tid, int wave, int lane) {
    LAS float* As = (LAS float*)lds;
    LAS float* TOT = (LAS float*)(lds + 4096);
    LAS unsigned char* Qs = lds + 8192;
    LAS unsigned char* Ks = lds + 8192 + 64 * GL_ST;
    LAS unsigned char* Vs = lds + 8192 + 128 * GL_ST;
    const bf16* Q = (const bf16*)(OPQ(a.ws) + WS_MIX + MIX_GQ); const bf16* Kb = (const bf16*)(OPQ(a.ws) + WS_MIX + MIX_GK); const bf16* V = (const bf16*)(OPQ(a.ws) + WS_MIX + MIX_GV);
    bf16* QT = (bf16*)(OPQ(a.ws) + WS_MIX + MIX_GQT); bf16* KT = (bf16*)(OPQ(a.ws) + WS_MIX + MIX_GKT); bf16* VT = (bf16*)(OPQ(a.ws) + WS_MIX + MIX_GVT); bf16* ATT = (bf16*)(OPQ(a.ws) + WS_MIX + MIX_GATT); float* DEC = (float*)(OPQ(a.ws) + WS_MIX + MIX_GDEC);
    const float* A32 = (const float*)(OPQ(a.ws) + WS_A32);
    const int c = (u >> 1) % 36, bh = (u >> 1) / 36, h = bh & 3, b = bh >> 2;
    const size_t row0 = (size_t)b * TT + 64 * c;
    const int kk = tid & 255, hf = tid >> 8;
    __syncthreads();
    for (int e = tid; e < 1024; e += NTHREADS) As[e] = A32[(row0 + (e >> 4)) * 32 + 16 * DIR + (e & 15)];
#pragma unroll
    for (int q = 0; q < 4; ++q) { const int e = tid + NTHREADS * q, i = e >> 5, ch = e & 31; *(LAS u32x4*)(Vs + i * GL_ST + 16 * ch) = *(const GAS u32x4*)(V + (row0 + i) * 2048 + h * 512 + 256 * DIR + 8 * ch); }
    unsigned short qraw[32], kraw[32];
    { const bf16* qp = Q + (row0 + 32 * hf) * 1024 + h * 256 + kk; const bf16* kp = Kb + (row0 + 32 * hf) * 1024 + h * 256 + kk;
#pragma unroll
      for (int p = 0; p < 32; ++p) { qraw[p] = qp[(size_t)p * 1024]; kraw[p] = kp[(size_t)p * 1024]; } }
    const float bias = OPQF(a.in[12])[(size_t)(slot * 2 + DIR) * 1024 + h * 256 + kk];
    LAS float* Zs = (LAS float*)(lds + 8192);
    float bq[2][4];
    { const float* wp = OPQF(a.in[11]) + (size_t)(slot * 2 + DIR) * 16 * 1024 + h * 256 + (lane & 15);
#pragma unroll
      for (int t2 = 0; t2 < 2; ++t2)
#pragma unroll
          for (int ks = 0; ks < 4; ++ks) bq[t2][ks] = wp[(size_t)(4 * ks + (lane >> 4)) * 1024 + 16 * (2 * wave + t2)]; }
    __syncthreads();
#pragma unroll
    for (int tm = 0; tm < 4; ++tm) { float aq[4];
#pragma unroll
        for (int ks = 0; ks < 4; ++ks) aq[ks] = As[(16 * tm + (lane & 15)) * 16 + 4 * ks + (lane >> 4)];
#pragma unroll
        for (int t2 = 0; t2 < 2; ++t2) { f32x4 zc = (f32x4){0.f, 0.f, 0.f, 0.f};
#pragma unroll
            for (int ks = 0; ks < 4; ++ks) zc = __builtin_amdgcn_mfma_f32_16x16x4f32(aq[ks], bq[t2][ks], zc, 0, 0, 0);
#pragma unroll
            for (int r = 0; r < 4; ++r) Zs[(16 * tm + 4 * (lane >> 4) + r) * 256 + 16 * (2 * wave + t2) + (lane & 15)] = zc[r]; } }
    __syncthreads();
    float lc[32]; float run = 0.f;
#pragma unroll
    for (int s = 0; s < 32; ++s) { const int p = DIR ? 31 - s : s, i = 32 * hf + p; const float z = bias + Zs[i * 256 + kk];
        run += log_sigmoid_f(z) * 0.0625f; lc[p] = run; }
    TOT[hf * 256 + kk] = run;
    __syncthreads();
    const float tot0 = TOT[kk], tot1 = TOT[256 + kk];
    const float off = DIR ? (hf == 0 ? tot1 : 0.f) : (hf == 1 ? tot0 : 0.f);
    const float dec = expf(tot0 + tot1);
    {
#pragma unroll
      for (int p = 0; p < 32; ++p) { const int i = 32 * hf + p; const float bb = lc[p] + off, eb = __expf(bb), ebi = __expf(-bb);
        const float qv = bf2f(qraw[p]), kv = bf2f(kraw[p]);
        const unsigned short qt = (unsigned short)f2bf(qv * eb); *(LAS unsigned short*)(Qs + i * GL_ST + 2 * kk) = qt;
        const float kh = kv * ebi; *(LAS unsigned short*)(Ks + i * GL_ST + 2 * kk) = (unsigned short)f2bf(kh); lc[p] = kh * dec; } }
#pragma unroll
    for (int g = 0; g < 4; ++g) { u32x4 o;
#pragma unroll
        for (int q = 0; q < 4; ++q) o[q] = pk2(lc[8 * g + 2 * q], lc[8 * g + 2 * q + 1]);
        *(GAS u32x4*)(KT + ((size_t)u * 256 + kk) * 64 + 32 * hf + 8 * g) = o; }
    if (hf == 0) DEC[(size_t)u * 256 + kk] = dec;
    __syncthreads();
#pragma unroll
    for (int q = 0; q < 4; ++q) { const int e = tid + NTHREADS * q, i = e >> 5, ch = e & 31; *(GAS u32x4*)(QT + ((size_t)u * 64 + i) * 256 + 8 * ch) = *(const LAS u32x4*)(Qs + i * GL_ST + 16 * ch); }
    { const int tr = wave >> 1, tc0 = (wave & 1) * 2, l15 = lane & 15, kq = lane >> 4;
      f32x4 acc[2] = {(f32x4){0.f, 0.f, 0.f, 0.f}, (f32x4){0.f, 0.f, 0.f, 0.f}};
#pragma unroll
      for (int s = 0; s < 8; ++s) { const bf16x8v af = *(const LAS bf16x8v*)(Qs + (16 * tr + l15) * GL_ST + (32 * s + 8 * kq) * 2);
#pragma unroll
          for (int t2 = 0; t2 < 2; ++t2) { const bf16x8v bfr = *(const LAS bf16x8v*)(Ks + (16 * (tc0 + t2) + l15) * GL_ST + (32 * s + 8 * kq) * 2);
              acc[t2] = __builtin_amdgcn_mfma_f32_16x16x32_bf16(af, bfr, acc[t2], 0, 0, 0); } }
#pragma unroll
      for (int t2 = 0; t2 < 2; ++t2)
#pragma unroll
          for (int r = 0; r < 4; ++r) { const int i = 16 * tr + 4 * kq + r, j = 16 * (tc0 + t2) + l15; const bool keep = DIR ? (j >= i) : (j <= i);
              ATT[((size_t)u * 64 + i) * 64 + j] = (bf16)f2bf(keep ? acc[t2][r] : 0.f); } }
    { bf16* vt = VT + ((size_t)(u >> 1) * 512 + 256 * DIR + kk) * 64 + 32 * hf;
#pragma unroll
      for (int g = 0; g < 4; ++g) { u32x4 o;
#pragma unroll
          for (int q = 0; q < 4; ++q) { const int i = 32 * hf + 8 * g + 2 * q;
              o[q] = (unsigned)*(const LAS unsigned short*)(Vs + i * GL_ST + 2 * kk) | ((unsigned)*(const LAS unsigned short*)(Vs + (i + 1) * GL_ST + 2 * kk) << 16); }
          *(GAS u32x4*)(vt + 8 * g) = o; } }
}
__device__ __forceinline__ void gla_prep_phase(const Args& a, int slot, LAS unsigned char* lds, int tid, int wave, int lane, int wg, int G) {
    for (int u = wg; u < 1152; u += G) { if (u & 1) gla_prep_unit<1>(a, slot, u, lds, tid, wave, lane); else gla_prep_unit<0>(a, slot, u, lds, tid, wave, lane); }
}
constexpr int GS_VST = 144, GS_STB = 64 * GL_ST, GS_VSB = 64 * GS_VST;
struct ScanB { bf16x8v Qf[8], Af[2]; };
struct ScanC { bf16x8v Kf[2][4]; };
__device__ __forceinline__ int scan_chunk(int dir, int n) { return dir ? (n < 4 ? 3 - n : 39 - n) : n; }
__device__ __forceinline__ void scan_load_b(ScanB& o, const bf16* QT, const bf16* ATT, size_t u, int wave, int l15, int kq) {
#pragma unroll
    for (int s = 0; s < 8; ++s) o.Qf[s] = *(const GAS bf16x8v*)(QT + (u * 64 + 16 * wave + l15) * 256 + 32 * s + 8 * kq);
#pragma unroll
    for (int s = 0; s < 2; ++s) o.Af[s] = *(const GAS bf16x8v*)(ATT + (u * 64 + 16 * wave + l15) * 64 + 32 * s + 8 * kq);
}
__device__ __forceinline__ void scan_load_c(ScanC& o, const bf16* KT, size_t u, int cw, int r32, int hi) {
#pragma unroll
    for (int mt = 0; mt < 2; ++mt)
#pragma unroll
        for (int s = 0; s < 4; ++s) o.Kf[mt][s] = *(const GAS bf16x8v*)(KT + (u * 256 + 64 * cw + 32 * mt + r32) * 64 + 16 * s + 8 * hi);
}
__device__ __forceinline__ void scan_part_o(const ScanB& o, LAS unsigned char* os, const LAS unsigned char* stp, const LAS unsigned char* vs, int wave, int l15, int kq) {
    f32x4 oacc[4];
#pragma unroll
    for (int t4 = 0; t4 < 4; ++t4) oacc[t4] = (f32x4){0.f, 0.f, 0.f, 0.f};
    bf16x8v bfr[2][4];
#pragma unroll
    for (int t4 = 0; t4 < 4; ++t4) bfr[0][t4] = *(const LAS bf16x8v*)(stp + (16 * t4 + l15) * GL_ST + (8 * kq) * 2);
#pragma unroll
    for (int g = 0; g < 10; ++g) {
        if (g + 1 < 10) { const int s = g + 1;
#pragma unroll
            for (int t4 = 0; t4 < 4; ++t4) bfr[(g + 1) & 1][t4] = s < 8 ? *(const LAS bf16x8v*)(stp + (16 * t4 + l15) * GL_ST + (32 * s + 8 * kq) * 2)
                                                                         : *(const LAS bf16x8v*)(vs + (16 * t4 + l15) * GS_VST + (32 * (s - 8) + 8 * kq) * 2); }
#pragma unroll
        for (int t4 = 0; t4 < 4; ++t4) oacc[t4] = __builtin_amdgcn_mfma_f32_16x16x32_bf16(g < 8 ? o.Qf[g] : o.Af[g - 8], bfr[g & 1][t4], oacc[t4], 0, 0, 0);
    }
#pragma unroll
    for (int t4 = 0; t4 < 4; ++t4)
#pragma unroll
        for (int r = 0; r < 4; ++r) *(LAS unsigned short*)(os + (16 * wave + 4 * kq + r) * GS_VST + (16 * t4 + l15) * 2) = (unsigned short)f2bf(oacc[t4][r]);
}
__device__ __forceinline__ void scan_part_s(const ScanC& oc, f32x16 (&S)[2][2], LAS unsigned char* stn, const LAS unsigned char* vs, const LAS float* decs, int cw, int r32, int hi) {
    bf16x8v vfr[4][2];
#pragma unroll
    for (int s = 0; s < 4; ++s)
#pragma unroll
        for (int nt = 0; nt < 2; ++nt) vfr[s][nt] = *(const LAS bf16x8v*)(vs + (32 * nt + r32) * GS_VST + (16 * s + 8 * hi) * 2);
#pragma unroll
    for (int mt = 0; mt < 2; ++mt)
#pragma unroll
        for (int g = 0; g < 4; ++g) { const f32x4 dc = *(const LAS f32x4*)(decs + 64 * cw + 32 * mt + 8 * g + 4 * hi);
#pragma unroll
            for (int nt = 0; nt < 2; ++nt)
#pragma unroll
                for (int q = 0; q < 4; ++q) S[mt][nt][4 * g + q] *= dc[q]; }
#pragma unroll
    for (int s = 0; s < 4; ++s)
#pragma unroll
        for (int mt = 0; mt < 2; ++mt)
#pragma unroll
            for (int nt = 0; nt < 2; ++nt) S[mt][nt] = __builtin_amdgcn_mfma_f32_32x32x16_bf16(oc.Kf[mt][s], vfr[s][nt], S[mt][nt], 0, 0, 0);
#pragma unroll
    for (int mt = 0; mt < 2; ++mt)
#pragma unroll
        for (int nt = 0; nt < 2; ++nt)
#pragma unroll
            for (int g = 0; g < 4; ++g) { u32x2 w2; w2.x = pg8::cvt_pk_bf16(S[mt][nt][4 * g], S[mt][nt][4 * g + 1]); w2.y = pg8::cvt_pk_bf16(S[mt][nt][4 * g + 2], S[mt][nt][4 * g + 3]);
                *(LAS u32x2*)(stn + (32 * nt + r32) * GL_ST + (64 * cw + 32 * mt + 8 * g + 4 * hi) * 2) = w2; }
}
__device__ __forceinline__ void scan_flush_o(const LAS unsigned char* os, bf16* O, int b, int h, int c, int dvs, int tid) {
    const u32x4 v = *(const LAS u32x4*)(os + (tid >> 3) * GS_VST + 16 * (tid & 7));
    bf16* op = O + ((size_t)b * TT + 64 * c + (tid >> 3)) * 2048 + h * 512 + 64 * dvs + 8 * (tid & 7);
    asm volatile("s_waitcnt lgkmcnt(0)\n\tglobal_store_dwordx4 %0, %1, off\n\ts_nop 2" :: "v"(op), "v"(v) : "memory");
}
template <bool OW> __device__ __forceinline__ void gla_scan_body(const Args& a, LAS unsigned char* lds, int tid, int wave, int lane, int wg, int G) {
    const bf16* QT = (const bf16*)(OPQ(a.ws) + WS_MIX + MIX_GQT); const bf16* KT = (const bf16*)(OPQ(a.ws) + WS_MIX + MIX_GKT); const bf16* VT = (const bf16*)(OPQ(a.ws) + WS_MIX + MIX_GVT);
    const bf16* ATT = (const bf16*)(OPQ(a.ws) + WS_MIX + MIX_GATT); const float* DEC = (const float*)(OPQ(a.ws) + WS_MIX + MIX_GDEC);
    LAS unsigned char* ST = lds; LAS unsigned char* Vs = lds + 2 * GS_STB; LAS unsigned char* Os = lds + 2 * GS_STB + 2 * GS_VSB; LAS float* DECs = (LAS float*)(lds + 2 * GS_STB + 4 * GS_VSB);
    const int l15 = lane & 15, kq = lane >> 4, r32 = lane & 31, hi = lane >> 5, cw = wave & 3;
    const int vso = (tid >> 3) * GS_VST + 16 * (tid & 7);
    for (int item = wg; item < 256; item += G) {
        const int dvs = (item >> 3) & 7, combo = (item & 7) * 4 + (item >> 6), dir = combo & 1, h = (combo >> 1) & 3, b = combo >> 3, bh = b * 4 + h;
        bf16* O = (bf16*)(OPQ(a.ws) + WS_MIX + (dir ? MIX_GOB : MIX_GOF));
        __syncthreads();
        for (int e = tid; e < GS_STB / 16; e += NTHREADS) *(LAS u32x4*)(ST + GS_STB + 16 * e) = (u32x4){0u, 0u, 0u, 0u};
        f32x16 S[2][2];
#pragma unroll
        for (int mt = 0; mt < 2; ++mt)
#pragma unroll
            for (int nt = 0; nt < 2; ++nt)
#pragma unroll
                for (int i = 0; i < 16; ++i) S[mt][nt][i] = 0.f;
        ScanB BA, BB; ScanC CA, CB; u32x4 vA, vB; f32x4 dA = (f32x4){0.f, 0.f, 0.f, 0.f}, dB = dA;
#define SCAN_BAR() do { asm volatile("s_waitcnt lgkmcnt(0)" ::: "memory"); __builtin_amdgcn_s_barrier(); asm volatile("" ::: "memory"); } while (0)
#define SCAN_LOAD(BS, CS, vr, dr, n_) do { const int c_ = scan_chunk(dir, (n_)); const size_t uv_ = (size_t)bh * 36 + c_, u_ = uv_ * 2 + dir; \
            vr = *(const GAS u32x4*)(VT + (uv_ * 512 + 64 * dvs + (tid >> 3)) * 64 + 8 * (tid & 7)); if (tid < 64) dr = *(const GAS f32x4*)(DEC + u_ * 256 + 4 * tid); \
            if constexpr (OW) scan_load_b(BS, QT, ATT, u_, wave, l15, kq); else scan_load_c(CS, KT, u_, cw, r32, hi); } while (0)
#define SCAN_STAGE(vr, dr, buf) do { *(LAS u32x4*)(Vs + (buf) * GS_VSB + vso) = vr; if (tid < 64) *(LAS f32x4*)(DECs + (buf) * 256 + 4 * tid) = dr; } while (0)
#define SCAN_STEP(BS, CS, n_) do { const int n__ = (n_); if constexpr (OW) scan_part_o(BS, Os + (n__ & 1) * GS_VSB, ST + ((n__ + 1) & 1) * GS_STB, Vs + (n__ & 1) * GS_VSB, wave, l15, kq); \
            else scan_part_s(CS, S, ST + (n__ & 1) * GS_STB, Vs + (n__ & 1) * GS_VSB, DECs + (n__ & 1) * 256, cw, r32, hi); } while (0)
        SCAN_LOAD(BA, CA, vA, dA, 0);
        SCAN_STAGE(vA, dA, 0);
        SCAN_LOAD(BB, CB, vB, dB, 1);
        SCAN_BAR();
#pragma unroll 1
        for (int n = 0; n < 36; n += 2) {
            SCAN_STEP(BA, CA, n);
            SCAN_STAGE(vB, dB, 1);
            if (n > 0) scan_flush_o(Os + GS_VSB, O, b, h, scan_chunk(dir, n - 1), dvs, tid);
            SCAN_LOAD(BA, CA, vA, dA, n + 2 < 36 ? n + 2 : 35);
            SCAN_BAR();
            SCAN_STEP(BB, CB, n + 1);
            SCAN_STAGE(vA, dA, 0);
            scan_flush_o(Os, O, b, h, scan_chunk(dir, n), dvs, tid);
            SCAN_LOAD(BB, CB, vB, dB, n + 3 < 36 ? n + 3 : 35);
            SCAN_BAR();
        }
        scan_flush_o(Os + GS_VSB, O, b, h, scan_chunk(dir, 35), dvs, tid);
#undef SCAN_BAR
#undef SCAN_LOAD
#undef SCAN_STAGE
#undef SCAN_STEP
    }
}
__device__ __forceinline__ void gla_scan_phase(const Args& a, LAS unsigned char* lds, int tid, int wave, int lane, int wg, int G) {
    if (wave < 4) gla_scan_body<true>(a, lds, tid, wave, lane, wg, G); else gla_scan_body<false>(a, lds, tid, wave, lane, wg, G);
}
__device__ __forceinline__ void gla_onorm_phase(const Args& a, int slot, bool skip_ctx, int lane, int gw, int ngw) {
    const bf16* OF = (const bf16*)(OPQ(a.ws) + WS_MIX + MIX_GOF); const bf16* OB = (const bf16*)(OPQ(a.ws) + WS_MIX + MIX_GOB); const bf16* OG = (const bf16*)(OPQ(a.ws) + WS_MIX + MIX_GOG);
    const float* og_g = OPQF(a.in[13]) + (size_t)slot * D; bf16* HA = (bf16*)(OPQ(a.ws) + WS_HA);
    const int nit = skip_ctx ? NB * SEQ * 2 : M * 2;
#pragma unroll 2
    for (int it = gw; it < nit; it += ngw) {
        int r = it >> 1; const int h2 = (it & 1) * 2;
        if (skip_ctx) r = (r >> 11) * TT + LC + (r & (SEQ - 1));
#pragma unroll
        for (int hj = 0; hj < 2; ++hj) { const int hh = h2 + hj;
            const size_t off = (size_t)r * D + hh * 512 + 8 * lane;
            const u32x4 f = *(const GAS u32x4*)(OF + off), bk = *(const GAS u32x4*)(OB + off), g = *(const GAS u32x4*)(OG + off);
            float o[8];
#pragma unroll
            for (int q = 0; q < 4; ++q) { o[2 * q] = bflo(f[q]) + bflo(bk[q]); o[2 * q + 1] = bfhi(f[q]) + bfhi(bk[q]); }
            float ss = 0.f;
#pragma unroll
            for (int q = 0; q < 8; ++q) ss += o[q] * o[q];
            const float rs = 1.0f / sqrtf(wave_sum(ss) * (1.0f / 512.0f) + EPS);
            const f32x4 w0 = *(const GAS f32x4*)(og_g + hh * 512 + 8 * lane), w1 = *(const GAS f32x4*)(og_g + hh * 512 + 8 * lane + 4);
            u32x4 w;
#pragma unroll
            for (int q = 0; q < 4; ++q) { const float wa = q < 2 ? w0[2 * q] : w1[2 * q - 4], wb = q < 2 ? w0[2 * q + 1] : w1[2 * q - 3];
                w[q] = pk2(o[2 * q] * rs * wa * bflo(g[q]), o[2 * q + 1] * rs * wb * bfhi(g[q])); }
            *(GAS u32x4*)(HA + off) = w;
        }
    }
}

constexpr int ATT_KST = 144, ATT_VST = 136, ATT_KB = 64 * ATT_KST, ATT_VB = 64 * ATT_VST;
__device__ __forceinline__ void swa_attn_phase(const Args& a, bool skip_ctx, LAS unsigned char* lds, int tid, int wave, int lane, int wg, int G) {
    const bf16* SQ = (const bf16*)(OPQ(a.ws) + WS_MIX + MIX_SQ); const bf16* SK = (const bf16*)(OPQ(a.ws) + WS_MIX + MIX_SK); const bf16* SVT = (const bf16*)(OPQ(a.ws) + WS_MIX + MIX_SV);
    const float* sink = OPQF(a.in[16]); bf16* HA = (bf16*)(OPQ(a.ws) + WS_HA);
    LAS unsigned char* Kb = lds; LAS unsigned char* Vb = lds + 2 * ATT_KB;
    const int r32 = lane & 31, hi = lane >> 5, srow = tid >> 3, sch = tid & 7;
    const int nunits = skip_ctx ? 512 : 576;
    for (int ui = wg; ui < nunits; ui += G) {
        const bool lat = ui < 512;
        int b, kvh, qb; { const int w = ui & 255, x = w & 7, s = w >> 3;
            if (lat) { const int combo = 2 * x + (ui >> 8); b = combo >> 2; kvh = combo & 3; qb = s; }
            else { const int combo = 2 * x + (s & 1); b = combo >> 2; kvh = combo & 3; qb = (s >> 1) & 3; } }
        const int head = kvh * 8 + wave;
        const int tq0 = lat ? LC + 64 * qb : 64 * qb;
        const int w_lo = qb - 2 < 0 ? 0 : qb - 2, w_hi = qb + 2 > 31 ? 31 : qb + 2;
        const int ntile = lat ? 4 + (w_hi - w_lo + 1) : 4;
        const bf16* kbase = SK + (size_t)b * TT * 256 + kvh * 64 + (size_t)srow * 256 + 8 * sch;
        const bf16* vbase = SVT + ((size_t)(b * 4 + kvh) * 64 + srow) * TT + 8 * sch;
        bf16x8v Qf[2][4];
#pragma unroll
        for (int nt = 0; nt < 2; ++nt)
#pragma unroll
            for (int ks = 0; ks < 4; ++ks) Qf[nt][ks] = *(const GAS bf16x8v*)(SQ + ((size_t)b * TT + tq0 + 32 * nt + r32) * D + head * 64 + 16 * ks + 8 * hi);
        const float sink2 = sink[head] * 1.4426950408889634f;
        float m2[2] = {sink2, sink2}, ls[2] = {hi ? 0.f : 1.f, hi ? 0.f : 1.f};
        f32x16 O[2][2];
#pragma unroll
        for (int dt = 0; dt < 2; ++dt)
#pragma unroll
            for (int nt = 0; nt < 2; ++nt)
#pragma unroll
                for (int i = 0; i < 16; ++i) O[dt][nt][i] = 0.f;
        u32x4 kreg, vreg;
        { const int t0 = 0; kreg = *(const GAS u32x4*)(kbase + (size_t)t0 * 256); vreg = *(const GAS u32x4*)(vbase + t0); }
        *(LAS u32x4*)(Kb + srow * ATT_KST + 16 * sch) = kreg;
        *(LAS u32x2*)(Vb + srow * ATT_VST + 16 * sch) = (u32x2){vreg.x, vreg.y}; *(LAS u32x2*)(Vb + srow * ATT_VST + 16 * sch + 8) = (u32x2){vreg.z, vreg.w};
        __syncthreads();
#pragma unroll 1
        for (int j = 0; j < ntile; ++j) {
            const int buf = j & 1;
            if (j + 1 < ntile) { const int jn = j + 1; const int t0 = jn < 4 ? 64 * jn : LC + 64 * (w_lo + jn - 4);
                kreg = *(const GAS u32x4*)(kbase + (size_t)t0 * 256); vreg = *(const GAS u32x4*)(vbase + t0); }
            const int rel = j < 4 ? 0 : (w_lo + j - 4) - qb;
            const bool masked = (rel == 2 || rel == -2);
            const LAS unsigned char* kt = Kb + buf * ATT_KB; const LAS unsigned char* vt = Vb + buf * ATT_VB;
#pragma unroll
            for (int nt = 0; nt < 2; ++nt) {
                f32x16 s[2];
#pragma unroll
                for (int mt = 0; mt < 2; ++mt) {
#pragma unroll
                    for (int i = 0; i < 16; ++i) s[mt][i] = -m2[nt];
#pragma unroll
                    for (int ks = 0; ks < 4; ++ks) { const bf16x8v kf = *(const LAS bf16x8v*)(kt + (32 * mt + r32) * ATT_KST + (16 * ks + 8 * hi) * 2);
                        s[mt] = __builtin_amdgcn_mfma_f32_32x32x16_bf16(kf, Qf[nt][ks], s[mt], 0, 0, 0); }
                }
                __builtin_amdgcn_sched_barrier(0);
                if (masked) {
                    int mb = r32 - 4 * hi - 64 * rel; asm volatile("" : "+v"(mb));
#pragma unroll
                    for (int mt = 0; mt < 2; ++mt)
#pragma unroll
                        for (int i = 0; i < 16; ++i) { const int cc = 32 * mt + (i & 3) + 8 * (i >> 2) - 32 * nt;
                            if (mb > 128 + cc || mb < cc - 128) s[mt][i] = -1e30f; }
                }
                float mx = s[0][0];
#pragma unroll
                for (int i = 1; i < 16; ++i) mx = fmaxf(mx, s[0][i]);
#pragma unroll
                for (int i = 0; i < 16; ++i) mx = fmaxf(mx, s[1][i]);
                mx = fmaxf(mx, __shfl_xor(mx, 32));
                if (__any(mx > 8.0f)) { const float dlt = fmaxf(mx, 0.f), alpha = __builtin_amdgcn_exp2f(-dlt); m2[nt] += dlt; ls[nt] *= alpha;
#pragma unroll
                    for (int mt = 0; mt < 2; ++mt)
#pragma unroll
                        for (int i = 0; i < 16; ++i) s[mt][i] -= dlt;
#pragma unroll
                    for (int dt = 0; dt < 2; ++dt)
#pragma unroll
                        for (int i = 0; i < 16; ++i) O[dt][nt][i] *= alpha; }
                float psum = 0.f;
#pragma unroll
                for (int mt = 0; mt < 2; ++mt)
#pragma unroll
                    for (int i = 0; i < 16; ++i) { s[mt][i] = __builtin_amdgcn_exp2f(s[mt][i]); psum += s[mt][i]; }
                ls[nt] += psum;
                __builtin_amdgcn_sched_barrier(0);
                bf16x8v Pf[2][2];
#pragma unroll
                for (int mt = 0; mt < 2; ++mt)
#pragma unroll
                    for (int s2 = 0; s2 < 2; ++s2) { u32x4 w;
#pragma unroll
                        for (int q = 0; q < 4; ++q) w[q] = pg8::cvt_pk_bf16(s[mt][8 * s2 + 2 * q], s[mt][8 * s2 + 2 * q + 1]);
                        Pf[mt][s2] = __builtin_bit_cast(bf16x8v, w); }
#pragma unroll
                for (int dt = 0; dt < 2; ++dt)
#pragma unroll
                    for (int mt = 0; mt < 2; ++mt)
#pragma unroll
                        for (int s2 = 0; s2 < 2; ++s2) { const LAS unsigned char* vp = vt + (32 * dt + r32) * ATT_VST + (32 * mt + 16 * s2 + 4 * hi) * 2;
                            const u32x2 lo = *(const LAS u32x2*)vp, hh = *(const LAS u32x2*)(vp + 16);
                            const bf16x8v vf = __builtin_bit_cast(bf16x8v, (u32x4){lo.x, lo.y, hh.x, hh.y});
                            O[dt][nt] = __builtin_amdgcn_mfma_f32_32x32x16_bf16(vf, Pf[mt][s2], O[dt][nt], 0, 0, 0); }
                __builtin_amdgcn_sched_barrier(0);
            }
            if (j + 1 < ntile) { const int nb = buf ^ 1;
                *(LAS u32x4*)(Kb + nb * ATT_KB + srow * ATT_KST + 16 * sch) = kreg;
                *(LAS u32x2*)(Vb + nb * ATT_VB + srow * ATT_VST + 16 * sch) = (u32x2){vreg.x, vreg.y}; *(LAS u32x2*)(Vb + nb * ATT_VB + srow * ATT_VST + 16 * sch + 8) = (u32x2){vreg.z, vreg.w}; }
            __syncthreads();
        }
#pragma unroll
        for (int nt = 0; nt < 2; ++nt) {
            const float lt = ls[nt] + __shfl_xor(ls[nt], 32), inv = 1.0f / lt;
            bf16* op = HA + ((size_t)b * TT + tq0 + 32 * nt + r32) * D + head * 64 + 4 * hi;
#pragma unroll
            for (int dt = 0; dt < 2; ++dt)
#pragma unroll
                for (int g = 0; g < 4; ++g) { u32x2 w; w.x = pg8::cvt_pk_bf16(O[dt][nt][4 * g] * inv, O[dt][nt][4 * g + 1] * inv); w.y = pg8::cvt_pk_bf16(O[dt][nt][4 * g + 2] * inv, O[dt][nt][4 * g + 3] * inv);
                    *(GAS u32x2*)(op + 32 * dt + 8 * g) = w; }
        }
    }
}

__device__ __forceinline__ void gmlp_stats_phase(const Args& a, bool skip_ctx, int lane, int gw, int ngw) {
    const bf16* V = (const bf16*)(OPQ(a.ws) + WS_MIX + MIX_V); float* MU = (float*)(OPQ(a.ws) + WS_STAT); float* RS = MU + M;
    for (int r = gw; r < M; r += ngw) {
        if (skip_ctx && (r % TT) < LC) continue;
        float v[32];
#pragma unroll
        for (int j = 0; j < 4; ++j) { const u32x4 w = *(const GAS u32x4*)(V + (size_t)r * D + 512 * j + 8 * lane);
#pragma unroll
            for (int q = 0; q < 4; ++q) { v[8 * j + 2 * q] = bflo(w[q]); v[8 * j + 2 * q + 1] = bfhi(w[q]); } }
        float s = 0.f;
#pragma unroll
        for (int j = 0; j < 32; ++j) s += v[j];
        const float mean = wave_sum(s) * (1.0f / D); float q2 = 0.f;
#pragma unroll
        for (int j = 0; j < 32; ++j) { const float d = v[j] - mean; q2 += d * d; }
        const float var = wave_sum(q2) * (1.0f / D);
        if (lane == 0) { MU[r] = mean; RS[r] = 1.0f / sqrtf(var + EPS); }
    }
}
constexpr int GM_ST = 272;
__device__ __forceinline__ void gmlp_spatial_phase(const Args& a, bool skip_ctx, LAS unsigned char* lds, int tid, int wave, int lane, int wg, int G) {
    LAS unsigned char* VT = lds;
    LAS unsigned char* WSs = lds + 128 * GM_ST;
    const bf16* U = (const bf16*)(OPQ(a.ws) + WS_MIX + MIX_U); const bf16* V = (const bf16*)(OPQ(a.ws) + WS_MIX + MIX_V);
    const float* SP = (const float*)(OPQ(a.ws) + WS_A32);
    LAS float* TB = (LAS float*)(lds + 256 * GM_ST);
    const float* lng = OPQF(a.in[19]); const float* lnb = OPQF(a.in[20]); const float* wsp = OPQF(a.in[21]); const float* bs = OPQF(a.in[22]); bf16* HA = (bf16*)(OPQ(a.ws) + WS_HA);
    const int l15 = lane & 15, kq = lane >> 4;
    for (int g = wg & 15; g < 16; g += (G >= 16 ? 16 : G)) {
        if (G < 16 && false) {}
        const int C0 = 128 * g;
        __syncthreads();
        for (int e = tid; e < 128 * 32; e += NTHREADS) { const int i = e >> 5, j4 = e & 31; const f32x4 w = *(const GAS f32x4*)(wsp + (size_t)g * 16384 + i * 128 + 4 * j4);
            u32x2 o; o.x = pk2(w[0], w[1]); o.y = pk2(w[2], w[3]); *(LAS u32x2*)(WSs + i * GM_ST + 8 * j4) = o; }
        const int nstep = (G >> 4 > 0 ? G >> 4 : 1);
        for (int e = tid; e < 5 * 128; e += NTHREADS) { const int k = e >> 7, j = e & 127, n = (wg >> 4) + nstep * k;
            if (n < 72) { const float* sp = SP + (size_t)(128 * n + j) * 64; float s1 = 0.f, s2 = 0.f;
#pragma unroll
                for (int q = 0; q < 16; ++q) { const f32x4 w = *(const GAS f32x4*)(sp + 4 * q); s1 += w.x + w.z; s2 += w.y + w.w; }
                const float mean = s1 * (1.0f / D), var = fmaxf(s2 * (1.0f / D) - mean * mean, 0.f);
                TB[2 * e] = mean; TB[2 * e + 1] = 1.0f / sqrtf(var + EPS); } }
        u32x4 vnx[4]; int pref_n = -1;
        const int c8t = (tid & 15) * 8;
        const f32x4 g0 = *(const GAS f32x4*)(lng + C0 + c8t), g1 = *(const GAS f32x4*)(lng + C0 + c8t + 4), b0 = *(const GAS f32x4*)(lnb + C0 + c8t), b1 = *(const GAS f32x4*)(lnb + C0 + c8t + 4);
        for (int n = wg >> 4, kit = 0; n < 72; n += nstep, ++kit) {
            const int R0 = 128 * n;
            if (skip_ctx && (R0 % TT) < LC) continue;
            if (pref_n != n) {
#pragma unroll
                for (int q = 0; q < 4; ++q) { const int e = tid + NTHREADS * q; vnx[q] = *(const GAS u32x4*)(V + (size_t)(R0 + (e >> 4)) * D + C0 + (e & 15) * 8); } }
            __syncthreads();
#pragma unroll
            for (int q = 0; q < 4; ++q) { const int e = tid + NTHREADS * q, j = e >> 4, c8 = (e & 15) * 8;
                const u32x4 vv = vnx[q]; const float mu = TB[2 * (kit * 128 + j)], rs = TB[2 * (kit * 128 + j) + 1];
#pragma unroll
                for (int k = 0; k < 4; ++k) { const float x0 = (bflo(vv[k]) - mu) * rs, x1 = (bfhi(vv[k]) - mu) * rs;
                    const float ga = k < 2 ? g0[2 * k] : g1[2 * k - 4], gb = k < 2 ? g0[2 * k + 1] : g1[2 * k - 3], ba_ = k < 2 ? b0[2 * k] : b1[2 * k - 4], bb = k < 2 ? b0[2 * k + 1] : b1[2 * k - 3];
                    const int sw = ((((j >> 3) ^ (c8 >> 3)) & 15) << 4) + (j & 7) * 2;
                    *(LAS unsigned short*)(VT + (c8 + 2 * k) * GM_ST + sw) = (unsigned short)f2bf(x0 * ga + ba_);
                    *(LAS unsigned short*)(VT + (c8 + 2 * k + 1) * GM_ST + sw) = (unsigned short)f2bf(x1 * gb + bb); } }
            __syncthreads();
            { const int nn = n + nstep; pref_n = -1;
              if (nn < 72 && !(skip_ctx && ((128 * nn) % TT) < LC)) { pref_n = nn;
#pragma unroll
                  for (int q = 0; q < 4; ++q) { const int e = tid + NTHREADS * q; vnx[q] = *(const GAS u32x4*)(V + (size_t)(128 * nn + (e >> 4)) * D + C0 + (e & 15) * 8); } } }
            bf16x8v Bf[4];
#pragma unroll
            for (int ks = 0; ks < 4; ++ks) Bf[ks] = *(const LAS bf16x8v*)(WSs + (16 * wave + l15) * GM_ST + (32 * ks + 8 * kq) * 2);
            const int i = 16 * wave + l15; const float bsv = bs[g * 128 + i];
            const size_t orow = (size_t)(R0 + i) * D + C0 + 4 * kq;
#pragma unroll
            for (int ct = 0; ct < 8; ++ct) { f32x4 acc = (f32x4){0.f, 0.f, 0.f, 0.f};
#pragma unroll
                for (int ks = 0; ks < 4; ++ks) { const int cr = 16 * ct + l15; const bf16x8v af = *(const LAS bf16x8v*)(VT + cr * GM_ST + ((((4 * ks + kq) ^ (cr >> 3)) & 15) << 4));
                    acc = __builtin_amdgcn_mfma_f32_16x16x32_bf16(af, Bf[ks], acc, 0, 0, 0); }
                const u32x2 uu = *(const GAS u32x2*)(U + orow + 16 * ct);
                u32x2 o; o.x = pk2(bflo(uu.x) * (acc[0] + bsv), bfhi(uu.x) * (acc[1] + bsv)); o.y = pk2(bflo(uu.y) * (acc[2] + bsv), bfhi(uu.y) * (acc[3] + bsv));
                *(GAS u32x2*)(HA + orow + 16 * ct) = o; }
        }
    }
}

#ifndef SITE_MASK
#define SITE_MASK 0x1ff
#endif
#define SITE(n) (((SITE_MASK) >> (n)) & 1)
#ifndef DUP_PHASE
#define DUP_PHASE (-1)
#endif
#define REPS(p) for (int rep_ = 0; rep_ < (((p) == DUP_PHASE) ? 2 : 1); ++rep_)
constexpr int N_PHASES = 2 + 9 * DEPTH;
__host__ __device__ constexpr bool phase_exists(int p) { if (p < 2) return true; const int q = (p - 2) % 9, kind = ((p - 2) / 9) % 3; return !((q == 2 && kind == 1) || (q == 3 && kind != 0) || (q == 1 && kind == 2)); }

__global__ void __launch_bounds__(NTHREADS, 2) trunk_fwd(Args args) {
    extern __shared__ __attribute__((aligned(16))) unsigned char lds_raw[];
    LAS unsigned char* lds = (LAS unsigned char*)lds_raw;
    const int wave = __builtin_amdgcn_readfirstlane((int)threadIdx.x >> 6);
#define FRESH_WS() unsigned char* ws = args.ws; asm volatile("" : "+s"(ws))
#define FRESH_TID() int tid_f = threadIdx.x; asm volatile("" : "+v"(tid_f)); const int tid = tid_f, lane = tid & 63; (void)lane
    const int G = gridDim.x, wg = blockIdx.x;
    const int gw = wg * NWAVES + wave, ngw = G * NWAVES;
    unsigned char* ws = args.ws;
    gu32* ctl = (gu32*)(OPQ(args.ws) + WS_CTL);
    for (int u = threadIdx.x; u < (LDS_BYTES - LDSCTL_OFF) / 4; u += NTHREADS) ((LAS unsigned*)(lds + LDSCTL_OFF))[u] = 0u;
    __syncthreads();
    XcdBarrier bar = xcd_barrier_post((unsigned*)(ctl + CW_BAR), (volatile LAS unsigned*)(lds + MISC_OFF) + 8);
    const int lo = args.ph_lo, hi = args.ph_hi;
#define IN(k) (lo <= (k) && (k) < hi)
#define PULL(until, quota) do { int tp_ = threadIdx.x; asm volatile("" : "+v"(tp_)); tr_pull(args, lds, wave, tp_ & 63, (until), (quota)); } while (0)
#define LIGHT(nunits) (((nunits) % G) != 0 && wg >= ((nunits) % G))
#define SEAM(k) do { if ((k) + 1 < hi) { XcdBarrier bl = bar; asm volatile("" : "+s"(bl.bar)); xcd_barrier(bl); } } while (0)

    if (IN(0) && SITE(8)) { FRESH_TID(); REPS(0) { if (wg < 64) adaln_unit(args, lds, tid, wave, lane, 0, wg); if (wg == G - 1) p0_rope(args, tid); tr_pull(args, lds, wave, lane, PROLOGUE_UNTIL, 1 << 20); __syncthreads(); } SEAM(0); }
    if (IN(1) && SITE(8)) { FRESH_TID(); norm0_phase(args, wave, lane, wg, G); SEAM(1); }

    const pg8::bf16_t* HA = (const pg8::bf16_t*)(OPQ(args.ws) + WS_HA);
#pragma unroll 1
    for (int l = 0; l < DEPTH; ++l) {
        const int base = 2 + 9 * l, kind = l % 3, slot = l / 3;
        const bool last = (l == DEPTH - 1);
        if (IN(base + 0)) { REPS(base + 0) {
            if (kind == 0) {
                pg8::Gemm g{HA, (const pg8::bf16_t*)(OPQ(args.ws) + WS_GLAW + slot * GLAW_STRIDE), M, GLA_NP, D, D}; pg8::Sched S; S.init(M / 256, GLA_NP / 256, G, wg, 0);
                pg8::EpiGlaIn E{(pg8::bf16_t*)(OPQ(args.ws) + WS_MIX + MIX_GQ), (pg8::bf16_t*)(OPQ(args.ws) + WS_MIX + MIX_GK), (pg8::bf16_t*)(OPQ(args.ws) + WS_MIX + MIX_GV), (pg8::bf16_t*)(OPQ(args.ws) + WS_MIX + MIX_GOG), (float*)(OPQ(args.ws) + WS_A32)};
                if (SITE(0)) pg8::gemm_phase<pg8::EpiGlaIn, pg8::Sched, true, true>(lds, g, S, E);
            } else if (kind == 1) {
                pg8::Gemm g{HA, (const pg8::bf16_t*)(OPQ(args.ws) + WS_SWAW), M, SWA_N, D, D}; pg8::Sched S; S.init(M / 256, SWA_N / 256, G, wg, 0);
                pg8::EpiSwaIn E{(pg8::bf16_t*)(OPQ(args.ws) + WS_MIX + MIX_SQ), (pg8::bf16_t*)(OPQ(args.ws) + WS_MIX + MIX_SK), (pg8::bf16_t*)(OPQ(args.ws) + WS_MIX + MIX_SV), (const float*)(OPQ(args.ws) + WS_ROPE), (const float*)(OPQ(args.ws) + WS_ROPE) + 1024};
                if (SITE(1)) pg8::gemm_phase<pg8::EpiSwaIn, pg8::Sched, true, true>(lds, g, S, E);
            } else {
                pg8::Gemm g{HA, (const pg8::bf16_t*)(OPQ(args.ws) + WS_GMW), M, GM_N, D, D}; pg8::Sched S; S.init(M / 256, GM_N / 256, G, wg, 0);
                pg8::EpiGmlpIn E{(pg8::bf16_t*)(OPQ(args.ws) + WS_MIX + MIX_U), (pg8::bf16_t*)(OPQ(args.ws) + WS_MIX + MIX_V), (float*)(OPQ(args.ws) + WS_A32)};
                if (SITE(2)) pg8::gemm_phase<pg8::EpiGmlpIn, pg8::Sched, true, true>(lds, g, S, E);
            }
            { const int nun = 36 * (kind == 0 ? GLA_NP / 256 : (kind == 1 ? SWA_N / 256 : GM_N / 256)); if (LIGHT(nun)) { const int li = wg - (nun % G); if (!last && li < 64) { FRESH_TID(); adaln_unit(args, lds, tid, wave, lane, l + 1, li); } PULL(tr_need(base + 6 + REACH), Q_IN); } }
            } SEAM(base + 0);
        }
        if (IN(base + 1) && kind != 2) { FRESH_TID(); REPS(base + 1) {
            if (kind == 0) gla_prep_phase(args, slot, lds, tid, wave, lane, wg, G);
            else if (kind == 1) swa_attn_phase(args, last, lds, tid, wave, lane, wg, G);
            else {   }
            __syncthreads(); } SEAM(base + 1);
        }
        if (IN(base + 2) && kind != 1) { FRESH_TID(); REPS(base + 2) {
            if (kind == 0) gla_scan_phase(args, lds, tid, wave, lane, wg, G);
            else gmlp_spatial_phase(args, last, lds, tid, wave, lane, wg, G);
            __syncthreads(); } SEAM(base + 2);
        }
        if (IN(base + 3) && kind == 0) { FRESH_TID(); REPS(base + 3) {
            gla_onorm_phase(args, slot, last, lane, gw, ngw);
            __syncthreads(); } SEAM(base + 3);
        }
        if (IN(base + 4)) { REPS(base + 4) {
            const size_t wo = kind == 0 ? WS_GLAW + slot * GLAW_STRIDE + GLAW_WO : (kind == 1 ? WS_SWAW + SWAW_WO : WS_GMW + GMW_WO);
#pragma unroll 1
            for (int pass = 0; pass < (last ? 1 : 2); ++pass) {
                pg8::Gemm g{HA, (const pg8::bf16_t*)(OPQ(args.ws) + wo), M, D, D, D}; pg8::Sched S; S.init(32, D / 256, G, wg, 1);
                pg8::EpiY E{(pg8::bf16_t*)(OPQ(args.ws) + WS_Y), nullptr, D};
                if (pass) { const int cp = wg >> 5, sl = wg & 3, Ks = D / 4; g.A += sl * Ks; g.Bt += sl * Ks; g.K = Ks; S.init_one(wg < 128, 9 * cp, (wg >> 2) & 7);
                    E.P = (pg8::bf16_t*)(OPQ(args.ws) + WS_YP) + (ptrdiff_t)sl * (NB * LC) * D + (ptrdiff_t)(cp - 9 * cp) * 256 * D; }
                if (SITE(3)) pg8::gemm_phase<pg8::EpiY, pg8::Sched, true, true>(lds, g, S, E);
            }
            if (!last && wg >= 128) PULL(tr_need(base + 6 + REACH), Q_WO);
            } SEAM(base + 4);
        }
        if (IN(base + 5)) { FRESH_TID(); if (SITE(7)) resid_phase<0>(args, l, lds, tid, wave, lane, wg, G); PULL(tr_need(base + 6), 1 << 20); SEAM(base + 5); }
        if (IN(base + 6)) { REPS(base + 6) {
            pg8::Gemm g{HA, (const pg8::bf16_t*)(OPQ(args.ws) + WS_FFNW + l * FFNW_STRIDE), M, 2 * FF, D, D}; pg8::Sched S; S.init(last ? 32 : 36, 2 * FF / 256, G, wg, last ? 1 : 0); S.set_tail(D / 64);
            pg8::EpiUp E{(pg8::bf16_t*)(OPQ(args.ws) + WS_HFF), FF, (unsigned*)(OPQ(args.ws) + WS_CTL) + CW_SPLIT + l * 128, OPQ(args.ws) + WS_YP, (LAS unsigned*)(lds + MISC_OFF + 4), 1 << S.Ssh};
            if (SITE(4)) pg8::gemm_phase<pg8::EpiUp, pg8::Sched, true, true>(lds, g, S, E);
            PULL(tr_need(base + 7), 1 << 20);
            } SEAM(base + 6);
        }
        if (IN(base + 7)) { REPS(base + 7) {
#pragma unroll 1
            for (int pass = 0; pass < (last ? 1 : 2); ++pass) {
                pg8::Gemm g{(const pg8::bf16_t*)(OPQ(args.ws) + WS_HFF), (const pg8::bf16_t*)(OPQ(args.ws) + WS_FFNW + l * FFNW_STRIDE + FFNW_W2), M, D, FF, FF}; pg8::Sched S; S.init(32, D / 256, G, wg, 1);
                pg8::EpiY E{(pg8::bf16_t*)(OPQ(args.ws) + WS_Y), nullptr, D};
                if (pass) { const int cp = wg >> 5, sl = wg & 3, Ks = FF / 4; g.A += sl * Ks; g.Bt += sl * Ks; g.K = Ks; S.init_one(wg < 128, 9 * cp, (wg >> 2) & 7);
                    E.P = (pg8::bf16_t*)(OPQ(args.ws) + WS_YP) + (ptrdiff_t)sl * (NB * LC) * D + (ptrdiff_t)(cp - 9 * cp) * 256 * D; }
                if (SITE(5)) pg8::gemm_phase<pg8::EpiY, pg8::Sched, true, true>(lds, g, S, E);
            }
            if (!last && wg >= 128) PULL(tr_need(base + 9), Q_DN);
            } SEAM(base + 7);
        }
        if (IN(base + 8)) { FRESH_TID(); if (SITE(7)) resid_phase<1>(args, l, lds, tid, wave, lane, wg, G); if (!last) PULL(tr_need(base + 9), 1 << 20); SEAM(base + 8); }
    }
#undef IN
#undef SEAM
}

#ifndef MK_ONE_LAUNCH
#define MK_ONE_LAUNCH 0
#endif
extern "C" void kernel_launch(void* const* d_in, const int* in_sizes, int n_in, void* d_out, int out_size, void* d_ws, size_t ws_size, hipStream_t stream) {
    static int grid = 0;
    if (grid == 0) {
        if (n_in != 24 || out_size != NB * SEQ * D || ws_size < WS_END) { fprintf(stderr, "kernel_launch: unexpected problem (n_in %d, out %d, ws %zu); nothing launched\n", n_in, out_size, ws_size); grid = -1; return; }
        int dev = 0, cus = 0, per_cu = 0;
        if (hipGetDevice(&dev) != hipSuccess || hipDeviceGetAttribute(&cus, hipDeviceAttributeMultiprocessorCount, dev) != hipSuccess) { grid = -1; return; }
        if (hipFuncSetAttribute((const void*)trunk_fwd, hipFuncAttributeMaxDynamicSharedMemorySize, LDS_BYTES) != hipSuccess) { fprintf(stderr, "kernel_launch: hipFuncSetAttribute failed\n"); grid = -1; return; }
        if (hipOccupancyMaxActiveBlocksPerMultiprocessor(&per_cu, (const void*)trunk_fwd, NTHREADS, LDS_BYTES) != hipSuccess || per_cu < 1) { fprintf(stderr, "kernel_launch: occupancy query says %d\n", per_cu); }
        (void)hipGetLastError();
        grid = cus;
    }
    if (grid < 0) return;
    if (hipMemsetAsync((char*)d_ws + WS_CTL, 0, CTL_ZERO_BYTES, stream) != hipSuccess) return;
    Args a{};
    for (int i = 0; i < 24; ++i) a.in[i] = (const float*)d_in[i];
    a.out = (float*)d_out; a.ws = (unsigned char*)d_ws;
#if MK_ONE_LAUNCH
    a.ph_lo = 0; a.ph_hi = N_PHASES;
    hipLaunchKernelGGL(trunk_fwd, dim3(grid), dim3(NTHREADS), LDS_BYTES, stream, a);
#else
#ifndef HOST_DUP_PHASE
#define HOST_DUP_PHASE (-1)
#endif
#ifndef HOST_DUP_REPS
#define HOST_DUP_REPS 2
#endif
    for (int p = 0; p < N_PHASES; ++p) { if (!phase_exists(p)) continue; a.ph_lo = p; a.ph_hi = p + 1;
        for (int rep = 0; rep < (p == HOST_DUP_PHASE ? HOST_DUP_REPS : 1); ++rep) hipLaunchKernelGGL(trunk_fwd, dim3(grid), dim3(NTHREADS), LDS_BYTES, stream, a); }
#endif
}
```
